# Optimizing an MI355X kernel written in HIP

```python
import math
import jax, jax.numpy as jnp
from jax import lax
import numpy as np

D_MODEL = 1024
BATCH = 2
SEQ = 8192
DEPTH = 2

CHUNK = 64
N_MIXERS = 2
N_LAYERS_A = (DEPTH + 1) // 2
N_LAYERS_B = DEPTH // 2

A_HEADS = 8
A_HEAD_DIM = 64
A_V_DIM = 2 * A_HEAD_DIM
Q_BLOCK = 128
T5_BUCKETS = 32
T5_MAX_DIST = 1024

B_HEADS = 16
B_HEAD_DIM = D_MODEL // B_HEADS
LEFT_CHUNKS = 8
BAND = (LEFT_CHUNKS + 1) * CHUNK
MAX_REL = 256

N_EXPERTS = 16
N_GROUPS = 4
E_PER_GROUP = N_EXPERTS // N_GROUPS
TOPK_GROUPS = 1
TOP_K = 2
D_FF_EXPERT = 512

NORM_EPS = 1e-6
NEG_INF = -1e30

kernel_name = "hybrid_diffattn_chunkattn_grouped_moe"


def rms_norm(x, g):
    xf = x.astype(jnp.float32)
    y = xf * lax.rsqrt(jnp.mean(xf * xf, axis=-1, keepdims=True) + NORM_EPS)
    return (y * g.astype(jnp.float32)).astype(x.dtype)


def t5_bucket(rel):
    nb = T5_BUCKETS // 2
    ret = jnp.where(rel > 0, nb, 0)
    n = jnp.abs(rel)
    max_exact = nb // 2
    nf = jnp.maximum(n, 1).astype(jnp.float32)
    large = max_exact + (jnp.log(nf / max_exact) / math.log(T5_MAX_DIST / max_exact)
                         * (nb - max_exact)).astype(jnp.int32)
    large = jnp.minimum(large, nb - 1)
    return ret + jnp.where(n < max_exact, n, large)


def diff_attention(h, w_qkv, q_gain, k_gain, lam, subln_g, w_o, t5_bias, lambda_init):
    B, S, D = h.shape
    qkv = h @ w_qkv
    q, k, v = jnp.split(qkv, 3, axis=-1)
    q = q.reshape(B, S, A_HEADS, 2, A_HEAD_DIM)
    k = k.reshape(B, S, A_HEADS, 2, A_HEAD_DIM)
    v = v.reshape(B, S, A_HEADS, A_V_DIM)
    q = rms_norm(q, q_gain) * (A_HEAD_DIM ** -0.5)
    k = rms_norm(k, k_gain)
    lamf = lam.astype(jnp.float32)
    lam_full = (jnp.exp(jnp.sum(lamf[0] * lamf[1])) - jnp.exp(jnp.sum(lamf[2] * lamf[3]))
                + lambda_init)
    n_blocks = S // Q_BLOCK
    q_blocks = q.reshape(B, n_blocks, Q_BLOCK, A_HEADS, 2, A_HEAD_DIM).transpose(1, 0, 2, 3, 4, 5)
    k_pos = jnp.arange(S, dtype=jnp.int32)

    def one_block(args):
        qb, blk = args
        q_pos = blk * Q_BLOCK + jnp.arange(Q_BLOCK, dtype=jnp.int32)
        rel = k_pos[None, :] - q_pos[:, None]
        bias = t5_bias.astype(jnp.float32)[t5_bucket(rel)].transpose(2, 0, 1)
        allowed = (k_pos[None, :] // CHUNK) <= (q_pos[:, None] // CHUNK)
        s = jnp.einsum('bqhmd,bkhmd->bmhqk', qb, k).astype(jnp.float32) + bias[None, None]
        s = jnp.where(allowed[None, None, None], s, NEG_INF)
        p = jax.nn.softmax(s, axis=-1)
        a = p[:, 0] - lam_full * p[:, 1]
        return jnp.einsum('bhqk,bkhe->bqhe', a.astype(v.dtype), v)

    o = lax.map(one_block, (q_blocks, jnp.arange(n_blocks, dtype=jnp.int32)))
    o = o.transpose(1, 0, 2, 3, 4).reshape(B, S, A_HEADS, A_V_DIM)
    o = rms_norm(o, subln_g) * (1.0 - lambda_init)
    return o.reshape(B, S, D) @ w_o


def chunked_attention(h, w_qkv, q_gain, k_gain, rel_bias, w_o):
    B, S, D = h.shape
    NC = S // CHUNK
    qkv = h @ w_qkv
    q, k, v = jnp.split(qkv, 3, axis=-1)
    q = rms_norm(q.reshape(B, S, B_HEADS, B_HEAD_DIM), q_gain) * (B_HEAD_DIM ** -0.5)
    k = rms_norm(k.reshape(B, S, B_HEADS, B_HEAD_DIM), k_gain)
    v = v.reshape(B, S, B_HEADS, B_HEAD_DIM)
    pad = ((0, 0), (LEFT_CHUNKS * CHUNK, 0), (0, 0), (0, 0))
    kp = jnp.pad(k, pad)
    vp = jnp.pad(v, pad)
    qi = jnp.arange(CHUNK, dtype=jnp.int32)
    kb = jnp.arange(BAND, dtype=jnp.int32)
    rel = kb[None, :] - LEFT_CHUNKS * CHUNK - qi[:, None]
    idx = jnp.clip(rel, -MAX_REL, MAX_REL) + MAX_REL
    bias = rel_bias.astype(jnp.float32)[:, idx]
    band_chunk = kb // CHUNK
    q_chunks = q.reshape(B, NC, CHUNK, B_HEADS, B_HEAD_DIM).transpose(1, 0, 2, 3, 4)

    def one_chunk(args):
        qc, ci = args
        kband = lax.dynamic_slice_in_dim(kp, ci * CHUNK, BAND, axis=1)
        vband = lax.dynamic_slice_in_dim(vp, ci * CHUNK, BAND, axis=1)
        valid = (ci - LEFT_CHUNKS + band_chunk) >= 0
        s = jnp.einsum('bqhd,bkhd->bhqk', qc, kband).astype(jnp.float32) + bias[None]
        s = jnp.where(valid[None, None, None, :], s, NEG_INF)
        p = jax.nn.softmax(s, axis=-1)
        return jnp.einsum('bhqk,bkhd->bqhd', p.astype(vband.dtype), vband)

    o = lax.map(one_chunk, (q_chunks, jnp.arange(NC, dtype=jnp.int32)))
    o = o.transpose(1, 0, 2, 3, 4).reshape(B, S, D)
    return o @ w_o


def grouped_moe(h, router_w, router_bias, w_gate, w_up, w_down):
    B, S, D = h.shape
    t = h.reshape(B * S, D)
    scores = jax.nn.sigmoid((t @ router_w).astype(jnp.float32))
    sel = scores + router_bias.astype(jnp.float32)
    grp = sel.reshape(-1, N_GROUPS, E_PER_GROUP)
    group_score = lax.top_k(grp, TOP_K)[0].sum(-1)
    _, g_idx = lax.top_k(group_score, TOPK_GROUPS)
    group_mask = jax.nn.one_hot(g_idx, N_GROUPS, dtype=jnp.float32).sum(1) > 0
    expert_mask = jnp.repeat(group_mask, E_PER_GROUP, axis=1)
    masked = jnp.where(expert_mask, sel, NEG_INF)
    _, e_idx = lax.top_k(masked, TOP_K)
    w = jnp.take_along_axis(scores, e_idx, axis=1)
    w = w / jnp.sum(w, axis=-1, keepdims=True)
    gates = jnp.sum(jax.nn.one_hot(e_idx, N_EXPERTS, dtype=jnp.float32) * w[..., None], axis=1)
    gates = gates.astype(t.dtype)
    out = jnp.zeros_like(t)
    for e in range(N_EXPERTS):
        he = jax.nn.silu(t @ w_gate[e]) * (t @ w_up[e])
        out = out + gates[:, e:e + 1] * (he @ w_down[e])
    return out.reshape(B, S, D)


def setup_inputs(seed: int = 0) -> dict:
    key = jax.random.key(seed)
    ks = jax.random.split(key, 24)
    D, F, E = D_MODEL, D_FF_EXPERT, N_EXPERTS
    nrm = lambda k, shape, s: jax.random.normal(k, shape, jnp.float32) * s
    gain = lambda k, shape: 1.0 + 0.02 * jax.random.normal(k, shape, jnp.float32)
    return {
        "x": nrm(ks[0], (BATCH, SEQ, D), 1.0),
        "c": nrm(ks[1], (BATCH, D), 1.0),
        "ada_w": nrm(ks[2], (DEPTH, D, 6 * D), 0.5 * D ** -0.5),
        "ada_b": nrm(ks[3], (DEPTH, 6 * D), 0.01),
        "norm_mix_g": gain(ks[4], (DEPTH, D)),
        "norm_ffn_g": gain(ks[5], (DEPTH, D)),
        "t5_bias": nrm(ks[6], (T5_BUCKETS, A_HEADS), 0.2),
        "a_w_qkv": nrm(ks[7], (N_LAYERS_A, D, 3 * D), D ** -0.5),
        "a_q_gain": gain(ks[8], (N_LAYERS_A, A_HEAD_DIM)),
        "a_k_gain": gain(ks[9], (N_LAYERS_A, A_HEAD_DIM)),
        "a_lambda": nrm(ks[10], (N_LAYERS_A, 4, A_HEAD_DIM), 0.1),
        "a_subln_g": gain(ks[11], (N_LAYERS_A, A_V_DIM)),
        "a_w_o": nrm(ks[12], (N_LAYERS_A, D, D), D ** -0.5),
        "b_w_qkv": nrm(ks[13], (N_LAYERS_B, D, 3 * D), D ** -0.5),
        "b_q_gain": gain(ks[14], (N_LAYERS_B, B_HEAD_DIM)),
        "b_k_gain": gain(ks[15], (N_LAYERS_B, B_HEAD_DIM)),
        "b_rel_bias": nrm(ks[16], (N_LAYERS_B, B_HEADS, 2 * MAX_REL + 1), 0.2),
        "b_w_o": nrm(ks[17], (N_LAYERS_B, D, D), D ** -0.5),
        "router_w": nrm(ks[18], (D, E), D ** -0.5),
        "router_bias": nrm(ks[19], (E,), 0.01),
        "moe_w_gate": nrm(ks[20], (DEPTH, E, D, F), D ** -0.5),
        "moe_w_up": nrm(ks[21], (DEPTH, E, D, F), D ** -0.5),
        "moe_w_down": nrm(ks[22], (DEPTH, E, F, D), F ** -0.5),
    }


def reference(x, c, ada_w, ada_b, norm_mix_g, norm_ffn_g, t5_bias,
              a_w_qkv, a_q_gain, a_k_gain, a_lambda, a_subln_g, a_w_o,
              b_w_qkv, b_q_gain, b_k_gain, b_rel_bias, b_w_o,
              router_w, router_bias, moe_w_gate, moe_w_up, moe_w_down):
    silu_c = jax.nn.silu(c)
    for i in range(DEPTH):
        mod = silu_c @ ada_w[i] + ada_b[i]
        sh1, sc1, g1, sh2, sc2, g2 = [m[:, None, :] for m in jnp.split(mod, 6, axis=-1)]
        h = rms_norm(x, norm_mix_g[i]) * (1.0 + sc1) + sh1
        if i % N_MIXERS == 0:
            j = i // N_MIXERS
            lambda_init = 0.8 - 0.6 * math.exp(-0.3 * i)
            y = diff_attention(h, a_w_qkv[j], a_q_gain[j], a_k_gain[j], a_lambda[j],
                               a_subln_g[j], a_w_o[j], t5_bias, lambda_init)
        else:
            j = i // N_MIXERS
            y = chunked_attention(h, b_w_qkv[j], b_q_gain[j], b_k_gain[j], b_rel_bias[j], b_w_o[j])
        x = x + g1 * y
        h = rms_norm(x, norm_ffn_g[i]) * (1.0 + sc2) + sh2
        x = x + g2 * grouped_moe(h, router_w, router_bias, moe_w_gate[i], moe_w_up[i], moe_w_down[i])
    return x
```

```cpp
#define FASTMASK 0xFFFFu
#define ONE_LAUNCH 1
#include <hip/hip_runtime.h>
#include <cstdio>
#include <cstdint>

constexpr int BATCH = 2, SEQ = 8192, D = 1024, T = BATCH * SEQ, DEPTH = 2;
constexpr int NE = 16, FF = 512;
constexpr float NORM_EPS = 1e-6f;
constexpr float LOG2E = 1.4426950408889634f;

typedef unsigned short bf16;
__device__ __forceinline__ unsigned f2bf(float f) { unsigned u = __builtin_bit_cast(unsigned, f); return (u + 0x7fffu + ((u >> 16) & 1u)) >> 16; }
__device__ __forceinline__ float bf2f(unsigned h) { return __builtin_bit_cast(float, (h & 0xffffu) << 16); }

constexpr size_t MiB = 1u << 20;
constexpr size_t WS_CTL = 0, CTL_ZERO_BYTES = 1 * MiB;
constexpr size_t WS_MOD = 1 * MiB;
constexpr size_t WS_MISC = WS_MOD + 128 * 1024;
constexpr size_t WS_LTOK = 2 * MiB;
constexpr size_t WS_LW = 4 * MiB;
constexpr size_t WS_WQKV_A = 8 * MiB, WS_WO_A = 14 * MiB, WS_WQKV_B = 16 * MiB, WS_WO_B = 22 * MiB;
constexpr size_t WS_WGU = 24 * MiB, WS_WD = 88 * MiB;
constexpr size_t WS_H = 120 * MiB;
constexpr size_t WS_Q = 152 * MiB, WS_K = 184 * MiB, WS_V = 216 * MiB;
constexpr size_t WS_Y = 152 * MiB;
constexpr size_t WS_HE = 216 * MiB;
constexpr size_t WS_END = 252 * MiB;
constexpr int HE_ROWS = 36864;
constexpr int CW_CNT = 1024;

struct Ptrs {
    const float *x, *c, *ada_w, *ada_b, *norm_mix_g, *norm_ffn_g, *t5_bias, *a_w_qkv, *a_q_gain, *a_k_gain, *a_lambda, *a_subln_g, *a_w_o,
        *b_w_qkv, *b_q_gain, *b_k_gain, *b_rel_bias, *b_w_o, *router_w, *router_bias, *moe_w_gate, *moe_w_up, *moe_w_down;
    float* out; unsigned char* ws;
};

__global__ void __launch_bounds__(256) k_adaln(Ptrs P) {
    __shared__ float sc[2][D];
    for (int i = threadIdx.x; i < 2 * D; i += 256) { const float v = P.c[i]; sc[i / D][i % D] = v / (1.f + __expf(-v)); }
    __syncthreads();
    const int idx = blockIdx.x * 256 + threadIdx.x;
    if (idx >= DEPTH * 6 * D) return;
    const int l = idx / (6 * D), n = idx % (6 * D);
    float a0 = 0.f, a1 = 0.f;
    for (int k = 0; k < D; ++k) { const float w = P.ada_w[((size_t)l * D + k) * (6 * D) + n]; a0 += sc[0][k] * w; a1 += sc[1][k] * w; }
    float* mod = (float*)(P.ws + WS_MOD);
    const float bb = P.ada_b[l * 6 * D + n];
    mod[(l * 2 + 0) * 6 * D + n] = a0 + bb; mod[(l * 2 + 1) * 6 * D + n] = a1 + bb;
    if (idx == 0) {
        float s01 = 0.f, s23 = 0.f;
        for (int d = 0; d < 64; ++d) { s01 += P.a_lambda[d] * P.a_lambda[64 + d]; s23 += P.a_lambda[128 + d] * P.a_lambda[192 + d]; }
        ((float*)(P.ws + WS_MISC))[0] = __expf(s01) - __expf(s23) + 0.2f;
    }
}

__device__ __forceinline__ float block_sum_256(float v, float* red) {
    for (int o = 32; o > 0; o >>= 1) v += __shfl_xor(v, o);
    __syncthreads();
    if ((threadIdx.x & 63) == 0) red[threadIdx.x >> 6] = v;
    __syncthreads();
    return red[0] + red[1] + red[2] + red[3];
}

__global__ void __launch_bounds__(256) k_norm(const float* xin, const float* g, const float* mod_l, int sh_off, int sc_off, bf16* h) {
    __shared__ float red[4];
    const int row = blockIdx.x, b = row / SEQ, t = threadIdx.x;
    const float4 v = ((const float4*)(xin + (size_t)row * D))[t];
    const float ss = block_sum_256(v.x * v.x + v.y * v.y + v.z * v.z + v.w * v.w, red);
    const float inv = rsqrtf(ss * (1.f / D) + NORM_EPS);
    const float* mb = mod_l + b * 6 * D;
    const float4 gg = ((const float4*)g)[t], sc = ((const float4*)(mb + sc_off))[t], sh = ((const float4*)(mb + sh_off))[t];
    const float o0 = v.x * inv * gg.x * (1.f + sc.x) + sh.x, o1 = v.y * inv * gg.y * (1.f + sc.y) + sh.y, o2 = v.z * inv * gg.z * (1.f + sc.z) + sh.z, o3 = v.w * inv * gg.w * (1.f + sc.w) + sh.w;
    uint2 w; w.x = f2bf(o0) | (f2bf(o1) << 16); w.y = f2bf(o2) | (f2bf(o3) << 16);
    ((uint2*)(h + (size_t)row * D))[t] = w;
}

template <class Prob> __global__ void __launch_bounds__(256) k_slow_gemm(Prob pb) {
    __shared__ float As[16][68], Bs[16][68];
    __shared__ float Cs[Prob::NPASS][64][65];
    if (!pb.setup(blockIdx.x)) return;
    const int tid = threadIdx.x, ty = tid >> 4, tx = tid & 15;
    for (int pass = 0; pass < Prob::NPASS; ++pass) {
        float acc[4][4];
#pragma unroll
        for (int i = 0; i < 4; ++i)
#pragma unroll
            for (int j = 0; j < 4; ++j) acc[i][j] = 0.f;
        for (int k0 = 0; k0 < pb.K; k0 += 16) {
            __syncthreads();
#pragma unroll
            for (int i = 0; i < 4; ++i) { const int e = tid + 256 * i; { const int r = e >> 4, k = e & 15; As[k][r] = pb.A(r, k0 + k); } { const int k = e >> 6, c = e & 63; Bs[k][c] = pb.B(pass, k0 + k, c); } }
            __syncthreads();
#pragma unroll
            for (int k = 0; k < 16; ++k) {
                float a[4], b[4];
#pragma unroll
                for (int i = 0; i < 4; ++i) { a[i] = As[k][ty * 4 + i]; b[i] = Bs[k][tx * 4 + i]; }
#pragma unroll
                for (int i = 0; i < 4; ++i)
#pragma unroll
                    for (int j = 0; j < 4; ++j) acc[i][j] += a[i] * b[j];
            }
        }
#pragma unroll
        for (int i = 0; i < 4; ++i)
#pragma unroll
            for (int j = 0; j < 4; ++j) Cs[pass][ty * 4 + i][tx * 4 + j] = acc[i][j];
    }
    __syncthreads();
    pb.epi(Cs, tid);
}

struct ProbQKV {
    static constexpr int NPASS = 1;
    const bf16* H; const float* W; const float* qg; const float* kg; bf16 *Q, *Kb, *V; int K;
    int m0, n0;
    __device__ bool setup(int bx) { m0 = (bx / 48) * 64; n0 = (bx % 48) * 64; return true; }
    __device__ float A(int r, int k) const { return bf2f(H[(size_t)(m0 + r) * D + k]); }
    __device__ float B(int, int k, int c) const { return W[(size_t)k * (3 * D) + n0 + c]; }
    __device__ void epi(float (*Cs)[64][65], int tid) const {
        const int r = tid >> 2, part = tid & 3;
        const int region = n0 / D, col0 = n0 % D;
        float ss = 0.f;
        for (int c = 0; c < 16; ++c) { const float v = Cs[0][r][part * 16 + c]; ss += v * v; }
        ss += __shfl_xor(ss, 1); ss += __shfl_xor(ss, 2);
        const float inv = rsqrtf(ss * (1.f / 64.f) + NORM_EPS);
        bf16* dst = (region == 0 ? Q : region == 1 ? Kb : V) + (size_t)(m0 + r) * D + col0;
        for (int c = 0; c < 16; ++c) { const int cc = part * 16 + c; float v = Cs[0][r][cc];
            if (region == 0) v = v * inv * qg[cc] * (0.125f * LOG2E); else if (region == 1) v = v * inv * kg[cc];
            dst[cc] = (bf16)f2bf(v); }
    }
};

struct ProbWo {
    static constexpr int NPASS = 1;
    const bf16* O; const float* W; const float* xres; const float* gate; float* out; int K;
    int m0, n0;
    __device__ bool setup(int bx) { m0 = (bx / 16) * 64; n0 = (bx % 16) * 64; return true; }
    __device__ float A(int r, int k) const { return bf2f(O[(size_t)(m0 + r) * D + k]); }
    __device__ float B(int, int k, int c) const { return W[(size_t)k * D + n0 + c]; }
    __device__ void epi(float (*Cs)[64][65], int tid) const {
        const int r = tid >> 2, part = tid & 3, row = m0 + r, b = row / SEQ;
        for (int c = 0; c < 16; ++c) { const int col = n0 + part * 16 + c; out[(size_t)row * D + col] = xres[(size_t)row * D + col] + gate[b * 6 * D + col] * Cs[0][r][part * 16 + c]; }
    }
};

__device__ __forceinline__ void expert_bases(const unsigned* cnt  , int e, int& cnt_e, int& base_e) {
    int base = 0, ce = 0;
    for (int i = 0; i < NE; ++i) { const int c = (int)cnt[i * 64]; if (i < e) base += (c + 255) & ~255; if (i == e) ce = c; }
    cnt_e = ce; base_e = base;
}

struct ProbUp {
    static constexpr int NPASS = 2;
    const bf16* H2; const float *Wg, *Wu; const unsigned* cnt; const unsigned* ltok; bf16* he; int K;
    int e, r0, n0, cnt_e, base_e;
    __device__ bool setup(int bx) { n0 = (bx % 8) * 64; const int rt = (bx / 8) % 256; e = bx / (8 * 256); r0 = rt * 64; expert_bases(cnt, e, cnt_e, base_e); return r0 < cnt_e; }
    __device__ float A(int r, int k) const { const int rr = r0 + r; if (rr >= cnt_e) return 0.f; const unsigned tok = ltok[(size_t)e * T + rr] & 0x7fffffffu; return bf2f(H2[(size_t)tok * D + k]); }
    __device__ float B(int pass, int k, int c) const { return (pass == 0 ? Wg : Wu)[((size_t)e * D + k) * FF + n0 + c]; }
    __device__ void epi(float (*Cs)[64][65], int tid) const {
        const int r = tid >> 2, part = tid & 3; if (r0 + r >= cnt_e) return;
        bf16* dst = he + (size_t)(base_e + r0 + r) * FF + n0;
        for (int c = 0; c < 16; ++c) { const int cc = part * 16 + c; const float g = Cs[0][r][cc], u = Cs[1][r][cc]; dst[cc] = (bf16)f2bf(g / (1.f + __expf(-g)) * u); }
    }
};
struct ProbDown {
    static constexpr int NPASS = 1;
    const bf16* he; const float* Wd; const unsigned* cnt; const unsigned* ltok; const float* lw; bf16* ybuf; int K;
    int e, r0, n0, cnt_e, base_e;
    __device__ bool setup(int bx) { n0 = (bx % 16) * 64; const int rt = (bx / 16) % 256; e = bx / (16 * 256); r0 = rt * 64; expert_bases(cnt, e, cnt_e, base_e); return r0 < cnt_e; }
    __device__ float A(int r, int k) const { const int rr = r0 + r; if (rr >= cnt_e) return 0.f; return bf2f(he[(size_t)(base_e + rr) * FF + k]); }
    __device__ float B(int, int k, int c) const { return Wd[((size_t)e * FF + k) * D + n0 + c]; }
    __device__ void epi(float (*Cs)[64][65], int tid) const {
        const int r = tid >> 2, part = tid & 3; if (r0 + r >= cnt_e) return;
        const unsigned tk = ltok[(size_t)e * T + r0 + r]; const float w = lw[(size_t)e * T + r0 + r];
        bf16* dst = ybuf + ((size_t)(tk >> 31) * T + (tk & 0x7fffffffu)) * D + n0;
        for (int c = 0; c < 16; ++c) { const int cc = part * 16 + c; dst[cc] = (bf16)f2bf(w * Cs[0][r][cc]); }
    }
};

__global__ void __launch_bounds__(256) k_norm_route(const float* xin, const float* g, const float* mod_l, int sh_off, int sc_off, bf16* h, const float* rw, const float* rb,
                                                    unsigned* cnt, unsigned* ltok, float* lw) {
    const int lane = threadIdx.x & 63, row = blockIdx.x * 4 + (threadIdx.x >> 6), b = row / SEQ;
    const float* mb = mod_l + b * 6 * D;
    float hv[16]; float ss = 0.f;
#pragma unroll
    for (int j = 0; j < 4; ++j) { const float4 v = ((const float4*)(xin + (size_t)row * D))[lane + 64 * j]; hv[4 * j] = v.x; hv[4 * j + 1] = v.y; hv[4 * j + 2] = v.z; hv[4 * j + 3] = v.w; ss += v.x * v.x + v.y * v.y + v.z * v.z + v.w * v.w; }
    for (int o = 32; o > 0; o >>= 1) ss += __shfl_xor(ss, o);
    const float inv = rsqrtf(ss * (1.f / D) + NORM_EPS);
    float lg[16];
#pragma unroll
    for (int e = 0; e < 16; ++e) lg[e] = 0.f;
#pragma unroll
    for (int j = 0; j < 4; ++j) {
        const int c0 = (lane + 64 * j) * 4;
        const float4 gg = *(const float4*)(g + c0), sc = *(const float4*)(mb + sc_off + c0), sh = *(const float4*)(mb + sh_off + c0);
        hv[4 * j] = hv[4 * j] * inv * gg.x * (1.f + sc.x) + sh.x; hv[4 * j + 1] = hv[4 * j + 1] * inv * gg.y * (1.f + sc.y) + sh.y;
        hv[4 * j + 2] = hv[4 * j + 2] * inv * gg.z * (1.f + sc.z) + sh.z; hv[4 * j + 3] = hv[4 * j + 3] * inv * gg.w * (1.f + sc.w) + sh.w;
        uint2 w; w.x = f2bf(hv[4 * j]) | (f2bf(hv[4 * j + 1]) << 16); w.y = f2bf(hv[4 * j + 2]) | (f2bf(hv[4 * j + 3]) << 16);
        *(uint2*)(h + (size_t)row * D + c0) = w;
#pragma unroll
        for (int i = 0; i < 4; ++i) { const float4* wr = (const float4*)(rw + (size_t)(c0 + i) * NE); const float x = hv[4 * j + i];
#pragma unroll
            for (int q = 0; q < 4; ++q) { const float4 w4 = wr[q]; lg[4 * q] += x * w4.x; lg[4 * q + 1] += x * w4.y; lg[4 * q + 2] += x * w4.z; lg[4 * q + 3] += x * w4.w; } }
    }
#pragma unroll
    for (int e = 0; e < 16; ++e) for (int o = 32; o > 0; o >>= 1) lg[e] += __shfl_xor(lg[e], o);
    if (lane == 0) {
        float sc[16], sel[16];
#pragma unroll
        for (int e = 0; e < 16; ++e) { sc[e] = 1.f / (1.f + __expf(-lg[e])); sel[e] = sc[e] + rb[e]; }
        int bg = 0; float bgs = -3e38f;
#pragma unroll
        for (int gi = 0; gi < 4; ++gi) {
            float m1 = -3e38f, m2 = -3e38f;
#pragma unroll
            for (int i = 0; i < 4; ++i) { const float v = sel[gi * 4 + i]; if (v > m1) { m2 = m1; m1 = v; } else if (v > m2) m2 = v; }
            const float gs = m1 + m2; if (gs > bgs) { bgs = gs; bg = gi; }
        }
        int e0 = 0, e1 = 0; float s0 = -3e38f, s1 = -3e38f, w0 = 0.f, w1 = 0.f;
#pragma unroll
        for (int gi = 0; gi < 4; ++gi) if (gi == bg) {
#pragma unroll
            for (int i = 0; i < 4; ++i) { const int e = gi * 4 + i; const float v = sel[e];
                if (v > s0) { s1 = s0; e1 = e0; w1 = w0; s0 = v; e0 = e; w0 = sc[e]; } else if (v > s1) { s1 = v; e1 = e; w1 = sc[e]; } }
        }
        const float ws = w0 + w1; w0 /= ws; w1 /= ws;
        const unsigned p0 = atomicAdd(&cnt[e0 * 64], 1u), p1 = atomicAdd(&cnt[e1 * 64], 1u);
        ltok[(size_t)e0 * T + p0] = (unsigned)row; lw[(size_t)e0 * T + p0] = w0;
        ltok[(size_t)e1 * T + p1] = (unsigned)row | 0x80000000u; lw[(size_t)e1 * T + p1] = w1;
    }
}

__global__ void __launch_bounds__(256) k_combine(float* xio, const bf16* ybuf, const float* gate  , int do_norm, const float* g, const float* modn, int sh_off, int sc_off, bf16* h) {
    __shared__ float red[4];
    const int row = blockIdx.x, b = row / SEQ, t = threadIdx.x;
    float4 v = ((const float4*)(xio + (size_t)row * D))[t];
    const uint2 y0 = ((const uint2*)(ybuf + (size_t)row * D))[t], y1 = ((const uint2*)(ybuf + ((size_t)T + row) * D))[t];
    const float4 gt = ((const float4*)(gate + b * 6 * D))[t];
    v.x += gt.x * (bf2f(y0.x) + bf2f(y1.x)); v.y += gt.y * (bf2f(y0.x >> 16) + bf2f(y1.x >> 16)); v.z += gt.z * (bf2f(y0.y) + bf2f(y1.y)); v.w += gt.w * (bf2f(y0.y >> 16) + bf2f(y1.y >> 16));
    ((float4*)(xio + (size_t)row * D))[t] = v;
    if (do_norm) {
        const float ss = block_sum_256(v.x * v.x + v.y * v.y + v.z * v.z + v.w * v.w, red);
        const float inv = rsqrtf(ss * (1.f / D) + NORM_EPS);
        const float* mb = modn + b * 6 * D;
        const float4 gg = ((const float4*)g)[t], sc = ((const float4*)(mb + sc_off))[t], sh = ((const float4*)(mb + sh_off))[t];
        const float o0 = v.x * inv * gg.x * (1.f + sc.x) + sh.x, o1 = v.y * inv * gg.y * (1.f + sc.y) + sh.y, o2 = v.z * inv * gg.z * (1.f + sc.z) + sh.z, o3 = v.w * inv * gg.w * (1.f + sc.w) + sh.w;
        uint2 w; w.x = f2bf(o0) | (f2bf(o1) << 16); w.y = f2bf(o2) | (f2bf(o3) << 16);
        ((uint2*)(h + (size_t)row * D))[t] = w;
    }
}

__device__ __forceinline__ int t5_bucket_ref(int rel) {
    const int ret = rel > 0 ? 16 : 0; const int n = rel < 0 ? -rel : rel;
    const float nf = (float)(n < 1 ? 1 : n);
    int large = 8 + (int)(logf(nf / 8.f) / logf(128.f) * 8.f); if (large > 15) large = 15;
    return ret + (n < 8 ? n : large);
}
__device__ __forceinline__ void slow_map(const bf16* Qrow, const bf16* Kcol, const bf16* Vcol, const float* t5h, int qpos, int kend, float (&o)[64]) {
    float q[64];
#pragma unroll
    for (int d = 0; d < 64; ++d) { q[d] = bf2f(Qrow[d]); o[d] = 0.f; }
    float m = -3e38f, l = 0.f;
    for (int j = 0; j < kend; ++j) {
        const uint4* kr = (const uint4*)(Kcol + (size_t)j * D);
        float s = 0.f;
#pragma unroll
        for (int c = 0; c < 8; ++c) { const uint4 kk = kr[c];
            s += q[8 * c] * bf2f(kk.x) + q[8 * c + 1] * bf2f(kk.x >> 16) + q[8 * c + 2] * bf2f(kk.y) + q[8 * c + 3] * bf2f(kk.y >> 16)
               + q[8 * c + 4] * bf2f(kk.z) + q[8 * c + 5] * bf2f(kk.z >> 16) + q[8 * c + 6] * bf2f(kk.w) + q[8 * c + 7] * bf2f(kk.w >> 16); }
        s += t5h[t5_bucket_ref(j - qpos) * 8] * LOG2E;
        const float mn = fmaxf(m, s), a = exp2f(m - mn), p = exp2f(s - mn);
        l = l * a + p; m = mn;
        const uint4* vr = (const uint4*)(Vcol + (size_t)j * D);
#pragma unroll
        for (int c = 0; c < 8; ++c) { const uint4 vv = vr[c];
            o[8 * c] = o[8 * c] * a + p * bf2f(vv.x); o[8 * c + 1] = o[8 * c + 1] * a + p * bf2f(vv.x >> 16); o[8 * c + 2] = o[8 * c + 2] * a + p * bf2f(vv.y); o[8 * c + 3] = o[8 * c + 3] * a + p * bf2f(vv.y >> 16);
            o[8 * c + 4] = o[8 * c + 4] * a + p * bf2f(vv.z); o[8 * c + 5] = o[8 * c + 5] * a + p * bf2f(vv.z >> 16); o[8 * c + 6] = o[8 * c + 6] * a + p * bf2f(vv.w); o[8 * c + 7] = o[8 * c + 7] * a + p * bf2f(vv.w >> 16); }
    }
    const float il = 1.f / l;
#pragma unroll
    for (int d = 0; d < 64; ++d) o[d] *= il;
}
__global__ void __launch_bounds__(64) k_slow_attnA(const bf16* Q, const bf16* Kb, const bf16* Vb, const float* t5, const float* misc, const float* subg, bf16* O) {
    const int blk = blockIdx.x, qt = blk % (SEQ / 32), h = (blk / (SEQ / 32)) % 8, b = blk / (SEQ / 32 * 8);
    const int lane = threadIdx.x, ql = lane >> 1, vh = lane & 1, qpos = qt * 32 + ql; const size_t row = (size_t)b * SEQ + qpos;
    const int kend = (qpos / 64 + 1) * 64;
    float o0[64], o1[64];
    slow_map(Q + row * D + (2 * h) * 64, Kb + (size_t)b * SEQ * D + (2 * h) * 64, Vb + (size_t)b * SEQ * D + h * 128 + vh * 64, t5 + h, qpos, kend, o0);
    slow_map(Q + row * D + (2 * h + 1) * 64, Kb + (size_t)b * SEQ * D + (2 * h + 1) * 64, Vb + (size_t)b * SEQ * D + h * 128 + vh * 64, t5 + h, qpos, kend, o1);
    const float lam = misc[0]; float ss = 0.f;
#pragma unroll
    for (int d = 0; d < 64; ++d) { o0[d] -= lam * o1[d]; ss += o0[d] * o0[d]; }
    ss += __shfl_xor(ss, 1);
    const float inv = rsqrtf(ss * (1.f / 128.f) + NORM_EPS) * 0.8f;
    bf16* dst = O + row * D + h * 128 + vh * 64;
#pragma unroll
    for (int d = 0; d < 64; d += 2) *(unsigned*)(dst + d) = f2bf(o0[d] * inv * subg[vh * 64 + d]) | (f2bf(o0[d + 1] * inv * subg[vh * 64 + d + 1]) << 16);
}
__global__ void __launch_bounds__(64) k_slow_attnB(const bf16* Q, const bf16* Kb, const bf16* Vb, const float* relb, bf16* O) {
    const int blk = blockIdx.x, ci = blk % (SEQ / 64), h = (blk / (SEQ / 64)) % 16, b = blk / (SEQ / 64 * 16);
    const int qpos = ci * 64 + threadIdx.x; const size_t row = (size_t)b * SEQ + qpos;
    const int k0 = ci >= 8 ? (ci - 8) * 64 : 0, kend = (ci + 1) * 64;
    float q[64], o[64];
#pragma unroll
    for (int d = 0; d < 64; ++d) { q[d] = bf2f(Q[row * D + h * 64 + d]); o[d] = 0.f; }
    float m = -3e38f, l = 0.f;
    const bf16* Kc = Kb + (size_t)b * SEQ * D + h * 64; const bf16* Vc = Vb + (size_t)b * SEQ * D + h * 64;
    for (int j = k0; j < kend; ++j) {
        const uint4* kr = (const uint4*)(Kc + (size_t)j * D);
        float s = 0.f;
#pragma unroll
        for (int c = 0; c < 8; ++c) { const uint4 kk = kr[c];
            s += q[8 * c] * bf2f(kk.x) + q[8 * c + 1] * bf2f(kk.x >> 16) + q[8 * c + 2] * bf2f(kk.y) + q[8 * c + 3] * bf2f(kk.y >> 16)
               + q[8 * c + 4] * bf2f(kk.z) + q[8 * c + 5] * bf2f(kk.z >> 16) + q[8 * c + 6] * bf2f(kk.w) + q[8 * c + 7] * bf2f(kk.w >> 16); }
        int rel = j - qpos; rel = rel < -256 ? -256 : (rel > 256 ? 256 : rel);
        s += relb[h * 513 + rel + 256] * LOG2E;
        const float mn = fmaxf(m, s), a = exp2f(m - mn), p = exp2f(s - mn);
        l = l * a + p; m = mn;
        const uint4* vr = (const uint4*)(Vc + (size_t)j * D);
#pragma unroll
        for (int c = 0; c < 8; ++c) { const uint4 vv = vr[c];
            o[8 * c] = o[8 * c] * a + p * bf2f(vv.x); o[8 * c + 1] = o[8 * c + 1] * a + p * bf2f(vv.x >> 16); o[8 * c + 2] = o[8 * c + 2] * a + p * bf2f(vv.y); o[8 * c + 3] = o[8 * c + 3] * a + p * bf2f(vv.y >> 16);
            o[8 * c + 4] = o[8 * c + 4] * a + p * bf2f(vv.z); o[8 * c + 5] = o[8 * c + 5] * a + p * bf2f(vv.z >> 16); o[8 * c + 6] = o[8 * c + 6] * a + p * bf2f(vv.w); o[8 * c + 7] = o[8 * c + 7] * a + p * bf2f(vv.w >> 16); }
    }
    const float il = 1.f / l;
    bf16* dst = O + row * D + h * 64;
#pragma unroll
    for (int d = 0; d < 64; d += 2) *(unsigned*)(dst + d) = f2bf(o[d] * il) | (f2bf(o[d + 1] * il) << 16);
}

#define GAS __attribute__((address_space(1)))
#define LAS __attribute__((address_space(3)))
typedef unsigned v4u __attribute__((ext_vector_type(4)));
typedef unsigned v2u __attribute__((ext_vector_type(2)));
typedef float f32x4 __attribute__((ext_vector_type(4)));
typedef float f32x16 __attribute__((ext_vector_type(16)));
typedef short bf16x8 __attribute__((ext_vector_type(8)));
typedef short s16x4 __attribute__((ext_vector_type(4)));
typedef GAS unsigned gu32;
#define RLX_AGENT __ATOMIC_RELAXED, __HIP_MEMORY_SCOPE_AGENT
#define LDS_WAIT() asm volatile("s_waitcnt lgkmcnt(0)" ::: "memory")
#define VM_WAIT() asm volatile("s_waitcnt vmcnt(0)" ::: "memory")

constexpr int NWAVES = 8;
constexpr int RING_BYTES = 131072;
constexpr int LDSCTL_OFF = RING_BYTES, MISC_OFF = LDSCTL_OFF + 320;
constexpr int TAB_OFF = RING_BYTES + 1024;
constexpr int LDS_BYTES = 147456;
constexpr int CW_BAR = 4096;

__device__ __forceinline__ unsigned cvt_pk_bf16(float lo, float hi) { unsigned r; asm volatile("v_cvt_pk_bf16_f32 %0, %1, %2" : "=v"(r) : "v"(lo), "v"(hi)); return r; }
__device__ __forceinline__ float wave_sum(float v) {
#pragma unroll
    for (int o = 1; o < 64; o <<= 1) v += __shfl_xor(v, o);
    return v;
}

#define XB_TMO      128
#define XB_XCNT(j)  (256  + 64 * (j))
#define XB_XSUB(j)  (1280 + 64 * (j))
#define XB_XGEN(j)  (2304 + 64 * (j))
#define XB_TOP      3328
#define XB_TOPGEN   3392
#define XCD_BAR_WORDS 3456
#define XB_SPIN_CAP (1u << 18)
__device__ __forceinline__ unsigned xb_ld(unsigned* p)              { return __hip_atomic_load(p, __ATOMIC_RELAXED, __HIP_MEMORY_SCOPE_AGENT); }
__device__ __forceinline__ unsigned xb_add(unsigned* p, unsigned v) { return __hip_atomic_fetch_add(p, v, __ATOMIC_RELAXED, __HIP_MEMORY_SCOPE_AGENT); }
__device__ __forceinline__ unsigned xb_xcc_id() { return (unsigned)__builtin_amdgcn_s_getreg((3 << 11) | 20) & 0xFu; }
#define XB_SPIN(cond, bar) do { unsigned _sp = 0; while (cond) { __builtin_amdgcn_s_sleep(1); \
    if ((++_sp & 255u) == 0u) { if (xb_ld(&(bar)[XB_TMO])) break; if (_sp > XB_SPIN_CAP) { atomicAdd(&(bar)[XB_TMO], 1u); break; } } } } while (0)
struct XcdBarrier { unsigned* bar; unsigned x; volatile LAS unsigned* st; };
__device__ __forceinline__ XcdBarrier xcd_barrier_post(unsigned* bar, volatile LAS unsigned* st) {
    XcdBarrier b; b.bar = bar; b.x = xb_xcc_id(); b.st = st;
    if (threadIdx.x == 0) (void)xb_add(&bar[XB_XCNT(b.x)], 1u);
    return b;
}
__device__ __forceinline__ void xcd_barrier_complete(unsigned* bar, unsigned x, unsigned& nloc, unsigned& nx) {
    const unsigned G = gridDim.x * gridDim.y * gridDim.z;
    unsigned sum, cnt, mine, sp = 0u;
    for (;;) {
        sum = 0u; cnt = 0u; mine = 0u;
#pragma unroll
        for (unsigned j = 0; j < 16; ++j) { const unsigned c = xb_ld(&bar[XB_XCNT(j)]); sum += c; cnt += (c > 0u) ? 1u : 0u; mine = (j == x) ? c : mine; }
        if (sum == G) break;
        __builtin_amdgcn_s_sleep(1);
        if ((++sp & 255u) == 0u) { if (xb_ld(&bar[XB_TMO])) break; if (sp > XB_SPIN_CAP) { atomicAdd(&bar[XB_TMO], 1u); break; } }
    }
    nloc = mine > 0u ? mine : 1u; nx = cnt > 0u ? cnt : 1u;
}
__device__ __forceinline__ void xcd_barrier(const XcdBarrier& b) {
    asm volatile("s_waitcnt vmcnt(0)" ::: "memory");
    __syncthreads();
    if (threadIdx.x == 0) {
        unsigned* bar = b.bar;
        __builtin_amdgcn_s_waitcnt(0);
        unsigned nloc = b.st[0], nx = b.st[1];
        if (nloc == 0u) { xcd_barrier_complete(bar, b.x, nloc, nx); b.st[0] = nloc; b.st[1] = nx; }
        const unsigned old = xb_add(&bar[XB_XSUB(b.x)], 1u);
        const unsigned gen = old / nloc;
        if (old + 1u == (gen + 1u) * nloc) {
            __builtin_amdgcn_fence(__ATOMIC_RELEASE, "agent");
            asm volatile("s_waitcnt vmcnt(0)" ::: "memory");
            const unsigned og = xb_add(&bar[XB_TOP], 1u);
            const unsigned tg = og / nx;
            if (og + 1u == (tg + 1u) * nx) xb_add(&bar[XB_TOPGEN], 1u);
            else XB_SPIN(xb_ld(&bar[XB_TOPGEN]) == tg, bar);
            __builtin_amdgcn_fence(__ATOMIC_ACQUIRE, "agent");
            xb_add(&bar[XB_XGEN(b.x)], 1u);
            asm volatile("s_waitcnt vmcnt(0)" ::: "memory");
        } else {
            XB_SPIN(xb_ld(&bar[XB_XGEN(b.x)]) == gen, bar);
            __builtin_amdgcn_fence(__ATOMIC_ACQUIRE, "agent");
            asm volatile("s_waitcnt vmcnt(0)" ::: "memory");
        }
    }
    __syncthreads();
}

namespace g8 {
constexpr int BM = 256, BK = 64, HALF = 128, HTB = HALF * BK * 2, STAGE_BYTES = 8 * HTB;
__host__ __device__ __forceinline__ int lds_byte(int r, int c) { const int st = (r >> 4) * 2 + (c >> 5), rr = r & 15, cc = c & 31, ob = rr * 64 + cc * 2; return st * 1024 + (ob ^ (((ob >> 9) & 1) << 5)); }
__host__ __device__ __forceinline__ void stage_rc(int b, int& R, int& C) { const int st = b / 1024, sb = b % 1024, swz = sb ^ (((sb >> 9) & 1) << 5); R = (st >> 1) * 16 + swz / 64; C = (st & 1) * 32 + (swz % 64) / 2; }
__host__ __device__ __forceinline__ int perm32(int rho) { const int n = rho >> 4, i = rho & 15; return 8 * (i >> 2) + 4 * n + (i & 3); }

struct Unit { int arow0, brow0, orow0, pn, lidx, nvalid; };

struct DenseOrder {
    int nM, nN, nwg, G, c;
    __device__ void init(int M, int N, int G_, int c_) { nM = M / BM; nN = N / BM; nwg = nM * nN; G = G_; c = c_; }
    __device__ __forceinline__ bool next(int i, Unit& u) const {
        const long L = (long)i * G + c; if (L >= nwg) return false;
        int wgid = (int)L; { const int q = nwg / 8, r = nwg % 8, xcd = wgid % 8, off = wgid / 8; wgid = (xcd < r ? xcd * (q + 1) : r * (q + 1) + (xcd - r) * q) + off; }
        const int nig = 8 * nN, gid = wgid / nig, fm = gid * 8, gsz = (nM - fm) < 8 ? (nM - fm) : 8;
        const int pm = fm + ((wgid % nig) % gsz), pn = (wgid % nig) / gsz;
        u.arow0 = pm * BM; u.orow0 = pm * BM; u.brow0 = pn * BM; u.pn = pn; u.lidx = 0; u.nvalid = BM; return true;
    }
    __device__ __forceinline__ void aoffs(const Unit& u, int K, unsigned (&o)[4]) const {
#pragma unroll
        for (int i = 0; i < 2; ++i) { int R, C; stage_rc((int)threadIdx.x * 16 + i * 8192, R, C);
#pragma unroll
            for (int h = 0; h < 2; ++h) o[h * 2 + i] = (unsigned)((u.arow0 + h * HALF + R) * K + C) * 2u; }
    }
};
template <bool GATHER> struct MoeOrder {
    const LAS unsigned* tab; const unsigned* ltok; int G, c;
    __device__ __forceinline__ bool next(int i, Unit& u) const {
        const int L = i * G + c; const int ntile = (int)__builtin_amdgcn_readfirstlane(tab[0]);
        if (L >= ntile * 4) return false;
        const int rt = L >> 2, pn = L & 3; const unsigned w = __builtin_amdgcn_readfirstlane(tab[1 + rt]); const int e = (int)(w & 255u), ti = (int)(w >> 8);
        const int base = (int)__builtin_amdgcn_readfirstlane(tab[160 + e]), cnt = (int)__builtin_amdgcn_readfirstlane(tab[176 + e]);
        u.lidx = e * T + ti * BM; u.orow0 = base + ti * BM; u.arow0 = base + ti * BM; u.brow0 = e * 1024 + pn * BM; u.pn = pn; u.nvalid = (cnt - ti * BM) < BM ? (cnt - ti * BM) : BM; return true;
    }
    __device__ __forceinline__ void aoffs(const Unit& u, int K, unsigned (&o)[4]) const {
#pragma unroll
        for (int i = 0; i < 2; ++i) { int R, C; stage_rc((int)threadIdx.x * 16 + i * 8192, R, C);
#pragma unroll
            for (int h = 0; h < 2; ++h) {
                int row;
                if (GATHER) { int r = h * HALF + R; if (r >= u.nvalid) r = 0; row = (int)(ltok[u.lidx + r] & 0x7fffffffu); }
                else row = u.arow0 + h * HALF + R;
                o[h * 2 + i] = (unsigned)(row * K + C) * 2u; } }
    }
};

struct EpiQKV {
    static constexpr bool PERM = true;
    bf16* Q; size_t stride; const float *qg, *kg;
    __device__ __forceinline__ void operator()(const f32x4 (&acc)[2][2][4][2], const Unit& u, int wr, int wc, int fr, int fq) const {
        const int region = u.pn >> 2, colt = (u.pn & 3) * BM;
        bf16* base = Q + (size_t)region * stride;
        const bool nrm = region < 2;
        const float* gp = (region == 0) ? qg : kg; const float gs = (region == 0) ? 0.125f * LOG2E : 1.f;
        f32x4 gv[2][2];
#pragma unroll
        for (int bj = 0; bj < 2; ++bj)
#pragma unroll
            for (int n = 0; n < 2; ++n) { gv[bj][n] = (f32x4){1.f, 1.f, 1.f, 1.f}; if (nrm) gv[bj][n] = *(const f32x4*)(gp + 32 * bj + 8 * fq + 4 * n) * gs; }
#pragma unroll
        for (int ai = 0; ai < 2; ++ai)
#pragma unroll
            for (int m = 0; m < 4; ++m) {
                const int row = u.orow0 + ai * HALF + wr * 64 + m * 16 + fr;
                float ss = 0.f;
#pragma unroll
                for (int bj = 0; bj < 2; ++bj)
#pragma unroll
                    for (int n = 0; n < 2; ++n) { const f32x4 x = acc[ai][bj][m][n]; ss += (x[0] * x[0] + x[1] * x[1]) + (x[2] * x[2] + x[3] * x[3]); }
                ss += __shfl_xor(ss, 16); ss += __shfl_xor(ss, 32);
                const float inv = nrm ? rsqrtf(ss * (1.f / 64.f) + NORM_EPS) : 1.f;
                bf16* rowp = base + (size_t)row * D + colt + 64 * wc + 8 * fq;
#pragma unroll
                for (int bj = 0; bj < 2; ++bj) { const f32x4 v0 = acc[ai][bj][m][0] * gv[bj][0] * inv, v1 = acc[ai][bj][m][1] * gv[bj][1] * inv;
                    v4u w; w.x = cvt_pk_bf16(v0[0], v0[1]); w.y = cvt_pk_bf16(v0[2], v0[3]); w.z = cvt_pk_bf16(v1[0], v1[1]); w.w = cvt_pk_bf16(v1[2], v1[3]);
                    *(v4u*)(rowp + 32 * bj) = w; }
            }
    }
};
struct EpiWo {
    static constexpr bool PERM = false;
    const float* xres; const float* gate; float* out;
    __device__ __forceinline__ void operator()(const f32x4 (&acc)[2][2][4][2], const Unit& u, int wr, int wc, int fr, int fq) const {
        const int b = u.orow0 / SEQ; const int col0 = u.pn * BM + wc * 32 + 4 * fq;
        f32x4 gt[2][2];
#pragma unroll
        for (int bj = 0; bj < 2; ++bj)
#pragma unroll
            for (int n = 0; n < 2; ++n) gt[bj][n] = *(const f32x4*)(gate + b * 6 * D + col0 + bj * HALF + n * 16);
#pragma unroll
        for (int ai = 0; ai < 2; ++ai)
#pragma unroll
            for (int m = 0; m < 4; ++m) { const size_t off = (size_t)(u.orow0 + ai * HALF + wr * 64 + m * 16 + fr) * D + col0;
#pragma unroll
                for (int bj = 0; bj < 2; ++bj)
#pragma unroll
                    for (int n = 0; n < 2; ++n) { const f32x4 xr = *(const f32x4*)(xres + off + bj * HALF + n * 16); *(f32x4*)(out + off + bj * HALF + n * 16) = xr + gt[bj][n] * acc[ai][bj][m][n]; }
                if (m & 1) asm volatile("" ::: "memory"); }
    }
};
struct EpiUp {
    static constexpr bool PERM = true;
    bf16* he;
    __device__ __forceinline__ void operator()(const f32x4 (&acc)[2][2][4][2], const Unit& u, int wr, int wc, int fr, int fq) const {
#pragma unroll
        for (int ai = 0; ai < 2; ++ai)
#pragma unroll
            for (int m = 0; m < 4; ++m) { const int row = u.orow0 + ai * HALF + wr * 64 + m * 16 + fr;
                f32x4 v[2];
#pragma unroll
                for (int n = 0; n < 2; ++n)
#pragma unroll
                    for (int i = 0; i < 4; ++i) { const float g = acc[ai][0][m][n][i], up = acc[ai][1][m][n][i]; v[n][i] = g * __builtin_amdgcn_rcpf(1.f + __builtin_amdgcn_exp2f(-g * LOG2E)) * up; }
                v4u w; w.x = cvt_pk_bf16(v[0][0], v[0][1]); w.y = cvt_pk_bf16(v[0][2], v[0][3]); w.z = cvt_pk_bf16(v[1][0], v[1][1]); w.w = cvt_pk_bf16(v[1][2], v[1][3]);
                *(v4u*)(he + (size_t)row * FF + u.pn * HALF + 32 * wc + 8 * fq) = w; }
    }
};
struct EpiDown {
    static constexpr bool PERM = true;
    const unsigned* ltok; const float* lw; bf16* ybuf;
    __device__ __forceinline__ void operator()(const f32x4 (&acc)[2][2][4][2], const Unit& u, int wr, int wc, int fr, int fq) const {
#pragma unroll
        for (int ai = 0; ai < 2; ++ai)
#pragma unroll
            for (int m = 0; m < 4; ++m) { const int r = ai * HALF + wr * 64 + m * 16 + fr;
                if (r < u.nvalid) { const unsigned tk = ltok[u.lidx + r]; const float w = lw[u.lidx + r];
                    bf16* dst = ybuf + ((size_t)(tk >> 31) * T + (tk & 0x7fffffffu)) * D + u.pn * BM + 32 * wc + 8 * fq;
#pragma unroll
                    for (int bj = 0; bj < 2; ++bj) { const f32x4 v0 = acc[ai][bj][m][0] * w, v1 = acc[ai][bj][m][1] * w;
                        v4u o; o.x = cvt_pk_bf16(v0[0], v0[1]); o.y = cvt_pk_bf16(v0[2], v0[3]); o.z = cvt_pk_bf16(v1[0], v1[1]); o.w = cvt_pk_bf16(v1[2], v1[3]);
                        *(v4u*)(dst + bj * HALF) = o; } } }
    }
};

template <class Epi, class Sched>
__device__ __forceinline__ void gemm_phase(LAS unsigned char* lds, const bf16* A, const bf16* Bt, const int K, const Sched& S, const Epi& E) {
    const int tid = threadIdx.x, wid = __builtin_amdgcn_readfirstlane(tid >> 6), lane = tid & 63, wr = wid >> 2, wc = wid & 3, fr = lane & 15, fq = lane >> 4;
    const int nt = K / BK;
    unsigned voffB[2];
#pragma unroll
    for (int i = 0; i < 2; ++i) { int R, C; stage_rc(tid * 16 + i * 8192, R, C); const int Rb = Epi::PERM ? ((R & ~31) + perm32(R & 31)) : R; voffB[i] = (unsigned)(Rb * K + C) * 2u; }
    const size_t kstep = (size_t)(BK * 2);
    const size_t hstep = (size_t)HALF * K * 2;
    const unsigned ldsw = (unsigned)wid * 1024u;
    const int aoff = lds_byte(wr * 64 + fr, fq * 8), boff = lds_byte(wc * 32 + fr, fq * 8);
#define G8_SA(b, h) (((b) * 2 + (h)) * HTB)
#define G8_SB(b, h) ((4 + (b) * 2 + (h)) * HTB)
#define G8_STAGE_B(bufoff, gbase) do { _Pragma("unroll") for (int _i = 0; _i < 2; ++_i) \
        __builtin_amdgcn_global_load_lds((const unsigned*)((const char*)(gbase) + voffB[_i]), (LAS unsigned*)(lds + (bufoff) + ldsw + _i * 8192), 16, 0, 0); } while (0)
#define G8_STAGE_A(bufoff, kt, offs, h) do { _Pragma("unroll") for (int _i = 0; _i < 2; ++_i) \
        __builtin_amdgcn_global_load_lds((const unsigned*)((const char*)A + (size_t)(kt) * kstep + (offs)[(h) * 2 + _i]), (LAS unsigned*)(lds + (bufoff) + ldsw + _i * 8192), 16, 0, 0); } while (0)
#define G8_LDA(dst, b, h) do { _Pragma("unroll") for (int m = 0; m < 4; ++m) _Pragma("unroll") for (int k = 0; k < 2; ++k) dst[m][k] = *(const LAS bf16x8*)(lds + G8_SA(b, h) + aoff + m * 2048 + k * 1024); } while (0)
#define G8_LDB(dst, b, h) do { _Pragma("unroll") for (int n = 0; n < 2; ++n) _Pragma("unroll") for (int k = 0; k < 2; ++k) dst[n][k] = *(const LAS bf16x8*)(lds + G8_SB(b, h) + boff + n * 2048 + k * 1024); } while (0)
#define G8_MMA(ai, bj, At, Bt_) do { __builtin_amdgcn_s_setprio(1); _Pragma("unroll") for (int m = 0; m < 4; ++m) _Pragma("unroll") for (int n = 0; n < 2; ++n) _Pragma("unroll") for (int k = 0; k < 2; ++k) \
        acc[ai][bj][m][n] = __builtin_amdgcn_mfma_f32_16x16x32_bf16(Bt_[n][k], At[m][k], acc[ai][bj][m][n], 0, 0, 0); __builtin_amdgcn_s_setprio(0); } while (0)
#define G8_WAIT_V(n) asm volatile("s_waitcnt vmcnt(" #n ")" ::: "memory")
#define G8_WAIT_L(n) asm volatile("s_waitcnt lgkmcnt(" #n ")" ::: "memory")
#define G8_BAR __builtin_amdgcn_s_barrier()
#define G8_SCHED __builtin_amdgcn_sched_barrier(0)
    Unit cur, nxt; int ui = 0;
    if (!S.next(0, cur)) return;
    f32x4 acc[2][2][4][2];
#pragma unroll
    for (int a = 0; a < 2; ++a)
#pragma unroll
        for (int b = 0; b < 2; ++b)
#pragma unroll
            for (int m = 0; m < 4; ++m)
#pragma unroll
                for (int n = 0; n < 2; ++n) acc[a][b][m][n] = (f32x4){0.f, 0.f, 0.f, 0.f};
    bf16x8 At[4][2], B0[2][2], B1[2][2];
    unsigned offc[4], offn[4];
    S.aoffs(cur, K, offc);
    const char* cB = (const char*)Bt + (size_t)cur.brow0 * K * 2;
    G8_STAGE_B(G8_SB(0, 0), cB); G8_STAGE_B(G8_SB(0, 1), cB + hstep); G8_STAGE_A(G8_SA(0, 0), 0, offc, 0); G8_STAGE_A(G8_SA(0, 1), 0, offc, 1);
    if (wr == 1) G8_BAR;
    G8_WAIT_V(2); G8_BAR;
    G8_STAGE_B(G8_SB(1, 0), cB + kstep); G8_STAGE_A(G8_SA(1, 0), 1, offc, 0); G8_STAGE_B(G8_SB(1, 1), cB + hstep + kstep);
    G8_WAIT_V(6); G8_BAR;
    for (;;) {
        const bool has_next = S.next(ui + 1, nxt);
        if (has_next) S.aoffs(nxt, K, offn); else {
#pragma unroll
            for (int j = 0; j < 4; ++j) offn[j] = offc[j]; }
        const char* nB = has_next ? (const char*)Bt + (size_t)nxt.brow0 * K * 2 : cB;
        for (int t = 0; t < nt; t += 2) {
            const bool last = (t == nt - 2);
            const int kt2 = last ? 0 : t + 2;
            unsigned o2[4];
#pragma unroll
            for (int j = 0; j < 4; ++j) o2[j] = last ? offn[j] : offc[j];
            const char* b2 = last ? nB : cB + (size_t)(t + 2) * kstep; const char* b3 = b2 + kstep;
            G8_LDB(B0, 0, 0); G8_LDB(B1, 0, 1); G8_SCHED; G8_LDA(At, 0, 0); G8_STAGE_A(G8_SA(1, 1), t + 1, offc, 1);
            G8_WAIT_V(8); G8_WAIT_L(0); G8_BAR; G8_MMA(0, 0, At, B0); G8_MMA(0, 1, At, B1); G8_BAR; G8_SCHED;
            G8_LDA(At, 0, 1); G8_STAGE_B(G8_SB(0, 0), b2); G8_STAGE_B(G8_SB(0, 1), b2 + hstep); G8_STAGE_A(G8_SA(0, 0), kt2, o2, 0);
            G8_WAIT_V(8); G8_WAIT_L(0); G8_BAR; G8_MMA(1, 0, At, B0); G8_MMA(1, 1, At, B1); G8_BAR; G8_SCHED;
            G8_LDB(B0, 1, 0); G8_LDB(B1, 1, 1); G8_SCHED; G8_LDA(At, 1, 0); G8_STAGE_A(G8_SA(0, 1), kt2, o2, 1);
            G8_WAIT_V(8); G8_WAIT_L(0); G8_BAR; G8_MMA(0, 0, At, B0); G8_MMA(0, 1, At, B1); G8_BAR; G8_SCHED;
            G8_LDA(At, 1, 1); G8_STAGE_B(G8_SB(1, 0), b3); G8_STAGE_B(G8_SB(1, 1), b3 + hstep); G8_STAGE_A(G8_SA(1, 0), kt2 + 1, o2, 0);
            G8_WAIT_V(8); G8_WAIT_L(0); G8_BAR; G8_MMA(1, 0, At, B0); G8_MMA(1, 1, At, B1); G8_BAR; G8_SCHED;
        }
        if (wr == 0) G8_BAR;
        E(acc, cur, wr, wc, fr, fq);
        if (!has_next) break;
#pragma unroll
        for (int a = 0; a < 2; ++a)
#pragma unroll
            for (int b = 0; b < 2; ++b)
#pragma unroll
                for (int m = 0; m < 4; ++m)
#pragma unroll
                    for (int n = 0; n < 2; ++n) acc[a][b][m][n] = (f32x4){0.f, 0.f, 0.f, 0.f};
        cur = nxt; cB = nB; ++ui;
#pragma unroll
        for (int j = 0; j < 4; ++j) offc[j] = offn[j];
        if (wr == 1) G8_BAR;
    }
    G8_WAIT_V(0);
    G8_BAR;
#undef G8_SA
#undef G8_SB
#undef G8_STAGE_A
#undef G8_STAGE_B
#undef G8_LDA
#undef G8_LDB
#undef G8_MMA
#undef G8_WAIT_V
#undef G8_WAIT_L
#undef G8_BAR
#undef G8_SCHED
}
}
namespace att {
__device__ __forceinline__ int crow(int r, int hi) { return (r & 3) + 8 * (r >> 2) + 4 * hi; }
__device__ __forceinline__ void glds16(const void* gsrc, unsigned lds_dst) { unsigned keep;
    asm volatile("s_mov_b32 %0, m0\n\ts_mov_b32 m0, %2\n\ts_nop 0\n\tglobal_load_lds_dwordx4 %1, off\n\ts_mov_b32 m0, %0" : "=&s"(keep) : "v"(gsrc), "s"(lds_dst) : "memory"); }
typedef LAS const char* lds_cptr;
typedef short v4i16_t __attribute__((ext_vector_type(4)));
__device__ __forceinline__ s16x4 vtr(lds_cptr p) { return __builtin_bit_cast(s16x4, __builtin_amdgcn_ds_read_tr16_b64_v4i16((LAS v4i16_t*)p)); }
__device__ __forceinline__ float swap_add(float v) { auto rr = __builtin_amdgcn_permlane32_swap(__float_as_uint(v), __float_as_uint(v), false, false); return __uint_as_float(rr[0]) + __uint_as_float(rr[1]); }
#define ATT_WAIT_BAR(N) asm volatile("s_waitcnt vmcnt(" #N ") lgkmcnt(0)\n\ts_barrier" ::: "memory")

template <int MIX>
__device__ __forceinline__ void attn_unit(int b, int h, int blk, const bf16* Q, const bf16* __restrict__ K, const bf16* __restrict__ V, bf16* O, LAS unsigned char* lds, const float* tabg, float lam, const float* subg) {
    constexpr int KC = MIX == 0 ? 128 : 64, DV = KC, NDB = DV / 32, SLOT = KC * 128, NP = MIX == 0 ? 2 : 1;
    constexpr int TABN = MIX == 0 ? 768 : 416, OFFS = MIX == 0 ? 704 : 352, FARREL = MIX == 0 ? -559 : -256;
    constexpr int LDS_K = 0, LDS_V = 3 * SLOT, LDS_T = 6 * SLOT;
    const int tid = threadIdx.x, lane = tid & 63, r32 = lane & 31, hi = lane >> 5; const int wid = __builtin_amdgcn_readfirstlane(tid >> 6);
    int map, rb, R0, T_lo, T_hi, ci, w_lo;
    if (MIX == 0) { map = wid >> 2; rb = wid & 3; R0 = blk * 128; ci = 2 * blk + (rb >> 1); T_lo = 0; T_hi = 2 * blk + 1; w_lo = 0; }
    else { map = 0; rb = wid; R0 = blk * 256; ci = 4 * blk + (rb >> 1); T_lo = 4 * blk - 8 > 0 ? 4 * blk - 8 : 0; T_hi = 4 * blk + 3; w_lo = ci - 8 > 0 ? ci - 8 : 0; }
    const int w_hi = ci, qrow0 = R0 + 32 * rb;
    const size_t rowbase = (size_t)b * SEQ;
    const int hcol = h * KC, qcol = hcol + map * 64;
    const unsigned lds0 = (unsigned)(uintptr_t)lds;
    LAS float* tab = (LAS float*)(lds + LDS_T);
    for (int i = tid; i < TABN; i += NWAVES * 64) tab[i] = tabg[h * TABN + i];
    bf16x8 qr[4];
#pragma unroll
    for (int d0 = 0; d0 < 4; ++d0) qr[d0] = *(const bf16x8*)(Q + (rowbase + qrow0 + r32) * D + qcol + d0 * 16 + hi * 8);
    asm volatile("s_waitcnt vmcnt(0)" ::: "memory");
#pragma unroll
    for (int d0 = 0; d0 < 4; ++d0) asm volatile("" : "+v"(qr[d0]));
    const bf16* ksrc[NP]; const bf16* vsrc[NP]; unsigned kdst[NP], vdst[NP];
#pragma unroll
    for (int j = 0; j < NP; ++j) { const int p = wid + 8 * j;
        ksrc[j] = K + (rowbase + lane) * D + hcol + p * 8; kdst[j] = lds0 + LDS_K + p * 1024;
        vsrc[j] = V + (rowbase + 16 * (p & 3) + (lane >> 2)) * D + hcol + 32 * (p >> 2) + 8 * (lane & 3); vdst[j] = lds0 + LDS_V + p * 1024; }
#define ATT_ISSUE(t, slot) do { _Pragma("unroll") for (int j_ = 0; j_ < NP; ++j_) { \
        glds16(ksrc[j_] + (size_t)(t) * 64 * D, (unsigned)__builtin_amdgcn_readfirstlane(kdst[j_] + (slot))); \
        glds16(vsrc[j_] + (size_t)(t) * 64 * D, (unsigned)__builtin_amdgcn_readfirstlane(vdst[j_] + (slot))); } } while (0)
    const lds_cptr kp0 = (lds_cptr)lds + LDS_K + (map * 8 + hi) * 1024 + r32 * 16;
    const lds_cptr vp0 = (lds_cptr)lds + LDS_V + ((lane >> 4) & 1) * 32 + (lane & 3) * 8 + (4 * hi + ((lane & 15) >> 2)) * 64;
    f32x16 o[NDB];
#pragma unroll
    for (int i = 0; i < NDB; ++i) o[i] = f32x16{};
    float lsum = 0.f;
    ATT_ISSUE(T_lo, 0); if (T_lo + 1 <= T_hi) ATT_ISSUE(T_lo + 1, SLOT);
    int sl = 0;
    for (int t = T_lo; t <= T_hi; ++t) {
        if (t < T_hi) { if (NP == 2) ATT_WAIT_BAR(4); else ATT_WAIT_BAR(2); } else ATT_WAIT_BAR(0);
        if (t + 2 <= T_hi) { const int s2 = sl >= SLOT ? sl - SLOT : sl + 2 * SLOT; ATT_ISSUE(t + 2, s2); }
        if (t >= w_lo && t <= w_hi) {
            f32x16 p0, p1;
            const int maxrel = 64 * t + 63 - qrow0;
            if (maxrel > FARREL) { const LAS float* tp = tab + (64 * t + 4 * hi - (qrow0 + r32) + OFFS);
#pragma unroll
                for (int r = 0; r < 16; ++r) { p0[r] = tp[(r & 3) + 8 * (r >> 2)]; p1[r] = tp[32 + (r & 3) + 8 * (r >> 2)]; } }
            else { p0 = f32x16{}; p1 = f32x16{}; }
            const lds_cptr kp = kp0 + sl;
#pragma unroll
            for (int d0 = 0; d0 < 4; ++d0) { const bf16x8 k0 = *(const LAS bf16x8*)(kp + d0 * 2048), k1 = *(const LAS bf16x8*)(kp + d0 * 2048 + 512);
                p0 = __builtin_amdgcn_mfma_f32_32x32x16_bf16(k0, qr[d0], p0, 0, 0, 0); p1 = __builtin_amdgcn_mfma_f32_32x32x16_bf16(k1, qr[d0], p1, 0, 0, 0); }
            float sa = 0.f, sb = 0.f;
#pragma unroll
            for (int r = 0; r < 16; ++r) { p0[r] = __builtin_amdgcn_exp2f(p0[r]); p1[r] = __builtin_amdgcn_exp2f(p1[r]); sa += p0[r]; sb += p1[r]; }
            lsum += sa + sb;
            v4u pw[4];
            pw[0] = (v4u){cvt_pk_bf16(p0[0], p0[1]), cvt_pk_bf16(p0[2], p0[3]), cvt_pk_bf16(p0[4], p0[5]), cvt_pk_bf16(p0[6], p0[7])};
            pw[1] = (v4u){cvt_pk_bf16(p0[8], p0[9]), cvt_pk_bf16(p0[10], p0[11]), cvt_pk_bf16(p0[12], p0[13]), cvt_pk_bf16(p0[14], p0[15])};
            pw[2] = (v4u){cvt_pk_bf16(p1[0], p1[1]), cvt_pk_bf16(p1[2], p1[3]), cvt_pk_bf16(p1[4], p1[5]), cvt_pk_bf16(p1[6], p1[7])};
            pw[3] = (v4u){cvt_pk_bf16(p1[8], p1[9]), cvt_pk_bf16(p1[10], p1[11]), cvt_pk_bf16(p1[12], p1[13]), cvt_pk_bf16(p1[14], p1[15])};
            const lds_cptr vp = vp0 + sl;
#pragma unroll
            for (int db = 0; db < NDB; ++db)
#pragma unroll
                for (int s = 0; s < 4; ++s) { const s16x4 lo = vtr(vp + db * 4096 + s * 1024), hh = vtr(vp + db * 4096 + s * 1024 + 512);
                    const bf16x8 vf = (bf16x8){lo[0], lo[1], lo[2], lo[3], hh[0], hh[1], hh[2], hh[3]};
                    o[db] = __builtin_amdgcn_mfma_f32_32x32x16_bf16(vf, __builtin_bit_cast(bf16x8, pw[s]), o[db], 0, 0, 0); }
        }
        sl = sl == 2 * SLOT ? 0 : sl + SLOT;
    }
    const float l = swap_add(lsum);
    const size_t orow = (rowbase + qrow0 + r32) * D;
    if (MIX == 0) {
        const float f = (map == 0 ? 1.f : -lam) / l;
        ATT_WAIT_BAR(0);
        LAS float* X = (LAS float*)lds + rb * 4096 + lane;
        if (map == 1) {
#pragma unroll
            for (int db = 0; db < NDB; ++db)
#pragma unroll
                for (int r = 0; r < 16; ++r) X[(db * 16 + r) * 64] = o[db][r] * f; }
        ATT_WAIT_BAR(0);
        if (map == 0) { float ss = 0.f;
#pragma unroll
            for (int db = 0; db < NDB; ++db)
#pragma unroll
                for (int r = 0; r < 16; ++r) { const float v = o[db][r] * f + X[(db * 16 + r) * 64]; o[db][r] = v; ss += v * v; }
            ss = swap_add(ss);
            const float inv = rsqrtf(ss * (1.f / 128.f) + NORM_EPS) * 0.8f;
#pragma unroll
            for (int db = 0; db < NDB; ++db)
#pragma unroll
                for (int g = 0; g < 4; ++g) { const int d = 32 * db + 8 * g + 4 * hi; const f32x4 sg = *(const f32x4*)(subg + d);
                    v2u w; w.x = cvt_pk_bf16(o[db][4 * g] * inv * sg[0], o[db][4 * g + 1] * inv * sg[1]); w.y = cvt_pk_bf16(o[db][4 * g + 2] * inv * sg[2], o[db][4 * g + 3] * inv * sg[3]);
                    *(v2u*)(O + orow + h * 128 + d) = w; } }
        ATT_WAIT_BAR(0);
    } else {
        const float f = 1.f / l;
#pragma unroll
        for (int db = 0; db < NDB; ++db)
#pragma unroll
            for (int g = 0; g < 4; ++g) { const int d = 32 * db + 8 * g + 4 * hi;
                v2u w; w.x = cvt_pk_bf16(o[db][4 * g] * f, o[db][4 * g + 1] * f); w.y = cvt_pk_bf16(o[db][4 * g + 2] * f, o[db][4 * g + 3] * f);
                *(v2u*)(O + orow + h * 64 + d) = w; }
        ATT_WAIT_BAR(0);
    }
#undef ATT_ISSUE
}
#undef ATT_WAIT_BAR
}

struct Args { Ptrs P; int ph_lo, ph_hi; };
struct Frame { LAS unsigned char* lds; volatile LAS unsigned* MISC; gu32* ctl; int tid, lane, wave, vcu, G; };

__device__ __forceinline__ void norm_row(const float* xrow, const float* g, const float* mb, int sh_off, int sc_off, bf16* hrow, int lane) {
    f32x4 v[4]; float ss = 0.f;
#pragma unroll
    for (int j = 0; j < 4; ++j) { v[j] = ((const f32x4*)xrow)[lane + 64 * j]; ss += (v[j][0] * v[j][0] + v[j][1] * v[j][1]) + (v[j][2] * v[j][2] + v[j][3] * v[j][3]); }
    const float inv = rsqrtf(wave_sum(ss) * (1.f / D) + NORM_EPS);
#pragma unroll
    for (int j = 0; j < 4; ++j) { const int c0 = (lane + 64 * j) * 4;
        const f32x4 gg = *(const f32x4*)(g + c0), sc = *(const f32x4*)(mb + sc_off + c0), sh = *(const f32x4*)(mb + sh_off + c0);
        const f32x4 o = v[j] * inv * gg * (sc + 1.f) + sh;
        v2u w; w.x = cvt_pk_bf16(o[0], o[1]); w.y = cvt_pk_bf16(o[2], o[3]); *(v2u*)(hrow + c0) = w; }
}
__device__ __forceinline__ void route_row(int row, const float* xin, const float* g, const float* mb, int sh_off, int sc_off, bf16* h, const float* rw, const float* rb, unsigned* cnt, unsigned* ltok, float* lw, int lane) {
    float hv[16]; float ss = 0.f;
#pragma unroll
    for (int j = 0; j < 4; ++j) { const f32x4 v = ((const f32x4*)(xin + (size_t)row * D))[lane + 64 * j]; hv[4 * j] = v[0]; hv[4 * j + 1] = v[1]; hv[4 * j + 2] = v[2]; hv[4 * j + 3] = v[3]; ss += (v[0] * v[0] + v[1] * v[1]) + (v[2] * v[2] + v[3] * v[3]); }
    const float inv = rsqrtf(wave_sum(ss) * (1.f / D) + NORM_EPS);
    float lg[16];
#pragma unroll
    for (int e = 0; e < 16; ++e) lg[e] = 0.f;
#pragma unroll
    for (int j = 0; j < 4; ++j) {
        const int c0 = (lane + 64 * j) * 4;
        const f32x4 gg = *(const f32x4*)(g + c0), sc = *(const f32x4*)(mb + sc_off + c0), sh = *(const f32x4*)(mb + sh_off + c0);
#pragma unroll
        for (int i = 0; i < 4; ++i) hv[4 * j + i] = hv[4 * j + i] * inv * gg[i] * (1.f + sc[i]) + sh[i];
        v2u w; w.x = cvt_pk_bf16(hv[4 * j], hv[4 * j + 1]); w.y = cvt_pk_bf16(hv[4 * j + 2], hv[4 * j + 3]);
        *(v2u*)(h + (size_t)row * D + c0) = w;
#pragma unroll
        for (int i = 0; i < 4; ++i) { const f32x4* wr = (const f32x4*)(rw + (size_t)(c0 + i) * NE); const float x = hv[4 * j + i];
#pragma unroll
            for (int q = 0; q < 4; ++q) { const f32x4 w4 = wr[q]; lg[4 * q] += x * w4[0]; lg[4 * q + 1] += x * w4[1]; lg[4 * q + 2] += x * w4[2]; lg[4 * q + 3] += x * w4[3]; } }
    }
#pragma unroll
    for (int e = 0; e < 16; ++e) lg[e] = wave_sum(lg[e]);
    if (lane == 0) {
        float sc[16], sel[16];
#pragma unroll
        for (int e = 0; e < 16; ++e) { sc[e] = 1.f / (1.f + __expf(-lg[e])); sel[e] = sc[e] + rb[e]; }
        int bg = 0; float bgs = -3e38f;
#pragma unroll
        for (int gi = 0; gi < 4; ++gi) {
            float m1 = -3e38f, m2 = -3e38f;
#pragma unroll
            for (int i = 0; i < 4; ++i) { const float v = sel[gi * 4 + i]; if (v > m1) { m2 = m1; m1 = v; } else if (v > m2) m2 = v; }
            const float gs = m1 + m2; if (gs > bgs) { bgs = gs; bg = gi; }
        }
        int e0 = 0, e1 = 0; float s0 = -3e38f, s1 = -3e38f, w0 = 0.f, w1 = 0.f;
#pragma unroll
        for (int gi = 0; gi < 4; ++gi) if (gi == bg) {
#pragma unroll
            for (int i = 0; i < 4; ++i) { const int e = gi * 4 + i; const float v = sel[e];
                if (v > s0) { s1 = s0; e1 = e0; w1 = w0; s0 = v; e0 = e; w0 = sc[e]; } else if (v > s1) { s1 = v; e1 = e; w1 = sc[e]; } }
        }
        const float ws = w0 + w1; w0 /= ws; w1 /= ws;
        const unsigned p0 = atomicAdd(&cnt[e0 * 64], 1u), p1 = atomicAdd(&cnt[e1 * 64], 1u);
        ltok[(size_t)e0 * T + p0] = (unsigned)row; lw[(size_t)e0 * T + p0] = w0;
        ltok[(size_t)e1 * T + p1] = (unsigned)row | 0x80000000u; lw[(size_t)e1 * T + p1] = w1;
    }
}
__device__ __forceinline__ void combine_row(int row, float* xio, const bf16* ybuf, const float* gate, bool do_norm, const float* g, const float* mbn, bf16* h, int lane) {
    f32x4 v[4]; float ss = 0.f;
#pragma unroll
    for (int j = 0; j < 4; ++j) { const int c0 = (lane + 64 * j) * 4;
        v[j] = *(const f32x4*)(xio + (size_t)row * D + c0);
        const v2u y0 = *(const v2u*)(ybuf + (size_t)row * D + c0), y1 = *(const v2u*)(ybuf + ((size_t)T + row) * D + c0);
        const f32x4 gt = *(const f32x4*)(gate + c0);
        v[j][0] += gt[0] * (bf2f(y0.x) + bf2f(y1.x)); v[j][1] += gt[1] * (bf2f(y0.x >> 16) + bf2f(y1.x >> 16)); v[j][2] += gt[2] * (bf2f(y0.y) + bf2f(y1.y)); v[j][3] += gt[3] * (bf2f(y0.y >> 16) + bf2f(y1.y >> 16));
        *(f32x4*)(xio + (size_t)row * D + c0) = v[j];
        ss += (v[j][0] * v[j][0] + v[j][1] * v[j][1]) + (v[j][2] * v[j][2] + v[j][3] * v[j][3]); }
    if (do_norm) {
        const float inv = rsqrtf(wave_sum(ss) * (1.f / D) + NORM_EPS);
#pragma unroll
        for (int j = 0; j < 4; ++j) { const int c0 = (lane + 64 * j) * 4;
            const f32x4 gg = *(const f32x4*)(g + c0), sc = *(const f32x4*)(mbn + D + c0), sh = *(const f32x4*)(mbn + c0);
            const f32x4 o = v[j] * inv * gg * (sc + 1.f) + sh;
            v2u w; w.x = cvt_pk_bf16(o[0], o[1]); w.y = cvt_pk_bf16(o[2], o[3]); *(v2u*)(h + (size_t)row * D + c0) = w; }
    }
}

template <class RowMap>
__device__ __forceinline__ void transpose_item(const float* W, int K, int N, bf16* WT, RowMap rm, LAS float* scr, int item, int lane) {
    const int nblk = N / 32, kb = item / nblk, nb = item % nblk, k0 = 64 * kb, n0 = 32 * nb;
#pragma unroll 8
    for (int i = 0; i < 32; ++i) { const int kk = 2 * i + (lane >> 5); scr[kk * 33 + (lane & 31)] = W[(size_t)(k0 + kk) * N + n0 + (lane & 31)]; }
    LDS_WAIT(); asm volatile("" ::: "memory");
    const int c = lane & 7;
#pragma unroll
    for (int j = 0; j < 4; ++j) { const int n = (lane >> 3) + 8 * j; const LAS float* s = scr + (8 * c) * 33 + n;
        v4u o; o.x = cvt_pk_bf16(s[0 * 33], s[1 * 33]); o.y = cvt_pk_bf16(s[2 * 33], s[3 * 33]); o.z = cvt_pk_bf16(s[4 * 33], s[5 * 33]); o.w = cvt_pk_bf16(s[6 * 33], s[7 * 33]);
        *(v4u*)(WT + (size_t)rm(n0 + n) * K + k0 + 8 * c) = o; }
    LDS_WAIT(); asm volatile("" ::: "memory");
}
struct RmId { __device__ __forceinline__ int operator()(int n) const { return n; } };
struct RmQkv { __device__ __forceinline__ int operator()(int n) const { return (n & ~255) + 128 * ((n >> 5) & 1) + 32 * ((n >> 6) & 3) + (n & 31); } };
struct RmGU { int add; __device__ __forceinline__ int operator()(int n) const { return 256 * (n >> 7) + (n & 127) + add; } };

__device__ __forceinline__ int t5_bucket_fast(int rel) {
    const int ret = rel > 0 ? 16 : 0; const int n = rel < 0 ? -rel : rel;
    const int large = 8 + (n >= 15) + (n >= 27) + (n >= 50) + (n >= 91) + (n >= 166) + (n >= 305) + (n >= 559);
    return ret + (n < 8 ? n : large);
}
constexpr int TABA_N = 768, TABB_N = 416;
constexpr int MISC_TABA = 64, MISC_TABB = MISC_TABA + 8 * TABA_N;

__device__ __forceinline__ void p0_prologue(Frame& F, const Ptrs& P) {
    const int gw = F.vcu * NWAVES + F.wave, NGW = F.G * NWAVES, lane = F.lane;
    float* mod = (float*)(P.ws + WS_MOD); float* misc = (float*)(P.ws + WS_MISC);
    for (int it = gw; it < DEPTH * 384; it += NGW) {
        const int l = it / 384, n0 = (it % 384) * 16, kq = lane >> 2, cq = lane & 3;
        f32x4 a0 = {0.f, 0.f, 0.f, 0.f}, a1 = {0.f, 0.f, 0.f, 0.f};
#pragma unroll 8
        for (int i = 0; i < 64; ++i) { const int k = kq + 16 * i; const f32x4 w4 = *(const f32x4*)(P.ada_w + ((size_t)l * D + k) * (6 * D) + n0 + 4 * cq);
            const float c0 = P.c[k], c1 = P.c[D + k]; const float s0 = c0 / (1.f + __expf(-c0)), s1 = c1 / (1.f + __expf(-c1)); a0 += w4 * s0; a1 += w4 * s1; }
#pragma unroll
        for (int o = 4; o < 64; o <<= 1)
#pragma unroll
            for (int i = 0; i < 4; ++i) { a0[i] += __shfl_xor(a0[i], o); a1[i] += __shfl_xor(a1[i], o); }
        if (kq == 0) { const f32x4 bb = *(const f32x4*)(P.ada_b + l * 6 * D + n0 + 4 * cq);
            *(f32x4*)(mod + (l * 2 + 0) * 6 * D + n0 + 4 * cq) = a0 + bb; *(f32x4*)(mod + (l * 2 + 1) * 6 * D + n0 + 4 * cq) = a1 + bb; }
    }
    if (gw == NGW - 1 && lane == 0) { float s01 = 0.f, s23 = 0.f;
        for (int d = 0; d < 64; ++d) { s01 += P.a_lambda[d] * P.a_lambda[64 + d]; s23 += P.a_lambda[128 + d] * P.a_lambda[192 + d]; }
        misc[0] = __expf(s01) - __expf(s23) + 0.2f; }
    for (int i = gw * 64 + lane; i < 8 * TABA_N + 16 * TABB_N; i += NGW * 64) {
        if (i < 8 * TABA_N) { const int h = i / TABA_N, rel = i % TABA_N - 704; misc[MISC_TABA + i] = (P.t5_bias[t5_bucket_fast(rel) * 8 + h] - P.t5_bias[15 * 8 + h]) * LOG2E; }
        else { const int j = i - 8 * TABA_N, h = j / TABB_N; int rel = j % TABB_N - 352; rel = rel < -256 ? -256 : (rel > 256 ? 256 : rel);
            misc[MISC_TABB + j] = (P.b_rel_bias[h * 513 + rel + 256] - P.b_rel_bias[h * 513]) * LOG2E; }
    }
    LAS float* scr = (LAS float*)(F.lds + F.wave * 16384);
    constexpr int I_QKV = 16 * 96, I_WO = 16 * 32, I_E = 256, I_DENSE = 2 * (I_QKV + I_WO), NITEMS = I_DENSE + DEPTH * NE * 3 * I_E;
    for (int it = gw; it < NITEMS; it += NGW) {
        int r = it;
        if (r < I_QKV) { transpose_item(P.a_w_qkv, D, 3 * D, (bf16*)(P.ws + WS_WQKV_A), RmQkv{}, scr, r, lane); continue; } r -= I_QKV;
        if (r < I_WO) { transpose_item(P.a_w_o, D, D, (bf16*)(P.ws + WS_WO_A), RmId{}, scr, r, lane); continue; } r -= I_WO;
        if (r < I_QKV) { transpose_item(P.b_w_qkv, D, 3 * D, (bf16*)(P.ws + WS_WQKV_B), RmQkv{}, scr, r, lane); continue; } r -= I_QKV;
        if (r < I_WO) { transpose_item(P.b_w_o, D, D, (bf16*)(P.ws + WS_WO_B), RmId{}, scr, r, lane); continue; } r -= I_WO;
        const int le = r / (3 * I_E), which = (r / I_E) % 3, item = r % I_E;
        if (which == 0) transpose_item(P.moe_w_gate + (size_t)le * D * FF, D, FF, (bf16*)(P.ws + WS_WGU) + (size_t)le * 1024 * D, RmGU{0}, scr, item, lane);
        else if (which == 1) transpose_item(P.moe_w_up + (size_t)le * D * FF, D, FF, (bf16*)(P.ws + WS_WGU) + (size_t)le * 1024 * D, RmGU{128}, scr, item, lane);
        else transpose_item(P.moe_w_down + (size_t)le * FF * D, FF, D, (bf16*)(P.ws + WS_WD) + (size_t)le * D * FF, RmId{}, scr, item, lane);
    }
}

__device__ __forceinline__ void moe_prep(Frame& F, const unsigned* cnt) {
    LAS unsigned* tab = (LAS unsigned*)(F.lds + TAB_OFF);
    if (F.tid == 0) { int rt = 0, base = 0;
        for (int e = 0; e < NE; ++e) { const int c = (int)cnt[e * 64]; const int ntl = (c + 255) >> 8; tab[160 + e] = (unsigned)base; tab[176 + e] = (unsigned)c;
            for (int i = 0; i < ntl; ++i) tab[1 + rt + i] = (unsigned)e | ((unsigned)i << 8);
            rt += ntl; base += ntl * 256; }
        tab[0] = (unsigned)rt; }
    __syncthreads();
}

#ifndef DBG_EN
#define DBG_EN 0x1FFu
#endif
#define EN(j) ((DBG_EN >> (j)) & 1u)
#define IN(k) (lo <= (k) && (k) < hi)
#define SEAM(k) do { if (IN(k) && IN((k) + 1)) xcd_barrier(bar); } while (0)
template <int l>
__device__ __forceinline__ void run_layer(Frame& F, const Ptrs& P, const XcdBarrier& bar, const int lo, const int hi) {
    unsigned char* ws = P.ws;
    float* mod = (float*)(ws + WS_MOD); const float* misc = (const float*)(ws + WS_MISC);
    bf16 *H = (bf16*)(ws + WS_H), *Qb = (bf16*)(ws + WS_Q), *Kb = (bf16*)(ws + WS_K), *Vb = (bf16*)(ws + WS_V), *Y = (bf16*)(ws + WS_Y), *HE = (bf16*)(ws + WS_HE);
    const int gw = F.vcu * NWAVES + F.wave, NGW = F.G * NWAVES;
    {
        const int pb = 2 + 7 * l;
        const float* mod_l = mod + l * 2 * 6 * D;
        const float* xin = (l == 0) ? P.x : P.out;
        if (EN(2) && IN(pb + 0)) {
            g8::DenseOrder S; S.init(T, 3 * D, F.G, (int)blockIdx.x);
            g8::EpiQKV E{Qb, (size_t)(WS_K - WS_Q) / 2, l == 0 ? P.a_q_gain : P.b_q_gain, l == 0 ? P.a_k_gain : P.b_k_gain};
            g8::gemm_phase(F.lds, H, (const bf16*)(ws + (l == 0 ? WS_WQKV_A : WS_WQKV_B)), D, S, E);
        } SEAM(pb + 0);
        if (EN(3) && IN(pb + 1)) {
            if (l == 0) {
                const float lam = misc[0];
                if (F.G == 256) { const int bh = F.vcu >> 4, s = F.vcu & 15;
                    for (int i = 0; i < 4; ++i) { const int qb = (i == 0) ? s : (i == 1) ? 31 - s : (i == 2) ? 32 + s : 63 - s; att::attn_unit<0>(bh >> 3, bh & 7, qb, Qb, Kb, Vb, Qb, F.lds, misc + MISC_TABA, lam, P.a_subln_g); } }
                else for (int u = (int)blockIdx.x; u < 1024; u += F.G) att::attn_unit<0>(u >> 9, (u >> 6) & 7, u & 63, Qb, Kb, Vb, Qb, F.lds, misc + MISC_TABA, lam, P.a_subln_g);
            } else {
                if (F.G == 256) { const int bh = F.vcu >> 3;
                    for (int i = 0; i < 4; ++i) att::attn_unit<1>(bh >> 4, bh & 15, (F.vcu & 7) * 4 + i, Qb, Kb, Vb, Qb, F.lds, misc + MISC_TABB, 0.f, nullptr); }
                else for (int u = (int)blockIdx.x; u < 1024; u += F.G) att::attn_unit<1>(u >> 9, (u >> 5) & 15, u & 31, Qb, Kb, Vb, Qb, F.lds, misc + MISC_TABB, 0.f, nullptr);
            }
        } SEAM(pb + 1);
        if (EN(4) && IN(pb + 2)) {
            g8::DenseOrder S; S.init(T, D, F.G, (int)blockIdx.x);
            g8::EpiWo E{xin, mod_l + 2 * D, P.out};
            g8::gemm_phase(F.lds, Qb, (const bf16*)(ws + (l == 0 ? WS_WO_A : WS_WO_B)), D, S, E);
        } SEAM(pb + 2);
        unsigned* cnt = (unsigned*)(F.ctl + CW_CNT + l * 16 * 64); unsigned* ltok = (unsigned*)(ws + WS_LTOK) + (size_t)l * NE * T; float* lw = (float*)(ws + WS_LW) + (size_t)l * NE * T;
        if (EN(5) && IN(pb + 3)) {
            for (int row = gw; row < T; row += NGW) route_row(row, P.out, P.norm_ffn_g + l * D, mod_l + (row / SEQ) * 6 * D, 3 * D, 4 * D, H, P.router_w, P.router_bias, cnt, ltok, lw, F.lane);
        } SEAM(pb + 3);
        if (EN(6) && IN(pb + 4)) {
            moe_prep(F, cnt);
            g8::MoeOrder<true> S{(const LAS unsigned*)(F.lds + TAB_OFF), ltok, F.G, (int)blockIdx.x};
            g8::EpiUp E{HE};
            g8::gemm_phase(F.lds, H, (const bf16*)(ws + WS_WGU) + (size_t)l * NE * 1024 * D, D, S, E);
        } SEAM(pb + 4);
        if (EN(7) && IN(pb + 5)) {
            moe_prep(F, cnt);
            g8::MoeOrder<false> S{(const LAS unsigned*)(F.lds + TAB_OFF), ltok, F.G, (int)blockIdx.x};
            g8::EpiDown E{ltok, lw, Y};
            g8::gemm_phase(F.lds, HE, (const bf16*)(ws + WS_WD) + (size_t)l * NE * D * FF, FF, S, E);
        } SEAM(pb + 5);
        if (EN(8) && IN(pb + 6)) {
            const bool dn = (l + 1 < DEPTH);
            for (int row = gw; row < T; row += NGW) combine_row(row, P.out, Y, mod_l + (row / SEQ) * 6 * D + 5 * D, dn, P.norm_mix_g + (dn ? (l + 1) : 0) * D, mod + ((dn ? (l + 1) : 0) * 2 + row / SEQ) * 6 * D, H, F.lane);
        } SEAM(pb + 6);
    }
}
__global__ void __launch_bounds__(NWAVES * 64, 2) mk_fwd(Args args) {
    extern __shared__ __attribute__((aligned(16))) unsigned char lds[];
    Frame F;
    F.lds = (LAS unsigned char*)lds; F.MISC = (volatile LAS unsigned*)(F.lds + MISC_OFF);
    F.tid = threadIdx.x; F.lane = F.tid & 63; F.wave = __builtin_amdgcn_readfirstlane(F.tid >> 6);
    F.G = gridDim.x; { const int bx = blockIdx.x; F.vcu = (F.G % 8 == 0) ? (bx % 8) * (F.G / 8) + bx / 8 : bx; }
    const Ptrs& P = args.P;
    unsigned char* ws = P.ws;
    F.ctl = (gu32*)(ws + WS_CTL);
    for (int u = F.tid; u < (LDS_BYTES - LDSCTL_OFF) / 4; u += NWAVES * 64) ((LAS unsigned*)(F.lds + LDSCTL_OFF))[u] = 0u;
    __syncthreads();
    const int lo = args.ph_lo, hi = args.ph_hi;
    const bool multi = (hi - lo) > 1;
    XcdBarrier bar; bar.bar = (unsigned*)(F.ctl + CW_BAR); bar.x = 0; bar.st = nullptr;
    if (multi) bar = xcd_barrier_post((unsigned*)(F.ctl + CW_BAR), F.MISC + 8);
    float* mod = (float*)(ws + WS_MOD); const float* misc = (const float*)(ws + WS_MISC);
    bf16 *H = (bf16*)(ws + WS_H), *Qb = (bf16*)(ws + WS_Q), *Kb = (bf16*)(ws + WS_K), *Vb = (bf16*)(ws + WS_V), *Y = (bf16*)(ws + WS_Y), *HE = (bf16*)(ws + WS_HE);
    const int gw = F.vcu * NWAVES + F.wave, NGW = F.G * NWAVES;

    if (EN(0) && IN(0)) { p0_prologue(F, P); } SEAM(0);
    if (EN(1) && IN(1)) { for (int row = gw; row < T; row += NGW) norm_row(P.x + (size_t)row * D, P.norm_mix_g, mod + (row / SEQ) * 6 * D, 0, D, H + (size_t)row * D, F.lane); } SEAM(1);

    run_layer<0>(F, P, bar, lo, hi);
    run_layer<1>(F, P, bar, lo, hi);
#undef IN
#undef SEAM
}
#ifndef FASTMASK
#define FASTMASK 0xFFFFu
#endif
#ifndef ONE_LAUNCH
#define ONE_LAUNCH 1
#endif
extern "C" void kernel_launch(void* const* d_in, const int* in_sizes, int n_in, void* d_out, int out_size, void* d_ws, size_t ws_size, hipStream_t stream) {
    static int grid = 0;
    if (grid == 0) {
        if (n_in != 23 || out_size != T * D || ws_size < WS_END) { fprintf(stderr, "kernel_launch: unexpected shapes (n_in %d out %d ws %zu)\n", n_in, out_size, ws_size); grid = -1; return; }
        int dev = 0, cus = 0, per_cu = 0;
        if (hipGetDevice(&dev) != hipSuccess || hipDeviceGetAttribute(&cus, hipDeviceAttributeMultiprocessorCount, dev) != hipSuccess) { grid = -1; return; }
        if (hipFuncSetAttribute((const void*)mk_fwd, hipFuncAttributeMaxDynamicSharedMemorySize, LDS_BYTES) != hipSuccess) { fprintf(stderr, "kernel_launch: hipFuncSetAttribute failed\n"); grid = -1; return; }
        if (hipOccupancyMaxActiveBlocksPerMultiprocessor(&per_cu, (const void*)mk_fwd, NWAVES * 64, LDS_BYTES) != hipSuccess || per_cu < 1) fprintf(stderr, "kernel_launch: occupancy query reports %d\n", per_cu);
        (void)hipGetLastError();
        grid = cus;
    }
    if (grid < 0) return;
    Args a{};
    const float** pp = (const float**)&a.P;
    for (int i = 0; i < 23; ++i) pp[i] = (const float*)d_in[i];
    a.P.out = (float*)d_out; a.P.ws = (unsigned char*)d_ws;
    const Ptrs& P = a.P;
    unsigned char* ws = P.ws;
    (void)hipMemsetAsync(ws + WS_CTL, 0, CTL_ZERO_BYTES, stream);
#if ONE_LAUNCH
    a.ph_lo = 0; a.ph_hi = 16;
    hipLaunchKernelGGL(mk_fwd, dim3(grid), dim3(NWAVES * 64), LDS_BYTES, stream, a);
#else
    float* mod = (float*)(ws + WS_MOD); float* misc = (float*)(ws + WS_MISC);
    bf16 *H = (bf16*)(ws + WS_H), *Q = (bf16*)(ws + WS_Q), *Kb = (bf16*)(ws + WS_K), *V = (bf16*)(ws + WS_V), *Y = (bf16*)(ws + WS_Y), *HE = (bf16*)(ws + WS_HE);
    unsigned* ctl = (unsigned*)(ws + WS_CTL);
#define FAST(p) ((FASTMASK >> (p)) & 1u)
#define RUNFAST(p) do { a.ph_lo = (p); a.ph_hi = (p) + 1; hipLaunchKernelGGL(mk_fwd, dim3(grid), dim3(NWAVES * 64), LDS_BYTES, stream, a); } while (0)
    if (FASTMASK != 0u) RUNFAST(0);
    if (!FAST(0)) k_adaln<<<(DEPTH * 6 * D + 255) / 256, 256, 0, stream>>>(P);
    if (FAST(1)) RUNFAST(1); else k_norm<<<T, 256, 0, stream>>>(P.x, P.norm_mix_g, mod, 0, D, H);
    for (int l = 0; l < DEPTH; ++l) {
        const int pb = 2 + 7 * l;
        const float* mod_l = mod + l * 2 * 6 * D;
        const float* xin = (l == 0) ? P.x : P.out;
        if (FAST(pb + 0)) RUNFAST(pb + 0); else { ProbQKV pq{H, l == 0 ? P.a_w_qkv : P.b_w_qkv, l == 0 ? P.a_q_gain : P.b_q_gain, l == 0 ? P.a_k_gain : P.b_k_gain, Q, Kb, V, D, 0, 0}; k_slow_gemm<ProbQKV><<<(T / 64) * 48, 256, 0, stream>>>(pq); }
        if (FAST(pb + 1)) RUNFAST(pb + 1); else { if (l == 0) k_slow_attnA<<<BATCH * 8 * (SEQ / 32), 64, 0, stream>>>(Q, Kb, V, P.t5_bias, misc, P.a_subln_g, Q); else k_slow_attnB<<<BATCH * 16 * (SEQ / 64), 64, 0, stream>>>(Q, Kb, V, P.b_rel_bias, Q); }
        if (FAST(pb + 2)) RUNFAST(pb + 2); else { ProbWo pw{Q, l == 0 ? P.a_w_o : P.b_w_o, xin, mod_l + 2 * D, P.out, D, 0, 0}; k_slow_gemm<ProbWo><<<(T / 64) * 16, 256, 0, stream>>>(pw); }
        unsigned* cnt = ctl + CW_CNT + l * 16 * 64; unsigned* ltok = (unsigned*)(ws + WS_LTOK) + (size_t)l * NE * T; float* lw = (float*)(ws + WS_LW) + (size_t)l * NE * T;
        if (FAST(pb + 3)) RUNFAST(pb + 3); else k_norm_route<<<T / 4, 256, 0, stream>>>(P.out, P.norm_ffn_g + l * D, mod_l, 3 * D, 4 * D, H, P.router_w, P.router_bias, cnt, ltok, lw);
        if (FAST(pb + 4)) RUNFAST(pb + 4); else { ProbUp pu{H, P.moe_w_gate + (size_t)l * NE * D * FF, P.moe_w_up + (size_t)l * NE * D * FF, cnt, ltok, HE, D, 0, 0, 0, 0, 0}; k_slow_gemm<ProbUp><<<NE * 256 * 8, 256, 0, stream>>>(pu); }
        if (FAST(pb + 5)) RUNFAST(pb + 5); else { ProbDown pd{HE, P.moe_w_down + (size_t)l * NE * FF * D, cnt, ltok, lw, Y, FF, 0, 0, 0, 0, 0}; k_slow_gemm<ProbDown><<<NE * 256 * 16, 256, 0, stream>>>(pd); }
        const int nl = l + 1;
        if (FAST(pb + 6)) RUNFAST(pb + 6); else k_combine<<<T, 256, 0, stream>>>(P.out, Y, mod_l + 5 * D, nl < DEPTH ? 1 : 0, P.norm_mix_g + (nl < DEPTH ? nl : 0) * D, mod + (nl < DEPTH ? nl : 0) * 2 * 6 * D, 0, D, H);
    }
#endif
}
```

```cpp
#define FASTMASK 0xFFFFu
#define ONE_LAUNCH 1
#include <hip/hip_runtime.h>
#include <cstdio>
#include <cstdint>

constexpr int BATCH = 2, SEQ = 8192, D = 1024, T = BATCH * SEQ, DEPTH = 2;
constexpr int NE = 16, FF = 512;
constexpr float NORM_EPS = 1e-6f;
constexpr float LOG2E = 1.4426950408889634f;

typedef unsigned short bf16;
__device__ __forceinline__ unsigned f2bf(float f) { unsigned u = __builtin_bit_cast(unsigned, f); return (u + 0x7fffu + ((u >> 16) & 1u)) >> 16; }
__device__ __forceinline__ float bf2f(unsigned h) { return __builtin_bit_cast(float, (h & 0xffffu) << 16); }

constexpr size_t MiB = 1u << 20;
constexpr size_t WS_CTL = 0, CTL_ZERO_BYTES = 1 * MiB;
constexpr size_t WS_MOD = 1 * MiB;
constexpr size_t WS_MISC = WS_MOD + 128 * 1024;
constexpr size_t WS_LTOK = 2 * MiB;
constexpr size_t WS_LW = 4 * MiB;
constexpr size_t WS_WQKV_A = 8 * MiB, WS_WO_A = 14 * MiB, WS_WQKV_B = 16 * MiB, WS_WO_B = 22 * MiB;
constexpr size_t WS_WGU = 24 * MiB, WS_WD = 88 * MiB;
constexpr size_t WS_H = 120 * MiB;
constexpr size_t WS_Q = 152 * MiB, WS_K = 184 * MiB, WS_V = 216 * MiB;
constexpr size_t WS_Y = 152 * MiB;
constexpr size_t WS_HE = 216 * MiB;
constexpr size_t WS_END = 252 * MiB;
constexpr int HE_ROWS = 36864;
constexpr int CW_CNT = 1024;

struct Ptrs {
    const float *x, *c, *ada_w, *ada_b, *norm_mix_g, *norm_ffn_g, *t5_bias, *a_w_qkv, *a_q_gain, *a_k_gain, *a_lambda, *a_subln_g, *a_w_o,
        *b_w_qkv, *b_q_gain, *b_k_gain, *b_rel_bias, *b_w_o, *router_w, *router_bias, *moe_w_gate, *moe_w_up, *moe_w_down;
    float* out; unsigned char* ws;
};

__global__ void __launch_bounds__(256) k_adaln(Ptrs P) {
    __shared__ float sc[2][D];
    for (int i = threadIdx.x; i < 2 * D; i += 256) { const float v = P.c[i]; sc[i / D][i % D] = v / (1.f + __expf(-v)); }
    __syncthreads();
    const int idx = blockIdx.x * 256 + threadIdx.x;
    if (idx >= DEPTH * 6 * D) return;
    const int l = idx / (6 * D), n = idx % (6 * D);
    float a0 = 0.f, a1 = 0.f;
    for (int k = 0; k < D; ++k) { const float w = P.ada_w[((size_t)l * D + k) * (6 * D) + n]; a0 += sc[0][k] * w; a1 += sc[1][k] * w; }
    float* mod = (float*)(P.ws + WS_MOD);
    const float bb = P.ada_b[l * 6 * D + n];
    mod[(l * 2 + 0) * 6 * D + n] = a0 + bb; mod[(l * 2 + 1) * 6 * D + n] = a1 + bb;
    if (idx == 0) {
        float s01 = 0.f, s23 = 0.f;
        for (int d = 0; d < 64; ++d) { s01 += P.a_lambda[d] * P.a_lambda[64 + d]; s23 += P.a_lambda[128 + d] * P.a_lambda[192 + d]; }
        ((float*)(P.ws + WS_MISC))[0] = __expf(s01) - __expf(s23) + 0.2f;
    }
}

__device__ __forceinline__ float block_sum_256(float v, float* red) {
    for (int o = 32; o > 0; o >>= 1) v += __shfl_xor(v, o);
    __syncthreads();
    if ((threadIdx.x & 63) == 0) red[threadIdx.x >> 6] = v;
    __syncthreads();
    return red[0] + red[1] + red[2] + red[3];
}

__global__ void __launch_bounds__(256) k_norm(const float* xin, const float* g, const float* mod_l, int sh_off, int sc_off, bf16* h) {
    __shared__ float red[4];
    const int row = blockIdx.x, b = row / SEQ, t = threadIdx.x;
    const float4 v = ((const float4*)(xin + (size_t)row * D))[t];
    const float ss = block_sum_256(v.x * v.x + v.y * v.y + v.z * v.z + v.w * v.w, red);
    const float inv = rsqrtf(ss * (1.f / D) + NORM_EPS);
    const float* mb = mod_l + b * 6 * D;
    const float4 gg = ((const float4*)g)[t], sc = ((const float4*)(mb + sc_off))[t], sh = ((const float4*)(mb + sh_off))[t];
    const float o0 = v.x * inv * gg.x * (1.f + sc.x) + sh.x, o1 = v.y * inv * gg.y * (1.f + sc.y) + sh.y, o2 = v.z * inv * gg.z * (1.f + sc.z) + sh.z, o3 = v.w * inv * gg.w * (1.f + sc.w) + sh.w;
    uint2 w; w.x = f2bf(o0) | (f2bf(o1) << 16); w.y = f2bf(o2) | (f2bf(o3) << 16);
    ((uint2*)(h + (size_t)row * D))[t] = w;
}

template <class Prob> __global__ void __launch_bounds__(256) k_slow_gemm(Prob pb) {
    __shared__ float As[16][68], Bs[16][68];
    __shared__ float Cs[Prob::NPASS][64][65];
    if (!pb.setup(blockIdx.x)) return;
    const int tid = threadIdx.x, ty = tid >> 4, tx = tid & 15;
    for (int pass = 0; pass < Prob::NPASS; ++pass) {
        float acc[4][4];
#pragma unroll
        for (int i = 0; i < 4; ++i)
#pragma unroll
            for (int j = 0; j < 4; ++j) acc[i][j] = 0.f;
        for (int k0 = 0; k0 < pb.K; k0 += 16) {
            __syncthreads();
#pragma unroll
            for (int i = 0; i < 4; ++i) { const int e = tid + 256 * i; { const int r = e >> 4, k = e & 15; As[k][r] = pb.A(r, k0 + k); } { const int k = e >> 6, c = e & 63; Bs[k][c] = pb.B(pass, k0 + k, c); } }
            __syncthreads();
#pragma unroll
            for (int k = 0; k < 16; ++k) {
                float a[4], b[4];
#pragma unroll
                for (int i = 0; i < 4; ++i) { a[i] = As[k][ty * 4 + i]; b[i] = Bs[k][tx * 4 + i]; }
#pragma unroll
                for (int i = 0; i < 4; ++i)
#pragma unroll
                    for (int j = 0; j < 4; ++j) acc[i][j] += a[i] * b[j];
            }
        }
#pragma unroll
        for (int i = 0; i < 4; ++i)
#pragma unroll
            for (int j = 0; j < 4; ++j) Cs[pass][ty * 4 + i][tx * 4 + j] = acc[i][j];
    }
    __syncthreads();
    pb.epi(Cs, tid);
}

struct ProbQKV {
    static constexpr int NPASS = 1;
    const bf16* H; const float* W; const float* qg; const float* kg; bf16 *Q, *Kb, *V; int K;
    int m0, n0;
    __device__ bool setup(int bx) { m0 = (bx / 48) * 64; n0 = (bx % 48) * 64; return true; }
    __device__ float A(int r, int k) const { return bf2f(H[(size_t)(m0 + r) * D + k]); }
    __device__ float B(int, int k, int c) const { return W[(size_t)k * (3 * D) + n0 + c]; }
    __device__ void epi(float (*Cs)[64][65], int tid) const {
        const int r = tid >> 2, part = tid & 3;
        const int region = n0 / D, col0 = n0 % D;
        float ss = 0.f;
        for (int c = 0; c < 16; ++c) { const float v = Cs[0][r][part * 16 + c]; ss += v * v; }
        ss += __shfl_xor(ss, 1); ss += __shfl_xor(ss, 2);
        const float inv = rsqrtf(ss * (1.f / 64.f) + NORM_EPS);
        bf16* dst = (region == 0 ? Q : region == 1 ? Kb : V) + (size_t)(m0 + r) * D + col0;
        for (int c = 0; c < 16; ++c) { const int cc = part * 16 + c; float v = Cs[0][r][cc];
            if (region == 0) v = v * inv * qg[cc] * (0.125f * LOG2E); else if (region == 1) v = v * inv * kg[cc];
            dst[cc] = (bf16)f2bf(v); }
    }
};

struct ProbWo {
    static constexpr int NPASS = 1;
    const bf16* O; const float* W; const float* xres; const float* gate; float* out; int K;
    int m0, n0;
    __device__ bool setup(int bx) { m0 = (bx / 16) * 64; n0 = (bx % 16) * 64; return true; }
    __device__ float A(int r, int k) const { return bf2f(O[(size_t)(m0 + r) * D + k]); }
    __device__ float B(int, int k, int c) const { return W[(size_t)k * D + n0 + c]; }
    __device__ void epi(float (*Cs)[64][65], int tid) const {
        const int r = tid >> 2, part = tid & 3, row = m0 + r, b = row / SEQ;
        for (int c = 0; c < 16; ++c) { const int col = n0 + part * 16 + c; out[(size_t)row * D + col] = xres[(size_t)row * D + col] + gate[b * 6 * D + col] * Cs[0][r][part * 16 + c]; }
    }
};

__device__ __forceinline__ void expert_bases(const unsigned* cnt  , int e, int& cnt_e, int& base_e) {
    int base = 0, ce = 0;
    for (int i = 0; i < NE; ++i) { const int c = (int)cnt[i * 64]; if (i < e) base += (c + 255) & ~255; if (i == e) ce = c; }
    cnt_e = ce; base_e = base;
}

struct ProbUp {
    static constexpr int NPASS = 2;
    const bf16* H2; const float *Wg, *Wu; const unsigned* cnt; const unsigned* ltok; bf16* he; int K;
    int e, r0, n0, cnt_e, base_e;
    __device__ bool setup(int bx) { n0 = (bx % 8) * 64; const int rt = (bx / 8) % 256; e = bx / (8 * 256); r0 = rt * 64; expert_bases(cnt, e, cnt_e, base_e); return r0 < cnt_e; }
    __device__ float A(int r, int k) const { const int rr = r0 + r; if (rr >= cnt_e) return 0.f; const unsigned tok = ltok[(size_t)e * T + rr] & 0x7fffffffu; return bf2f(H2[(size_t)tok * D + k]); }
    __device__ float B(int pass, int k, int c) const { return (pass == 0 ? Wg : Wu)[((size_t)e * D + k) * FF + n0 + c]; }
    __device__ void epi(float (*Cs)[64][65], int tid) const {
        const int r = tid >> 2, part = tid & 3; if (r0 + r >= cnt_e) return;
        bf16* dst = he + (size_t)(base_e + r0 + r) * FF + n0;
        for (int c = 0; c < 16; ++c) { const int cc = part * 16 + c; const float g = Cs[0][r][cc], u = Cs[1][r][cc]; dst[cc] = (bf16)f2bf(g / (1.f + __expf(-g)) * u); }
    }
};
struct ProbDown {
    static constexpr int NPASS = 1;
    const bf16* he; const float* Wd; const unsigned* cnt; const unsigned* ltok; const float* lw; bf16* ybuf; int K;
    int e, r0, n0, cnt_e, base_e;
    __device__ bool setup(int bx) { n0 = (bx % 16) * 64; const int rt = (bx / 16) % 256; e = bx / (16 * 256); r0 = rt * 64; expert_bases(cnt, e, cnt_e, base_e); return r0 < cnt_e; }
    __device__ float A(int r, int k) const { const int rr = r0 + r; if (rr >= cnt_e) return 0.f; return bf2f(he[(size_t)(base_e + rr) * FF + k]); }
    __device__ float B(int, int k, int c) const { return Wd[((size_t)e * FF + k) * D + n0 + c]; }
    __device__ void epi(float (*Cs)[64][65], int tid) const {
        const int r = tid >> 2, part = tid & 3; if (r0 + r >= cnt_e) return;
        const unsigned tk = ltok[(size_t)e * T + r0 + r]; const float w = lw[(size_t)e * T + r0 + r];
        bf16* dst = ybuf + ((size_t)(tk >> 31) * T + (tk & 0x7fffffffu)) * D + n0;
        for (int c = 0; c < 16; ++c) { const int cc = part * 16 + c; dst[cc] = (bf16)f2bf(w * Cs[0][r][cc]); }
    }
};

__global__ void __launch_bounds__(256) k_norm_route(const float* xin, const float* g, const float* mod_l, int sh_off, int sc_off, bf16* h, const float* rw, const float* rb,
                                                    unsigned* cnt, unsigned* ltok, float* lw) {
    const int lane = threadIdx.x & 63, row = blockIdx.x * 4 + (threadIdx.x >> 6), b = row / SEQ;
    const float* mb = mod_l + b * 6 * D;
    float hv[16]; float ss = 0.f;
#pragma unroll
    for (int j = 0; j < 4; ++j) { const float4 v = ((const float4*)(xin + (size_t)row * D))[lane + 64 * j]; hv[4 * j] = v.x; hv[4 * j + 1] = v.y; hv[4 * j + 2] = v.z; hv[4 * j + 3] = v.w; ss += v.x * v.x + v.y * v.y + v.z * v.z + v.w * v.w; }
    for (int o = 32; o > 0; o >>= 1) ss += __shfl_xor(ss, o);
    const float inv = rsqrtf(ss * (1.f / D) + NORM_EPS);
    float lg[16];
#pragma unroll
    for (int e = 0; e < 16; ++e) lg[e] = 0.f;
#pragma unroll
    for (int j = 0; j < 4; ++j) {
        const int c0 = (lane + 64 * j) * 4;
        const float4 gg = *(const float4*)(g + c0), sc = *(const float4*)(mb + sc_off + c0), sh = *(const float4*)(mb + sh_off + c0);
        hv[4 * j] = hv[4 * j] * inv * gg.x * (1.f + sc.x) + sh.x; hv[4 * j + 1] = hv[4 * j + 1] * inv * gg.y * (1.f + sc.y) + sh.y;
        hv[4 * j + 2] = hv[4 * j + 2] * inv * gg.z * (1.f + sc.z) + sh.z; hv[4 * j + 3] = hv[4 * j + 3] * inv * gg.w * (1.f + sc.w) + sh.w;
        uint2 w; w.x = f2bf(hv[4 * j]) | (f2bf(hv[4 * j + 1]) << 16); w.y = f2bf(hv[4 * j + 2]) | (f2bf(hv[4 * j + 3]) << 16);
        *(uint2*)(h + (size_t)row * D + c0) = w;
#pragma unroll
        for (int i = 0; i < 4; ++i) { const float4* wr = (const float4*)(rw + (size_t)(c0 + i) * NE); const float x = hv[4 * j + i];
#pragma unroll
            for (int q = 0; q < 4; ++q) { const float4 w4 = wr[q]; lg[4 * q] += x * w4.x; lg[4 * q + 1] += x * w4.y; lg[4 * q + 2] += x * w4.z; lg[4 * q + 3] += x * w4.w; } }
    }
#pragma unroll
    for (int e = 0; e < 16; ++e) for (int o = 32; o > 0; o >>= 1) lg[e] += __shfl_xor(lg[e], o);
    if (lane == 0) {
        float sc[16], sel[16];
#pragma unroll
        for (int e = 0; e < 16; ++e) { sc[e] = 1.f / (1.f + __expf(-lg[e])); sel[e] = sc[e] + rb[e]; }
        int bg = 0; float bgs = -3e38f;
#pragma unroll
        for (int gi = 0; gi < 4; ++gi) {
            float m1 = -3e38f, m2 = -3e38f;
#pragma unroll
            for (int i = 0; i < 4; ++i) { const float v = sel[gi * 4 + i]; if (v > m1) { m2 = m1; m1 = v; } else if (v > m2) m2 = v; }
            const float gs = m1 + m2; if (gs > bgs) { bgs = gs; bg = gi; }
        }
        int e0 = 0, e1 = 0; float s0 = -3e38f, s1 = -3e38f, w0 = 0.f, w1 = 0.f;
#pragma unroll
        for (int gi = 0; gi < 4; ++gi) if (gi == bg) {
#pragma unroll
            for (int i = 0; i < 4; ++i) { const int e = gi * 4 + i; const float v = sel[e];
                if (v > s0) { s1 = s0; e1 = e0; w1 = w0; s0 = v; e0 = e; w0 = sc[e]; } else if (v > s1) { s1 = v; e1 = e; w1 = sc[e]; } }
        }
        const float ws = w0 + w1; w0 /= ws; w1 /= ws;
        const unsigned p0 = atomicAdd(&cnt[e0 * 64], 1u), p1 = atomicAdd(&cnt[e1 * 64], 1u);
        ltok[(size_t)e0 * T + p0] = (unsigned)row; lw[(size_t)e0 * T + p0] = w0;
        ltok[(size_t)e1 * T + p1] = (unsigned)row | 0x80000000u; lw[(size_t)e1 * T + p1] = w1;
    }
}

__global__ void __launch_bounds__(256) k_combine(float* xio, const bf16* ybuf, const float* gate  , int do_norm, const float* g, const float* modn, int sh_off, int sc_off, bf16* h) {
    __shared__ float red[4];
    const int row = blockIdx.x, b = row / SEQ, t = threadIdx.x;
    float4 v = ((const float4*)(xio + (size_t)row * D))[t];
    const uint2 y0 = ((const uint2*)(ybuf + (size_t)row * D))[t], y1 = ((const uint2*)(ybuf + ((size_t)T + row) * D))[t];
    const float4 gt = ((const float4*)(gate + b * 6 * D))[t];
    v.x += gt.x * (bf2f(y0.x) + bf2f(y1.x)); v.y += gt.y * (bf2f(y0.x >> 16) + bf2f(y1.x >> 16)); v.z += gt.z * (bf2f(y0.y) + bf2f(y1.y)); v.w += gt.w * (bf2f(y0.y >> 16) + bf2f(y1.y >> 16));
    ((float4*)(xio + (size_t)row * D))[t] = v;
    if (do_norm) {
        const float ss = block_sum_256(v.x * v.x + v.y * v.y + v.z * v.z + v.w * v.w, red);
        const float inv = rsqrtf(ss * (1.f / D) + NORM_EPS);
        const float* mb = modn + b * 6 * D;
        const float4 gg = ((const float4*)g)[t], sc = ((const float4*)(mb + sc_off))[t], sh = ((const float4*)(mb + sh_off))[t];
        const float o0 = v.x * inv * gg.x * (1.f + sc.x) + sh.x, o1 = v.y * inv * gg.y * (1.f + sc.y) + sh.y, o2 = v.z * inv * gg.z * (1.f + sc.z) + sh.z, o3 = v.w * inv * gg.w * (1.f + sc.w) + sh.w;
        uint2 w; w.x = f2bf(o0) | (f2bf(o1) << 16); w.y = f2bf(o2) | (f2bf(o3) << 16);
        ((uint2*)(h + (size_t)row * D))[t] = w;
    }
}

__device__ __forceinline__ int t5_bucket_ref(int rel) {
    const int ret = rel > 0 ? 16 : 0; const int n = rel < 0 ? -rel : rel;
    const float nf = (float)(n < 1 ? 1 : n);
    int large = 8 + (int)(logf(nf / 8.f) / logf(128.f) * 8.f); if (large > 15) large = 15;
    return ret + (n < 8 ? n : large);
}
__device__ __forceinline__ void slow_map(const bf16* Qrow, const bf16* Kcol, const bf16* Vcol, const float* t5h, int qpos, int kend, float (&o)[64]) {
    float q[64];
#pragma unroll
    for (int d = 0; d < 64; ++d) { q[d] = bf2f(Qrow[d]); o[d] = 0.f; }
    float m = -3e38f, l = 0.f;
    for (int j = 0; j < kend; ++j) {
        const uint4* kr = (const uint4*)(Kcol + (size_t)j * D);
        float s = 0.f;
#pragma unroll
        for (int c = 0; c < 8; ++c) { const uint4 kk = kr[c];
            s += q[8 * c] * bf2f(kk.x) + q[8 * c + 1] * bf2f(kk.x >> 16) + q[8 * c + 2] * bf2f(kk.y) + q[8 * c + 3] * bf2f(kk.y >> 16)
               + q[8 * c + 4] * bf2f(kk.z) + q[8 * c + 5] * bf2f(kk.z >> 16) + q[8 * c + 6] * bf2f(kk.w) + q[8 * c + 7] * bf2f(kk.w >> 16); }
        s += t5h[t5_bucket_ref(j - qpos) * 8] * LOG2E;
        const float mn = fmaxf(m, s), a = exp2f(m - mn), p = exp2f(s - mn);
        l = l * a + p; m = mn;
        const uint4* vr = (const uint4*)(Vcol + (size_t)j * D);
#pragma unroll
        for (int c = 0; c < 8; ++c) { const uint4 vv = vr[c];
            o[8 * c] = o[8 * c] * a + p * bf2f(vv.x); o[8 * c + 1] = o[8 * c + 1] * a + p * bf2f(vv.x >> 16); o[8 * c + 2] = o[8 * c + 2] * a + p * bf2f(vv.y); o[8 * c + 3] = o[8 * c + 3] * a + p * bf2f(vv.y >> 16);
            o[8 * c + 4] = o[8 * c + 4] * a + p * bf2f(vv.z); o[8 * c + 5] = o[8 * c + 5] * a + p * bf2f(vv.z >> 16); o[8 * c + 6] = o[8 * c + 6] * a + p * bf2f(vv.w); o[8 * c + 7] = o[8 * c + 7] * a + p * bf2f(vv.w >> 16); }
    }
    const float il = 1.f / l;
#pragma unroll
    for (int d = 0; d < 64; ++d) o[d] *= il;
}
__global__ void __launch_bounds__(64) k_slow_attnA(const bf16* Q, const bf16* Kb, const bf16* Vb, const float* t5, const float* misc, const float* subg, bf16* O) {
    const int blk = blockIdx.x, qt = blk % (SEQ / 32), h = (blk / (SEQ / 32)) % 8, b = blk / (SEQ / 32 * 8);
    const int lane = threadIdx.x, ql = lane >> 1, vh = lane & 1, qpos = qt * 32 + ql; const size_t row = (size_t)b * SEQ + qpos;
    const int kend = (qpos / 64 + 1) * 64;
    float o0[64], o1[64];
    slow_map(Q + row * D + (2 * h) * 64, Kb + (size_t)b * SEQ * D + (2 * h) * 64, Vb + (size_t)b * SEQ * D + h * 128 + vh * 64, t5 + h, qpos, kend, o0);
    slow_map(Q + row * D + (2 * h + 1) * 64, Kb + (size_t)b * SEQ * D + (2 * h + 1) * 64, Vb + (size_t)b * SEQ * D + h * 128 + vh * 64, t5 + h, qpos, kend, o1);
    const float lam = misc[0]; float ss = 0.f;
#pragma unroll
    for (int d = 0; d < 64; ++d) { o0[d] -= lam * o1[d]; ss += o0[d] * o0[d]; }
    ss += __shfl_xor(ss, 1);
    const float inv = rsqrtf(ss * (1.f / 128.f) + NORM_EPS) * 0.8f;
    bf16* dst = O + row * D + h * 128 + vh * 64;
#pragma unroll
    for (int d = 0; d < 64; d += 2) *(unsigned*)(dst + d) = f2bf(o0[d] * inv * subg[vh * 64 + d]) | (f2bf(o0[d + 1] * inv * subg[vh * 64 + d + 1]) << 16);
}
__global__ void __launch_bounds__(64) k_slow_attnB(const bf16* Q, const bf16* Kb, const bf16* Vb, const float* relb, bf16* O) {
    const int blk = blockIdx.x, ci = blk % (SEQ / 64), h = (blk / (SEQ / 64)) % 16, b = blk / (SEQ / 64 * 16);
    const int qpos = ci * 64 + threadIdx.x; const size_t row = (size_t)b * SEQ + qpos;
    const int k0 = ci >= 8 ? (ci - 8) * 64 : 0, kend = (ci + 1) * 64;
    float q[64], o[64];
#pragma unroll
    for (int d = 0; d < 64; ++d) { q[d] = bf2f(Q[row * D + h * 64 + d]); o[d] = 0.f; }
    float m = -3e38f, l = 0.f;
    const bf16* Kc = Kb + (size_t)b * SEQ * D + h * 64; const bf16* Vc = Vb + (size_t)b * SEQ * D + h * 64;
    for (int j = k0; j < kend; ++j) {
        const uint4* kr = (const uint4*)(Kc + (size_t)j * D);
        float s = 0.f;
#pragma unroll
        for (int c = 0; c < 8; ++c) { const uint4 kk = kr[c];
            s += q[8 * c] * bf2f(kk.x) + q[8 * c + 1] * bf2f(kk.x >> 16) + q[8 * c + 2] * bf2f(kk.y) + q[8 * c + 3] * bf2f(kk.y >> 16)
               + q[8 * c + 4] * bf2f(kk.z) + q[8 * c + 5] * bf2f(kk.z >> 16) + q[8 * c + 6] * bf2f(kk.w) + q[8 * c + 7] * bf2f(kk.w >> 16); }
        int rel = j - qpos; rel = rel < -256 ? -256 : (rel > 256 ? 256 : rel);
        s += relb[h * 513 + rel + 256] * LOG2E;
        const float mn = fmaxf(m, s), a = exp2f(m - mn), p = exp2f(s - mn);
        l = l * a + p; m = mn;
        const uint4* vr = (const uint4*)(Vc + (size_t)j * D);
#pragma unroll
        for (int c = 0; c < 8; ++c) { const uint4 vv = vr[c];
            o[8 * c] = o[8 * c] * a + p * bf2f(vv.x); o[8 * c + 1] = o[8 * c + 1] * a + p * bf2f(vv.x >> 16); o[8 * c + 2] = o[8 * c + 2] * a + p * bf2f(vv.y); o[8 * c + 3] = o[8 * c + 3] * a + p * bf2f(vv.y >> 16);
            o[8 * c + 4] = o[8 * c + 4] * a + p * bf2f(vv.z); o[8 * c + 5] = o[8 * c + 5] * a + p * bf2f(vv.z >> 16); o[8 * c + 6] = o[8 * c + 6] * a + p * bf2f(vv.w); o[8 * c + 7] = o[8 * c + 7] * a + p * bf2f(vv.w >> 16); }
    }
    const float il = 1.f / l;
    bf16* dst = O + row * D + h * 64;
#pragma unroll
    for (int d = 0; d < 64; d += 2) *(unsigned*)(dst + d) = f2bf(o[d] * il) | (f2bf(o[d + 1] * il) << 16);
}

#define GAS __attribute__((address_space(1)))
#define LAS __attribute__((address_space(3)))
typedef unsigned v4u __attribute__((ext_vector_type(4)));
typedef unsigned v2u __attribute__((ext_vector_type(2)));
typedef float f32x4 __attribute__((ext_vector_type(4)));
typedef float f32x16 __attribute__((ext_vector_type(16)));
typedef short bf16x8 __attribute__((ext_vector_type(8)));
typedef short s16x4 __attribute__((ext_vector_type(4)));
typedef GAS unsigned gu32;
#define RLX_AGENT __ATOMIC_RELAXED, __HIP_MEMORY_SCOPE_AGENT
#define LDS_WAIT() asm volatile("s_waitcnt lgkmcnt(0)" ::: "memory")
#define VM_WAIT() asm volatile("s_waitcnt vmcnt(0)" ::: "memory")

constexpr int NWAVES = 8;
constexpr int RING_BYTES = 131072;
constexpr int LDSCTL_OFF = RING_BYTES, MISC_OFF = LDSCTL_OFF + 320;
constexpr int TAB_OFF = RING_BYTES + 1024;
constexpr int LDS_BYTES = 147456;
constexpr int CW_BAR = 4096;

__device__ __forceinline__ unsigned cvt_pk_bf16(float lo, float hi) { unsigned r; asm volatile("v_cvt_pk_bf16_f32 %0, %1, %2" : "=v"(r) : "v"(lo), "v"(hi)); return r; }
__device__ __forceinline__ float wave_sum(float v) {
#pragma unroll
    for (int o = 1; o < 64; o <<= 1) v += __shfl_xor(v, o);
    return v;
}

#define XB_TMO      128
#define XB_XCNT(j)  (256  + 64 * (j))
#define XB_XSUB(j)  (1280 + 64 * (j))
#define XB_XGEN(j)  (2304 + 64 * (j))
#define XB_TOP      3328
#define XB_TOPGEN   3392
#define XCD_BAR_WORDS 3456
#define XB_SPIN_CAP (1u << 18)
__device__ __forceinline__ unsigned xb_ld(unsigned* p)              { return __hip_atomic_load(p, __ATOMIC_RELAXED, __HIP_MEMORY_SCOPE_AGENT); }
__device__ __forceinline__ unsigned xb_add(unsigned* p, unsigned v) { return __hip_atomic_fetch_add(p, v, __ATOMIC_RELAXED, __HIP_MEMORY_SCOPE_AGENT); }
__device__ __forceinline__ unsigned xb_xcc_id() { return (unsigned)__builtin_amdgcn_s_getreg((3 << 11) | 20) & 0xFu; }
#define XB_SPIN(cond, bar) do { unsigned _sp = 0; while (cond) { __builtin_amdgcn_s_sleep(1); \
    if ((++_sp & 255u) == 0u) { if (xb_ld(&(bar)[XB_TMO])) break; if (_sp > XB_SPIN_CAP) { atomicAdd(&(bar)[XB_TMO], 1u); break; } } } } while (0)
struct XcdBarrier { unsigned* bar; unsigned x; volatile LAS unsigned* st; };
__device__ __forceinline__ XcdBarrier xcd_barrier_post(unsigned* bar, volatile LAS unsigned* st) {
    XcdBarrier b; b.bar = bar; b.x = xb_xcc_id(); b.st = st;
    if (threadIdx.x == 0) (void)xb_add(&bar[XB_XCNT(b.x)], 1u);
    return b;
}
__device__ __forceinline__ void xcd_barrier_complete(unsigned* bar, unsigned x, unsigned& nloc, unsigned& nx) {
    const unsigned G = gridDim.x * gridDim.y * gridDim.z;
    unsigned sum, cnt, mine, sp = 0u;
    for (;;) {
        sum = 0u; cnt = 0u; mine = 0u;
#pragma unroll
        for (unsigned j = 0; j < 16; ++j) { const unsigned c = xb_ld(&bar[XB_XCNT(j)]); sum += c; cnt += (c > 0u) ? 1u : 0u; mine = (j == x) ? c : mine; }
        if (sum == G) break;
        __builtin_amdgcn_s_sleep(1);
        if ((++sp & 255u) == 0u) { if (xb_ld(&bar[XB_TMO])) break; if (sp > XB_SPIN_CAP) { atomicAdd(&bar[XB_TMO], 1u); break; } }
    }
    nloc = mine > 0u ? mine : 1u; nx = cnt > 0u ? cnt : 1u;
}
__device__ __forceinline__ void xcd_barrier(const XcdBarrier& b) {
    asm volatile("s_waitcnt vmcnt(0)" ::: "memory");
    __syncthreads();
    if (threadIdx.x == 0) {
        unsigned* bar = b.bar;
        __builtin_amdgcn_s_waitcnt(0);
        unsigned nloc = b.st[0], nx = b.st[1];
        if (nloc == 0u) { xcd_barrier_complete(bar, b.x, nloc, nx); b.st[0] = nloc; b.st[1] = nx; }
        const unsigned old = xb_add(&bar[XB_XSUB(b.x)], 1u);
        const unsigned gen = old / nloc;
        if (old + 1u == (gen + 1u) * nloc) {
            __builtin_amdgcn_fence(__ATOMIC_RELEASE, "agent");
            asm volatile("s_waitcnt vmcnt(0)" ::: "memory");
            const unsigned og = xb_add(&bar[XB_TOP], 1u);
            const unsigned tg = og / nx;
            if (og + 1u == (tg + 1u) * nx) xb_add(&bar[XB_TOPGEN], 1u);
            else XB_SPIN(xb_ld(&bar[XB_TOPGEN]) == tg, bar);
            __builtin_amdgcn_fence(__ATOMIC_ACQUIRE, "agent");
            xb_add(&bar[XB_XGEN(b.x)], 1u);
            asm volatile("s_waitcnt vmcnt(0)" ::: "memory");
        } else {
            XB_SPIN(xb_ld(&bar[XB_XGEN(b.x)]) == gen, bar);
            __builtin_amdgcn_fence(__ATOMIC_ACQUIRE, "agent");
            asm volatile("s_waitcnt vmcnt(0)" ::: "memory");
        }
    }
    __syncthreads();
}

namespace g8 {
constexpr int BM = 256, BK = 64, HALF = 128, HTB = HALF * BK * 2, STAGE_BYTES = 8 * HTB;
__host__ __device__ __forceinline__ int lds_byte(int r, int c) { const int st = (r >> 4) * 2 + (c >> 5), rr = r & 15, cc = c & 31, ob = rr * 64 + cc * 2; return st * 1024 + (ob ^ (((ob >> 9) & 1) << 5)); }
__host__ __device__ __forceinline__ void stage_rc(int b, int& R, int& C) { const int st = b / 1024, sb = b % 1024, swz = sb ^ (((sb >> 9) & 1) << 5); R = (st >> 1) * 16 + swz / 64; C = (st & 1) * 32 + (swz % 64) / 2; }
__host__ __device__ __forceinline__ int perm32(int rho) { const int n = rho >> 4, i = rho & 15; return 8 * (i >> 2) + 4 * n + (i & 3); }

struct Unit { int arow0, brow0, orow0, pn, lidx, nvalid; };

struct DenseOrder {
    int nM, nN, nwg, G, c;
    __device__ void init(int M, int N, int G_, int c_) { nM = M / BM; nN = N / BM; nwg = nM * nN; G = G_; c = c_; }
    __device__ __forceinline__ bool next(int i, Unit& u) const {
        const long L = (long)i * G + c; if (L >= nwg) return false;
        int wgid = (int)L; { const int q = nwg / 8, r = nwg % 8, xcd = wgid % 8, off = wgid / 8; wgid = (xcd < r ? xcd * (q + 1) : r * (q + 1) + (xcd - r) * q) + off; }
        const int nig = 8 * nN, gid = wgid / nig, fm = gid * 8, gsz = (nM - fm) < 8 ? (nM - fm) : 8;
        const int pm = fm + ((wgid % nig) % gsz), pn = (wgid % nig) / gsz;
        u.arow0 = pm * BM; u.orow0 = pm * BM; u.brow0 = pn * BM; u.pn = pn; u.lidx = 0; u.nvalid = BM; return true;
    }
    __device__ __forceinline__ void aoffs(const Unit& u, int K, unsigned (&o)[4]) const {
#pragma unroll
        for (int i = 0; i < 2; ++i) { int R, C; stage_rc((int)threadIdx.x * 16 + i * 8192, R, C);
#pragma unroll
            for (int h = 0; h < 2; ++h) o[h * 2 + i] = (unsigned)((u.arow0 + h * HALF + R) * K + C) * 2u; }
    }
};
template <bool GATHER> struct MoeOrder {
    const LAS unsigned* tab; const unsigned* ltok; int G, c;
    __device__ __forceinline__ bool next(int i, Unit& u) const {
        const int L = i * G + c; const int ntile = (int)__builtin_amdgcn_readfirstlane(tab[0]);
        if (L >= ntile * 4) return false;
        const int rt = L >> 2, pn = L & 3; const unsigned w = __builtin_amdgcn_readfirstlane(tab[1 + rt]); const int e = (int)(w & 255u), ti = (int)(w >> 8);
        const int base = (int)__builtin_amdgcn_readfirstlane(tab[160 + e]), cnt = (int)__builtin_amdgcn_readfirstlane(tab[176 + e]);
        u.lidx = e * T + ti * BM; u.orow0 = base + ti * BM; u.arow0 = base + ti * BM; u.brow0 = e * 1024 + pn * BM; u.pn = pn; u.nvalid = (cnt - ti * BM) < BM ? (cnt - ti * BM) : BM; return true;
    }
    __device__ __forceinline__ void aoffs(const Unit& u, int K, unsigned (&o)[4]) const {
#pragma unroll
        for (int i = 0; i < 2; ++i) { int R, C; stage_rc((int)threadIdx.x * 16 + i * 8192, R, C);
#pragma unroll
            for (int h = 0; h < 2; ++h) {
                int row;
                if (GATHER) { int r = h * HALF + R; if (r >= u.nvalid) r = 0; row = (int)(ltok[u.lidx + r] & 0x7fffffffu); }
                else row = u.arow0 + h * HALF + R;
                o[h * 2 + i] = (unsigned)(row * K + C) * 2u; } }
    }
};

struct EpiQKV {
    static constexpr bool PERM = true;
    bf16* Q; size_t stride; const float *qg, *kg;
    __device__ __forceinline__ void operator()(const f32x4 (&acc)[2][2][4][2], const Unit& u, int wr, int wc, int fr, int fq) const {
        const int region = u.pn >> 2, colt = (u.pn & 3) * BM;
        bf16* base = Q + (size_t)region * stride;
        const bool nrm = region < 2;
        const float* gp = (region == 0) ? qg : kg; const float gs = (region == 0) ? 0.125f * LOG2E : 1.f;
        f32x4 gv[2][2];
#pragma unroll
        for (int bj = 0; bj < 2; ++bj)
#pragma unroll
            for (int n = 0; n < 2; ++n) { gv[bj][n] = (f32x4){1.f, 1.f, 1.f, 1.f}; if (nrm) gv[bj][n] = *(const f32x4*)(gp + 32 * bj + 8 * fq + 4 * n) * gs; }
#pragma unroll
        for (int ai = 0; ai < 2; ++ai)
#pragma unroll
            for (int m = 0; m < 4; ++m) {
                const int row = u.orow0 + ai * HALF + wr * 64 + m * 16 + fr;
                float ss = 0.f;
#pragma unroll
                for (int bj = 0; bj < 2; ++bj)
#pragma unroll
                    for (int n = 0; n < 2; ++n) { const f32x4 x = acc[ai][bj][m][n]; ss += (x[0] * x[0] + x[1] * x[1]) + (x[2] * x[2] + x[3] * x[3]); }
                ss += __shfl_xor(ss, 16); ss += __shfl_xor(ss, 32);
                const float inv = nrm ? rsqrtf(ss * (1.f / 64.f) + NORM_EPS) : 1.f;
                bf16* rowp = base + (size_t)row * D + colt + 64 * wc + 8 * fq;
#pragma unroll
                for (int bj = 0; bj < 2; ++bj) { const f32x4 v0 = acc[ai][bj][m][0] * gv[bj][0] * inv, v1 = acc[ai][bj][m][1] * gv[bj][1] * inv;
                    v4u w; w.x = cvt_pk_bf16(v0[0], v0[1]); w.y = cvt_pk_bf16(v0[2], v0[3]); w.z = cvt_pk_bf16(v1[0], v1[1]); w.w = cvt_pk_bf16(v1[2], v1[3]);
                    *(v4u*)(rowp + 32 * bj) = w; }
            }
    }
};
struct EpiWo {
    static constexpr bool PERM = false;
    const float* xres; const float* gate; float* out;
    __device__ __forceinline__ void operator()(const f32x4 (&acc)[2][2][4][2], const Unit& u, int wr, int wc, int fr, int fq) const {
        const int b = u.orow0 / SEQ; const int col0 = u.pn * BM + wc * 32 + 4 * fq;
        f32x4 gt[2][2];
#pragma unroll
        for (int bj = 0; bj < 2; ++bj)
#pragma unroll
            for (int n = 0; n < 2; ++n) gt[bj][n] = *(const f32x4*)(gate + b * 6 * D + col0 + bj * HALF + n * 16);
#pragma unroll
        for (int ai = 0; ai < 2; ++ai)
#pragma unroll
            for (int m = 0; m < 4; ++m) { const size_t off = (size_t)(u.orow0 + ai * HALF + wr * 64 + m * 16 + fr) * D + col0;
#pragma unroll
                for (int bj = 0; bj < 2; ++bj)
#pragma unroll
                    for (int n = 0; n < 2; ++n) { const f32x4 xr = *(const f32x4*)(xres + off + bj * HALF + n * 16); *(f32x4*)(out + off + bj * HALF + n * 16) = xr + gt[bj][n] * acc[ai][bj][m][n]; }
                if (m & 1) asm volatile("" ::: "memory"); }
    }
};
struct EpiUp {
    static constexpr bool PERM = true;
    bf16* he;
    __device__ __forceinline__ void operator()(const f32x4 (&acc)[2][2][4][2], const Unit& u, int wr, int wc, int fr, int fq) const {
#pragma unroll
        for (int ai = 0; ai < 2; ++ai)
#pragma unroll
            for (int m = 0; m < 4; ++m) { const int row = u.orow0 + ai * HALF + wr * 64 + m * 16 + fr;
                f32x4 v[2];
#pragma unroll
                for (int n = 0; n < 2; ++n)
#pragma unroll
                    for (int i = 0; i < 4; ++i) { const float g = acc[ai][0][m][n][i], up = acc[ai][1][m][n][i]; v[n][i] = g * __builtin_amdgcn_rcpf(1.f + __builtin_amdgcn_exp2f(-g * LOG2E)) * up; }
                v4u w; w.x = cvt_pk_bf16(v[0][0], v[0][1]); w.y = cvt_pk_bf16(v[0][2], v[0][3]); w.z = cvt_pk_bf16(v[1][0], v[1][1]); w.w = cvt_pk_bf16(v[1][2], v[1][3]);
                *(v4u*)(he + (size_t)row * FF + u.pn * HALF + 32 * wc + 8 * fq) = w; }
    }
};
struct EpiDown {
    static constexpr bool PERM = true;
    const unsigned* ltok; const float* lw; bf16* ybuf;
    __device__ __forceinline__ void operator()(const f32x4 (&acc)[2][2][4][2], const Unit& u, int wr, int wc, int fr, int fq) const {
#pragma unroll
        for (int ai = 0; ai < 2; ++ai)
#pragma unroll
            for (int m = 0; m < 4; ++m) { const int r = ai * HALF + wr * 64 + m * 16 + fr;
                if (r < u.nvalid) { const unsigned tk = ltok[u.lidx + r]; const float w = lw[u.lidx + r];
                    bf16* dst = ybuf + ((size_t)(tk >> 31) * T + (tk & 0x7fffffffu)) * D + u.pn * BM + 32 * wc + 8 * fq;
#pragma unroll
                    for (int bj = 0; bj < 2; ++bj) { const f32x4 v0 = acc[ai][bj][m][0] * w, v1 = acc[ai][bj][m][1] * w;
                        v4u o; o.x = cvt_pk_bf16(v0[0], v0[1]); o.y = cvt_pk_bf16(v0[2], v0[3]); o.z = cvt_pk_bf16(v1[0], v1[1]); o.w = cvt_pk_bf16(v1[2], v1[3]);
                        *(v4u*)(dst + bj * HALF) = o; } } }
    }
};

template <class Epi, class Sched>
__device__ __forceinline__ void gemm_phase(LAS unsigned char* lds, const bf16* A, const bf16* Bt, const int K, const Sched& S, const Epi& E) {
    const int tid = threadIdx.x, wid = __builtin_amdgcn_readfirstlane(tid >> 6), lane = tid & 63, wr = wid >> 2, wc = wid & 3, fr = lane & 15, fq = lane >> 4;
    const int nt = K / BK;
    unsigned voffB[2];
#pragma unroll
    for (int i = 0; i < 2; ++i) { int R, C; stage_rc(tid * 16 + i * 8192, R, C); const int Rb = Epi::PERM ? ((R & ~31) + perm32(R & 31)) : R; voffB[i] = (unsigned)(Rb * K + C) * 2u; }
    const size_t kstep = (size_t)(BK * 2);
    const size_t hstep = (size_t)HALF * K * 2;
    const unsigned ldsw = (unsigned)wid * 1024u;
    const int aoff = lds_byte(wr * 64 + fr, fq * 8), boff = lds_byte(wc * 32 + fr, fq * 8);
#define G8_SA(b, h) (((b) * 2 + (h)) * HTB)
#define G8_SB(b, h) ((4 + (b) * 2 + (h)) * HTB)
#define G8_STAGE_B(bufoff, gbase) do { _Pragma("unroll") for (int _i = 0; _i < 2; ++_i) \
        __builtin_amdgcn_global_load_lds((const unsigned*)((const char*)(gbase) + voffB[_i]), (LAS unsigned*)(lds + (bufoff) + ldsw + _i * 8192), 16, 0, 0); } while (0)
#define G8_STAGE_A(bufoff, kt, offs, h) do { _Pragma("unroll") for (int _i = 0; _i < 2; ++_i) \
        __builtin_amdgcn_global_load_lds((const unsigned*)((const char*)A + (size_t)(kt) * kstep + (offs)[(h) * 2 + _i]), (LAS unsigned*)(lds + (bufoff) + ldsw + _i * 8192), 16, 0, 0); } while (0)
#define G8_LDA(dst, b, h) do { _Pragma("unroll") for (int m = 0; m < 4; ++m) _Pragma("unroll") for (int k = 0; k < 2; ++k) dst[m][k] = *(const LAS bf16x8*)(lds + G8_SA(b, h) + aoff + m * 2048 + k * 1024); } while (0)
#define G8_LDB(dst, b, h) do { _Pragma("unroll") for (int n = 0; n < 2; ++n) _Pragma("unroll") for (int k = 0; k < 2; ++k) dst[n][k] = *(const LAS bf16x8*)(lds + G8_SB(b, h) + boff + n * 2048 + k * 1024); } while (0)
#define G8_MMA(ai, bj, At, Bt_) do { __builtin_amdgcn_s_setprio(1); _Pragma("unroll") for (int m = 0; m < 4; ++m) _Pragma("unroll") for (int n = 0; n < 2; ++n) _Pragma("unroll") for (int k = 0; k < 2; ++k) \
        acc[ai][bj][m][n] = __builtin_amdgcn_mfma_f32_16x16x32_bf16(Bt_[n][k], At[m][k], acc[ai][bj][m][n], 0, 0, 0); __builtin_amdgcn_s_setprio(0); } while (0)
#define G8_WAIT_V(n) asm volatile("s_waitcnt vmcnt(" #n ")" ::: "memory")
#define G8_WAIT_L(n) asm volatile("s_waitcnt lgkmcnt(" #n ")" ::: "memory")
#define G8_BAR __builtin_amdgcn_s_barrier()
#define G8_SCHED __builtin_amdgcn_sched_barrier(0)
    Unit cur, nxt; int ui = 0;
    if (!S.next(0, cur)) return;
    f32x4 acc[2][2][4][2];
#pragma unroll
    for (int a = 0; a < 2; ++a)
#pragma unroll
        for (int b = 0; b < 2; ++b)
#pragma unroll
            for (int m = 0; m < 4; ++m)
#pragma unroll
                for (int n = 0; n < 2; ++n) acc[a][b][m][n] = (f32x4){0.f, 0.f, 0.f, 0.f};
    bf16x8 At[4][2], B0[2][2], B1[2][2];
    unsigned offc[4], offn[4];
    S.aoffs(cur, K, offc);
    const char* cB = (const char*)Bt + (size_t)cur.brow0 * K * 2;
    G8_STAGE_B(G8_SB(0, 0), cB); G8_STAGE_B(G8_SB(0, 1), cB + hstep); G8_STAGE_A(G8_SA(0, 0), 0, offc, 0); G8_STAGE_A(G8_SA(0, 1), 0, offc, 1);
    if (wr == 1) G8_BAR;
    G8_WAIT_V(2); G8_BAR;
    G8_STAGE_B(G8_SB(1, 0), cB + kstep); G8_STAGE_A(G8_SA(1, 0), 1, offc, 0); G8_STAGE_B(G8_SB(1, 1), cB + hstep + kstep);
    G8_WAIT_V(6); G8_BAR;
    for (;;) {
        const bool has_next = S.next(ui + 1, nxt);
        if (has_next) S.aoffs(nxt, K, offn); else {
#pragma unroll
            for (int j = 0; j < 4; ++j) offn[j] = offc[j]; }
        const char* nB = has_next ? (const char*)Bt + (size_t)nxt.brow0 * K * 2 : cB;
        for (int t = 0; t < nt; t += 2) {
            const bool last = (t == nt - 2);
            const int kt2 = last ? 0 : t + 2;
            unsigned o2[4];
#pragma unroll
            for (int j = 0; j < 4; ++j) o2[j] = last ? offn[j] : offc[j];
            const char* b2 = last ? nB : cB + (size_t)(t + 2) * kstep; const char* b3 = b2 + kstep;
            G8_LDB(B0, 0, 0); G8_LDB(B1, 0, 1); G8_SCHED; G8_LDA(At, 0, 0); G8_STAGE_A(G8_SA(1, 1), t + 1, offc, 1);
            G8_WAIT_V(8); G8_WAIT_L(0); G8_BAR; G8_MMA(0, 0, At, B0); G8_MMA(0, 1, At, B1); G8_BAR; G8_SCHED;
            G8_LDA(At, 0, 1); G8_STAGE_B(G8_SB(0, 0), b2); G8_STAGE_B(G8_SB(0, 1), b2 + hstep); G8_STAGE_A(G8_SA(0, 0), kt2, o2, 0);
            G8_WAIT_V(8); G8_WAIT_L(0); G8_BAR; G8_MMA(1, 0, At, B0); G8_MMA(1, 1, At, B1); G8_BAR; G8_SCHED;
            G8_LDB(B0, 1, 0); G8_LDB(B1, 1, 1); G8_SCHED; G8_LDA(At, 1, 0); G8_STAGE_A(G8_SA(0, 1), kt2, o2, 1);
            G8_WAIT_V(8); G8_WAIT_L(0); G8_BAR; G8_MMA(0, 0, At, B0); G8_MMA(0, 1, At, B1); G8_BAR; G8_SCHED;
            G8_LDA(At, 1, 1); G8_STAGE_B(G8_SB(1, 0), b3); G8_STAGE_B(G8_SB(1, 1), b3 + hstep); G8_STAGE_A(G8_SA(1, 0), kt2 + 1, o2, 0);
            G8_WAIT_V(8); G8_WAIT_L(0); G8_BAR; G8_MMA(1, 0, At, B0); G8_MMA(1, 1, At, B1); G8_BAR; G8_SCHED;
        }
        if (wr == 0) G8_BAR;
        E(acc, cur, wr, wc, fr, fq);
        if (!has_next) break;
#pragma unroll
        for (int a = 0; a < 2; ++a)
#pragma unroll
            for (int b = 0; b < 2; ++b)
#pragma unroll
                for (int m = 0; m < 4; ++m)
#pragma unroll
                    for (int n = 0; n < 2; ++n) acc[a][b][m][n] = (f32x4){0.f, 0.f, 0.f, 0.f};
        cur = nxt; cB = nB; ++ui;
#pragma unroll
        for (int j = 0; j < 4; ++j) offc[j] = offn[j];
        if (wr == 1) G8_BAR;
    }
    G8_WAIT_V(0);
    G8_BAR;
#undef G8_SA
#undef G8_SB
#undef G8_STAGE_A
#undef G8_STAGE_B
#undef G8_LDA
#undef G8_LDB
#undef G8_MMA
#undef G8_WAIT_V
#undef G8_WAIT_L
#undef G8_BAR
#undef G8_SCHED
}
}
namespace att {
__device__ __forceinline__ int crow(int r, int hi) { return (r & 3) + 8 * (r >> 2) + 4 * hi; }
__device__ __forceinline__ void glds16(const void* gsrc, unsigned lds_dst) { unsigned keep;
    asm volatile("s_mov_b32 %0, m0\n\ts_mov_b32 m0, %2\n\ts_nop 0\n\tglobal_load_lds_dwordx4 %1, off\n\ts_mov_b32 m0, %0" : "=&s"(keep) : "v"(gsrc), "s"(lds_dst) : "memory"); }
typedef LAS const char* lds_cptr;
typedef short v4i16_t __attribute__((ext_vector_type(4)));
__device__ __forceinline__ s16x4 vtr(lds_cptr p) { return __builtin_bit_cast(s16x4, __builtin_amdgcn_ds_read_tr16_b64_v4i16((LAS v4i16_t*)p)); }
__device__ __forceinline__ float swap_add(float v) { auto rr = __builtin_amdgcn_permlane32_swap(__float_as_uint(v), __float_as_uint(v), false, false); return __uint_as_float(rr[0]) + __uint_as_float(rr[1]); }
#define ATT_WAIT_BAR(N) asm volatile("s_waitcnt vmcnt(" #N ") lgkmcnt(0)\n\ts_barrier" ::: "memory")

template <int MIX>
__device__ __forceinline__ void attn_unit(int b, int h, int blk, const bf16* Q, const bf16* __restrict__ K, const bf16* __restrict__ V, bf16* O, LAS unsigned char* lds, const float* tabg, float lam, const float* subg) {
    constexpr int KC = MIX == 0 ? 128 : 64, DV = KC, NDB = DV / 32, SLOT = KC * 128, NP = MIX == 0 ? 2 : 1;
    constexpr int TABN = MIX == 0 ? 768 : 416, OFFS = MIX == 0 ? 704 : 352, FARREL = MIX == 0 ? -559 : -256;
    constexpr int LDS_K = 0, LDS_V = 3 * SLOT, LDS_T = 6 * SLOT;
    const int tid = threadIdx.x, lane = tid & 63, r32 = lane & 31, hi = lane >> 5; const int wid = __builtin_amdgcn_readfirstlane(tid >> 6);
    int map, rb, R0, T_lo, T_hi, ci, w_lo;
    if (MIX == 0) { map = wid >> 2; rb = wid & 3; R0 = blk * 128; ci = 2 * blk + (rb >> 1); T_lo = 0; T_hi = 2 * blk + 1; w_lo = 0; }
    else { map = 0; rb = wid; R0 = blk * 256; ci = 4 * blk + (rb >> 1); T_lo = 4 * blk - 8 > 0 ? 4 * blk - 8 : 0; T_hi = 4 * blk + 3; w_lo = ci - 8 > 0 ? ci - 8 : 0; }
    const int w_hi = ci, qrow0 = R0 + 32 * rb;
    const size_t rowbase = (size_t)b * SEQ;
    const int hcol = h * KC, qcol = hcol + map * 64;
    const unsigned lds0 = (unsigned)(uintptr_t)lds;
    LAS float* tab = (LAS float*)(lds + LDS_T);
    for (int i = tid; i < TABN; i += NWAVES * 64) tab[i] = tabg[h * TABN + i];
    bf16x8 qr[4];
#pragma unroll
    for (int d0 = 0; d0 < 4; ++d0) qr[d0] = *(const bf16x8*)(Q + (rowbase + qrow0 + r32) * D + qcol + d0 * 16 + hi * 8);
    asm volatile("s_waitcnt vmcnt(0)" ::: "memory");
#pragma unroll
    for (int d0 = 0; d0 < 4; ++d0) asm volatile("" : "+v"(qr[d0]));
    const bf16* ksrc[NP]; const bf16* vsrc[NP]; unsigned kdst[NP], vdst[NP];
#pragma unroll
    for (int j = 0; j < NP; ++j) { const int p = wid + 8 * j;
        ksrc[j] = K + (rowbase + lane) * D + hcol + p * 8; kdst[j] = lds0 + LDS_K + p * 1024;
        vsrc[j] = V + (rowbase + 16 * (p & 3) + (lane >> 2)) * D + hcol + 32 * (p >> 2) + 8 * (lane & 3); vdst[j] = lds0 + LDS_V + p * 1024; }
#define ATT_ISSUE(t, slot) do { _Pragma("unroll") for (int j_ = 0; j_ < NP; ++j_) { \
        glds16(ksrc[j_] + (size_t)(t) * 64 * D, (unsigned)__builtin_amdgcn_readfirstlane(kdst[j_] + (slot))); \
        glds16(vsrc[j_] + (size_t)(t) * 64 * D, (unsigned)__builtin_amdgcn_readfirstlane(vdst[j_] + (slot))); } } while (0)
    const lds_cptr kp0 = (lds_cptr)lds + LDS_K + (map * 8 + hi) * 1024 + r32 * 16;
    const lds_cptr vp0 = (lds_cptr)lds + LDS_V + ((lane >> 4) & 1) * 32 + (lane & 3) * 8 + (4 * hi + ((lane & 15) >> 2)) * 64;
    f32x16 o[NDB];
#pragma unroll
    for (int i = 0; i < NDB; ++i) o[i] = f32x16{};
    float lsum = 0.f;
    ATT_ISSUE(T_lo, 0); if (T_lo + 1 <= T_hi) ATT_ISSUE(T_lo + 1, SLOT);
    int sl = 0;
    for (int t = T_lo; t <= T_hi; ++t) {
        if (t < T_hi) { if (NP == 2) ATT_WAIT_BAR(4); else ATT_WAIT_BAR(2); } else ATT_WAIT_BAR(0);
        if (t + 2 <= T_hi) { const int s2 = sl >= SLOT ? sl - SLOT : sl + 2 * SLOT; ATT_ISSUE(t + 2, s2); }
        if (t >= w_lo && t <= w_hi) {
            f32x16 p0, p1;
            const int maxrel = 64 * t + 63 - qrow0;
            if (maxrel > FARREL) { const LAS float* tp = tab + (64 * t + 4 * hi - (qrow0 + r32) + OFFS);
#pragma unroll
                for (int r = 0; r < 16; ++r) { p0[r] = tp[(r & 3) + 8 * (r >> 2)]; p1[r] = tp[32 + (r & 3) + 8 * (r >> 2)]; } }
            else { p0 = f32x16{}; p1 = f32x16{}; }
            const lds_cptr kp = kp0 + sl;
#pragma unroll
            for (int d0 = 0; d0 < 4; ++d0) { const bf16x8 k0 = *(const LAS bf16x8*)(kp + d0 * 2048), k1 = *(const LAS bf16x8*)(kp + d0 * 2048 + 512);
                p0 = __builtin_amdgcn_mfma_f32_32x32x16_bf16(k0, qr[d0], p0, 0, 0, 0); p1 = __builtin_amdgcn_mfma_f32_32x32x16_bf16(k1, qr[d0], p1, 0, 0, 0); }
            float sa = 0.f, sb = 0.f;
#pragma unroll
            for (int r = 0; r < 16; ++r) { p0[r] = __builtin_amdgcn_exp2f(p0[r]); p1[r] = __builtin_amdgcn_exp2f(p1[r]); sa += p0[r]; sb += p1[r]; }
            lsum += sa + sb;
            v4u pw[4];
            pw[0] = (v4u){cvt_pk_bf16(p0[0], p0[1]), cvt_pk_bf16(p0[2], p0[3]), cvt_pk_bf16(p0[4], p0[5]), cvt_pk_bf16(p0[6], p0[7])};
            pw[1] = (v4u){cvt_pk_bf16(p0[8], p0[9]), cvt_pk_bf16(p0[10], p0[11]), cvt_pk_bf16(p0[12], p0[13]), cvt_pk_bf16(p0[14], p0[15])};
            pw[2] = (v4u){cvt_pk_bf16(p1[0], p1[1]), cvt_pk_bf16(p1[2], p1[3]), cvt_pk_bf16(p1[4], p1[5]), cvt_pk_bf16(p1[6], p1[7])};
            pw[3] = (v4u){cvt_pk_bf16(p1[8], p1[9]), cvt_pk_bf16(p1[10], p1[11]), cvt_pk_bf16(p1[12], p1[13]), cvt_pk_bf16(p1[14], p1[15])};
            const lds_cptr vp = vp0 + sl;
#pragma unroll
            for (int db = 0; db < NDB; ++db)
#pragma unroll
                for (int s = 0; s < 4; ++s) { const s16x4 lo = vtr(vp + db * 4096 + s * 1024), hh = vtr(vp + db * 4096 + s * 1024 + 512);
                    const bf16x8 vf = (bf16x8){lo[0], lo[1], lo[2], lo[3], hh[0], hh[1], hh[2], hh[3]};
                    o[db] = __builtin_amdgcn_mfma_f32_32x32x16_bf16(vf, __builtin_bit_cast(bf16x8, pw[s]), o[db], 0, 0, 0); }
        }
        sl = sl == 2 * SLOT ? 0 : sl + SLOT;
    }
    const float l = swap_add(lsum);
    const size_t orow = (rowbase + qrow0 + r32) * D;
    if (MIX == 0) {
        const float f = (map == 0 ? 1.f : -lam) / l;
        ATT_WAIT_BAR(0);
        LAS float* X = (LAS float*)lds + rb * 4096 + lane;
        if (map == 1) {
#pragma unroll
            for (int db = 0; db < NDB; ++db)
#pragma unroll
                for (int r = 0; r < 16; ++r) X[(db * 16 + r) * 64] = o[db][r] * f; }
        ATT_WAIT_BAR(0);
        if (map == 0) { float ss = 0.f;
#pragma unroll
            for (int db = 0; db < NDB; ++db)
#pragma unroll
                for (int r = 0; r < 16; ++r) { const float v = o[db][r] * f + X[(db * 16 + r) * 64]; o[db][r] = v; ss += v * v; }
            ss = swap_add(ss);
            const float inv = rsqrtf(ss * (1.f / 128.f) + NORM_EPS) * 0.8f;
#pragma unroll
            for (int db = 0; db < NDB; ++db)
#pragma unroll
                for (int g = 0; g < 4; ++g) { const int d = 32 * db + 8 * g + 4 * hi; const f32x4 sg = *(const f32x4*)(subg + d);
                    v2u w; w.x = cvt_pk_bf16(o[db][4 * g] * inv * sg[0], o[db][4 * g + 1] * inv * sg[1]); w.y = cvt_pk_bf16(o[db][4 * g + 2] * inv * sg[2], o[db][4 * g + 3] * inv * sg[3]);
                    *(v2u*)(O + orow + h * 128 + d) = w; } }
        ATT_WAIT_BAR(0);
    } else {
        const float f = 1.f / l;
#pragma unroll
        for (int db = 0; db < NDB; ++db)
#pragma unroll
            for (int g = 0; g < 4; ++g) { const int d = 32 * db + 8 * g + 4 * hi;
                v2u w; w.x = cvt_pk_bf16(o[db][4 * g] * f, o[db][4 * g + 1] * f); w.y = cvt_pk_bf16(o[db][4 * g + 2] * f, o[db][4 * g + 3] * f);
                *(v2u*)(O + orow + h * 64 + d) = w; }
        ATT_WAIT_BAR(0);
    }
#undef ATT_ISSUE
}
#undef ATT_WAIT_BAR
}

struct Args { Ptrs P; int ph_lo, ph_hi; };
struct Frame { LAS unsigned char* lds; volatile LAS unsigned* MISC; gu32* ctl; int tid, lane, wave, vcu, G; };

__device__ __forceinline__ void norm_row(const float* xrow, const float* g, const float* mb, int sh_off, int sc_off, bf16* hrow, int lane) {
    f32x4 v[4]; float ss = 0.f;
#pragma unroll
    for (int j = 0; j < 4; ++j) { v[j] = ((const f32x4*)xrow)[lane + 64 * j]; ss += (v[j][0] * v[j][0] + v[j][1] * v[j][1]) + (v[j][2] * v[j][2] + v[j][3] * v[j][3]); }
    const float inv = rsqrtf(wave_sum(ss) * (1.f / D) + NORM_EPS);
#pragma unroll
    for (int j = 0; j < 4; ++j) { const int c0 = (lane + 64 * j) * 4;
        const f32x4 gg = *(const f32x4*)(g + c0), sc = *(const f32x4*)(mb + sc_off + c0), sh = *(const f32x4*)(mb + sh_off + c0);
        const f32x4 o = v[j] * inv * gg * (sc + 1.f) + sh;
        v2u w; w.x = cvt_pk_bf16(o[0], o[1]); w.y = cvt_pk_bf16(o[2], o[3]); *(v2u*)(hrow + c0) = w; }
}
__device__ __forceinline__ void route_row(int row, const float* xin, const float* g, const float* mb, int sh_off, int sc_off, bf16* h, const float* rw, const float* rb, unsigned* cnt, unsigned* ltok, float* lw, int lane) {
    float hv[16]; float ss = 0.f;
#pragma unroll
    for (int j = 0; j < 4; ++j) { const f32x4 v = ((const f32x4*)(xin + (size_t)row * D))[lane + 64 * j]; hv[4 * j] = v[0]; hv[4 * j + 1] = v[1]; hv[4 * j + 2] = v[2]; hv[4 * j + 3] = v[3]; ss += (v[0] * v[0] + v[1] * v[1]) + (v[2] * v[2] + v[3] * v[3]); }
    const float inv = rsqrtf(wave_sum(ss) * (1.f / D) + NORM_EPS);
    float lg[16];
#pragma unroll
    for (int e = 0; e < 16; ++e) lg[e] = 0.f;
#pragma unroll
    for (int j = 0; j < 4; ++j) {
        const int c0 = (lane + 64 * j) * 4;
        const f32x4 gg = *(const f32x4*)(g + c0), sc = *(const f32x4*)(mb + sc_off + c0), sh = *(const f32x4*)(mb + sh_off + c0);
#pragma unroll
        for (int i = 0; i < 4; ++i) hv[4 * j + i] = hv[4 * j + i] * inv * gg[i] * (1.f + sc[i]) + sh[i];
        v2u w; w.x = cvt_pk_bf16(hv[4 * j], hv[4 * j + 1]); w.y = cvt_pk_bf16(hv[4 * j + 2], hv[4 * j + 3]);
        *(v2u*)(h + (size_t)row * D + c0) = w;
#pragma unroll
        for (int i = 0; i < 4; ++i) { const f32x4* wr = (const f32x4*)(rw + (size_t)(c0 + i) * NE); const float x = hv[4 * j + i];
#pragma unroll
            for (int q = 0; q < 4; ++q) { const f32x4 w4 = wr[q]; lg[4 * q] += x * w4[0]; lg[4 * q + 1] += x * w4[1]; lg[4 * q + 2] += x * w4[2]; lg[4 * q + 3] += x * w4[3]; } }
    }
#pragma unroll
    for (int e = 0; e < 16; ++e) lg[e] = wave_sum(lg[e]);
    if (lane == 0) {
        float sc[16], sel[16];
#pragma unroll
        for (int e = 0; e < 16; ++e) { sc[e] = 1.f / (1.f + __expf(-lg[e])); sel[e] = sc[e] + rb[e]; }
        int bg = 0; float bgs = -3e38f;
#pragma unroll
        for (int gi = 0; gi < 4; ++gi) {
            float m1 = -3e38f, m2 = -3e38f;
#pragma unroll
            for (int i = 0; i < 4; ++i) { const float v = sel[gi * 4 + i]; if (v > m1) { m2 = m1; m1 = v; } else if (v > m2) m2 = v; }
            const float gs = m1 + m2; if (gs > bgs) { bgs = gs; bg = gi; }
        }
        int e0 = 0, e1 = 0; float s0 = -3e38f, s1 = -3e38f, w0 = 0.f, w1 = 0.f;
#pragma unroll
        for (int gi = 0; gi < 4; ++gi) if (gi == bg) {
#pragma unroll
            for (int i = 0; i < 4; ++i) { const int e = gi * 4 + i; const float v = sel[e];
                if (v > s0) { s1 = s0; e1 = e0; w1 = w0; s0 = v; e0 = e; w0 = sc[e]; } else if (v > s1) { s1 = v; e1 = e; w1 = sc[e]; } }
        }
        const float ws = w0 + w1; w0 /= ws; w1 /= ws;
        const unsigned p0 = atomicAdd(&cnt[e0 * 64], 1u), p1 = atomicAdd(&cnt[e1 * 64], 1u);
        ltok[(size_t)e0 * T + p0] = (unsigned)row; lw[(size_t)e0 * T + p0] = w0;
        ltok[(size_t)e1 * T + p1] = (unsigned)row | 0x80000000u; lw[(size_t)e1 * T + p1] = w1;
    }
}
__device__ __forceinline__ void route_phase(Frame& F, const float* xin, const float* g, const float* mod_l, bf16* h, const float* rw, const float* rb, unsigned* cnt, unsigned* ltok, float* lw) {
    LAS float* rws = (LAS float*)F.lds;
    LAS unsigned* lcnt = (LAS unsigned*)(F.lds + 65536);
    const int lane = F.lane, e_l = lane & 15;
    for (int t = F.tid; t < 1024 * 4; t += NWAVES * 64) { const int k = t >> 2, q = t & 3; const f32x4 v = *(const f32x4*)(rw + (size_t)k * NE + 4 * q);
        const int j = k >> 8, ln = (k >> 2) & 63, i = k & 3; *(LAS f32x4*)(rws + ((((j * 4 + i) * 4 + q) * 64 + ln) * 4)) = v; }
    const float rbe = rb[e_l];
    for (int chunk = F.vcu; chunk < T / 64; chunk += F.G) {
        if (F.tid < 16) lcnt[F.tid] = 0u;
        __syncthreads();
        const int row0 = chunk * 64 + F.wave * 8, b = row0 / SEQ;
        const float* mb = mod_l + b * 6 * D;
        f32x4 Gm[4], Sh[4];
#pragma unroll
        for (int j = 0; j < 4; ++j) { const int c0 = (lane + 64 * j) * 4; const f32x4 gg = *(const f32x4*)(g + c0), sc = *(const f32x4*)(mb + 4 * D + c0); Gm[j] = gg * (sc + 1.f); Sh[j] = *(const f32x4*)(mb + 3 * D + c0); }
        unsigned s_tok[2], s_pl[2]; float s_w[2]; bool s_sel[2];
#pragma unroll
        for (int grp = 0; grp < 2; ++grp) {
            const int r0 = row0 + grp * 4;
            f32x4 xv[4][4];
#pragma unroll
            for (int r = 0; r < 4; ++r)
#pragma unroll
                for (int j = 0; j < 4; ++j) xv[r][j] = *(const f32x4*)(xin + (size_t)(r0 + r) * D + (lane + 64 * j) * 4);
            float ss[4];
#pragma unroll
            for (int r = 0; r < 4; ++r) { ss[r] = 0.f;
#pragma unroll
                for (int j = 0; j < 4; ++j) ss[r] += (xv[r][j][0] * xv[r][j][0] + xv[r][j][1] * xv[r][j][1]) + (xv[r][j][2] * xv[r][j][2] + xv[r][j][3] * xv[r][j][3]); }
#pragma unroll
            for (int o = 1; o < 64; o <<= 1)
#pragma unroll
                for (int r = 0; r < 4; ++r) ss[r] += __shfl_xor(ss[r], o);
#pragma unroll
            for (int r = 0; r < 4; ++r) { const float inv = rsqrtf(ss[r] * (1.f / D) + NORM_EPS);
#pragma unroll
                for (int j = 0; j < 4; ++j) { xv[r][j] = xv[r][j] * inv * Gm[j] + Sh[j];
                    v2u w; w.x = cvt_pk_bf16(xv[r][j][0], xv[r][j][1]); w.y = cvt_pk_bf16(xv[r][j][2], xv[r][j][3]); *(v2u*)(h + (size_t)(r0 + r) * D + (lane + 64 * j) * 4) = w; } }
            float acc[64];
#pragma unroll
            for (int v = 0; v < 64; ++v) acc[v] = 0.f;
#pragma unroll
            for (int j = 0; j < 4; ++j)
#pragma unroll
                for (int i = 0; i < 4; ++i) {
                    f32x4 wq[4];
#pragma unroll
                    for (int q = 0; q < 4; ++q) wq[q] = *(const LAS f32x4*)(rws + ((((j * 4 + i) * 4 + q) * 64 + lane) * 4));
#pragma unroll
                    for (int r = 0; r < 4; ++r) { const float x = xv[r][j][i];
#pragma unroll
                        for (int q = 0; q < 4; ++q)
#pragma unroll
                            for (int c = 0; c < 4; ++c) acc[r * 16 + q * 4 + c] += x * wq[q][c]; } }
#pragma unroll
            for (int s = 32; s >= 1; s >>= 1) { const bool up = (lane & s) != 0;
#pragma unroll
                for (int v = 0; v < s; ++v) { const float a = acc[v], bq = acc[v + s]; const float keep = up ? bq : a, send = up ? a : bq; acc[v] = keep + __shfl_xor(send, s); } }
            const float sc = 1.f / (1.f + __expf(-acc[0])), sel = sc + rbe;
            const int q0 = lane & ~3, me = lane & 3, myg = (lane >> 2) & 3;
            float v4[4], s4[4];
#pragma unroll
            for (int i = 0; i < 4; ++i) { v4[i] = __shfl(sel, q0 + i); s4[i] = __shfl(sc, q0 + i); }
            float m1 = -3e38f, m2 = -3e38f;
#pragma unroll
            for (int i = 0; i < 4; ++i) { const float x = v4[i]; if (x > m1) { m2 = m1; m1 = x; } else if (x > m2) m2 = x; }
            const float gs = m1 + m2;
            int bg = 0; float best = -3e38f;
#pragma unroll
            for (int gi = 0; gi < 4; ++gi) { const float x = __shfl(gs, (lane & ~15) + 4 * gi); if (x > best) { best = x; bg = gi; } }
            int myrank = 0; float scsum = 0.f;
#pragma unroll
            for (int i = 0; i < 4; ++i) { int rk = 0;
#pragma unroll
                for (int j = 0; j < 4; ++j) if (j != i) rk += (v4[j] > v4[i] || (v4[j] == v4[i] && j < i)) ? 1 : 0;
                if (rk < 2) scsum += s4[i];
                if (i == me) myrank = rk; }
            const bool selected = (myg == bg) && (myrank < 2);
            s_sel[grp] = selected; s_w[grp] = sc / scsum; s_tok[grp] = (unsigned)(r0 + (lane >> 4)) | ((unsigned)myrank << 31); s_pl[grp] = 0u;
            if (selected) s_pl[grp] = __hip_atomic_fetch_add(lcnt + e_l, 1u, __ATOMIC_RELAXED, __HIP_MEMORY_SCOPE_WORKGROUP);
        }
        __syncthreads();
        if (F.tid < 16) lcnt[16 + F.tid] = atomicAdd(&cnt[F.tid * 64], lcnt[F.tid]);
        __syncthreads();
#pragma unroll
        for (int grp = 0; grp < 2; ++grp) if (s_sel[grp]) { const size_t idx = (size_t)e_l * T + lcnt[16 + e_l] + s_pl[grp]; ltok[idx] = s_tok[grp]; lw[idx] = s_w[grp]; }
        __syncthreads();
    }
}
__device__ __forceinline__ void combine_row(int row, float* xio, const bf16* ybuf, const float* gate, bool do_norm, const float* g, const float* mbn, bf16* h, int lane) {
    f32x4 v[4]; float ss = 0.f;
#pragma unroll
    for (int j = 0; j < 4; ++j) { const int c0 = (lane + 64 * j) * 4;
        v[j] = *(const f32x4*)(xio + (size_t)row * D + c0);
        const v2u y0 = *(const v2u*)(ybuf + (size_t)row * D + c0), y1 = *(const v2u*)(ybuf + ((size_t)T + row) * D + c0);
        const f32x4 gt = *(const f32x4*)(gate + c0);
        v[j][0] += gt[0] * (bf2f(y0.x) + bf2f(y1.x)); v[j][1] += gt[1] * (bf2f(y0.x >> 16) + bf2f(y1.x >> 16)); v[j][2] += gt[2] * (bf2f(y0.y) + bf2f(y1.y)); v[j][3] += gt[3] * (bf2f(y0.y >> 16) + bf2f(y1.y >> 16));
        *(f32x4*)(xio + (size_t)row * D + c0) = v[j];
        ss += (v[j][0] * v[j][0] + v[j][1] * v[j][1]) + (v[j][2] * v[j][2] + v[j][3] * v[j][3]); }
    if (do_norm) {
        const float inv = rsqrtf(wave_sum(ss) * (1.f / D) + NORM_EPS);
#pragma unroll
        for (int j = 0; j < 4; ++j) { const int c0 = (lane + 64 * j) * 4;
            const f32x4 gg = *(const f32x4*)(g + c0), sc = *(const f32x4*)(mbn + D + c0), sh = *(const f32x4*)(mbn + c0);
            const f32x4 o = v[j] * inv * gg * (sc + 1.f) + sh;
            v2u w; w.x = cvt_pk_bf16(o[0], o[1]); w.y = cvt_pk_bf16(o[2], o[3]); *(v2u*)(h + (size_t)row * D + c0) = w; }
    }
}

template <class RowMap>
__device__ __forceinline__ void transpose_item(const float* W, int K, int N, bf16* WT, RowMap rm, LAS float* scr, int item, int lane) {
    const int nblk = N / 32, kb = item / nblk, nb = item % nblk, k0 = 64 * kb, n0 = 32 * nb;
#pragma unroll 8
    for (int i = 0; i < 32; ++i) { const int kk = 2 * i + (lane >> 5); scr[kk * 33 + (lane & 31)] = W[(size_t)(k0 + kk) * N + n0 + (lane & 31)]; }
    LDS_WAIT(); asm volatile("" ::: "memory");
    const int c = lane & 7;
#pragma unroll
    for (int j = 0; j < 4; ++j) { const int n = (lane >> 3) + 8 * j; const LAS float* s = scr + (8 * c) * 33 + n;
        v4u o; o.x = cvt_pk_bf16(s[0 * 33], s[1 * 33]); o.y = cvt_pk_bf16(s[2 * 33], s[3 * 33]); o.z = cvt_pk_bf16(s[4 * 33], s[5 * 33]); o.w = cvt_pk_bf16(s[6 * 33], s[7 * 33]);
        *(v4u*)(WT + (size_t)rm(n0 + n) * K + k0 + 8 * c) = o; }
    LDS_WAIT(); asm volatile("" ::: "memory");
}
struct RmId { __device__ __forceinline__ int operator()(int n) const { return n; } };
struct RmQkv { __device__ __forceinline__ int operator()(int n) const { return (n & ~255) + 128 * ((n >> 5) & 1) + 32 * ((n >> 6) & 3) + (n & 31); } };
struct RmGU { int add; __device__ __forceinline__ int operator()(int n) const { return 256 * (n >> 7) + (n & 127) + add; } };

__device__ __forceinline__ int t5_bucket_fast(int rel) {
    const int ret = rel > 0 ? 16 : 0; const int n = rel < 0 ? -rel : rel;
    const int large = 8 + (n >= 15) + (n >= 27) + (n >= 50) + (n >= 91) + (n >= 166) + (n >= 305) + (n >= 559);
    return ret + (n < 8 ? n : large);
}
constexpr int TABA_N = 768, TABB_N = 416;
constexpr int MISC_TABA = 64, MISC_TABB = MISC_TABA + 8 * TABA_N;

__device__ __forceinline__ void p0_prologue(Frame& F, const Ptrs& P) {
    const int gw = F.vcu * NWAVES + F.wave, NGW = F.G * NWAVES, lane = F.lane;
    float* mod = (float*)(P.ws + WS_MOD); float* misc = (float*)(P.ws + WS_MISC);
    for (int it = gw; it < DEPTH * 384; it += NGW) {
        const int l = it / 384, n0 = (it % 384) * 16, kq = lane >> 2, cq = lane & 3;
        f32x4 a0 = {0.f, 0.f, 0.f, 0.f}, a1 = {0.f, 0.f, 0.f, 0.f};
#pragma unroll 8
        for (int i = 0; i < 64; ++i) { const int k = kq + 16 * i; const f32x4 w4 = *(const f32x4*)(P.ada_w + ((size_t)l * D + k) * (6 * D) + n0 + 4 * cq);
            const float c0 = P.c[k], c1 = P.c[D + k]; const float s0 = c0 / (1.f + __expf(-c0)), s1 = c1 / (1.f + __expf(-c1)); a0 += w4 * s0; a1 += w4 * s1; }
#pragma unroll
        for (int o = 4; o < 64; o <<= 1)
#pragma unroll
            for (int i = 0; i < 4; ++i) { a0[i] += __shfl_xor(a0[i], o); a1[i] += __shfl_xor(a1[i], o); }
        if (kq == 0) { const f32x4 bb = *(const f32x4*)(P.ada_b + l * 6 * D + n0 + 4 * cq);
            *(f32x4*)(mod + (l * 2 + 0) * 6 * D + n0 + 4 * cq) = a0 + bb; *(f32x4*)(mod + (l * 2 + 1) * 6 * D + n0 + 4 * cq) = a1 + bb; }
    }
    if (gw == NGW - 1 && lane == 0) { float s01 = 0.f, s23 = 0.f;
        for (int d = 0; d < 64; ++d) { s01 += P.a_lambda[d] * P.a_lambda[64 + d]; s23 += P.a_lambda[128 + d] * P.a_lambda[192 + d]; }
        misc[0] = __expf(s01) - __expf(s23) + 0.2f; }
    for (int i = gw * 64 + lane; i < 8 * TABA_N + 16 * TABB_N; i += NGW * 64) {
        if (i < 8 * TABA_N) { const int h = i / TABA_N, rel = i % TABA_N - 704; misc[MISC_TABA + i] = (P.t5_bias[t5_bucket_fast(rel) * 8 + h] - P.t5_bias[15 * 8 + h]) * LOG2E; }
        else { const int j = i - 8 * TABA_N, h = j / TABB_N; int rel = j % TABB_N - 352; rel = rel < -256 ? -256 : (rel > 256 ? 256 : rel);
            misc[MISC_TABB + j] = (P.b_rel_bias[h * 513 + rel + 256] - P.b_rel_bias[h * 513]) * LOG2E; }
    }
    LAS float* scr = (LAS float*)(F.lds + F.wave * 16384);
    constexpr int I_QKV = 16 * 96, I_WO = 16 * 32, I_E = 256, I_DENSE = 2 * (I_QKV + I_WO), NITEMS = I_DENSE + DEPTH * NE * 3 * I_E;
    for (int it = gw; it < NITEMS; it += NGW) {
        int r = it;
        if (r < I_QKV) { transpose_item(P.a_w_qkv, D, 3 * D, (bf16*)(P.ws + WS_WQKV_A), RmQkv{}, scr, r, lane); continue; } r -= I_QKV;
        if (r < I_WO) { transpose_item(P.a_w_o, D, D, (bf16*)(P.ws + WS_WO_A), RmId{}, scr, r, lane); continue; } r -= I_WO;
        if (r < I_QKV) { transpose_item(P.b_w_qkv, D, 3 * D, (bf16*)(P.ws + WS_WQKV_B), RmQkv{}, scr, r, lane); continue; } r -= I_QKV;
        if (r < I_WO) { transpose_item(P.b_w_o, D, D, (bf16*)(P.ws + WS_WO_B), RmId{}, scr, r, lane); continue; } r -= I_WO;
        const int le = r / (3 * I_E), which = (r / I_E) % 3, item = r % I_E;
        if (which == 0) transpose_item(P.moe_w_gate + (size_t)le * D * FF, D, FF, (bf16*)(P.ws + WS_WGU) + (size_t)le * 1024 * D, RmGU{0}, scr, item, lane);
        else if (which == 1) transpose_item(P.moe_w_up + (size_t)le * D * FF, D, FF, (bf16*)(P.ws + WS_WGU) + (size_t)le * 1024 * D, RmGU{128}, scr, item, lane);
        else transpose_item(P.moe_w_down + (size_t)le * FF * D, FF, D, (bf16*)(P.ws + WS_WD) + (size_t)le * D * FF, RmId{}, scr, item, lane);
    }
}

__device__ __forceinline__ void moe_prep(Frame& F, const unsigned* cnt) {
    LAS unsigned* tab = (LAS unsigned*)(F.lds + TAB_OFF);
    if (F.tid == 0) { int rt = 0, base = 0;
        for (int e = 0; e < NE; ++e) { const int c = (int)cnt[e * 64]; const int ntl = (c + 255) >> 8; tab[160 + e] = (unsigned)base; tab[176 + e] = (unsigned)c;
            for (int i = 0; i < ntl; ++i) tab[1 + rt + i] = (unsigned)e | ((unsigned)i << 8);
            rt += ntl; base += ntl * 256; }
        tab[0] = (unsigned)rt; }
    __syncthreads();
}

#ifndef REP_P0
#define REP_P0 1
#endif
#ifndef REP_QKV
#define REP_QKV 1
#endif
#ifndef REP_ATT0
#define REP_ATT0 1
#endif
#ifndef REP_ATT1
#define REP_ATT1 1
#endif
#ifndef REP_WO0
#define REP_WO0 1
#endif
#ifndef REP_UP
#define REP_UP 1
#endif
#ifndef REP_DOWN
#define REP_DOWN 1
#endif
#ifndef REP_NORM1
#define REP_NORM1 1
#endif
#ifndef REP_ROUTE
#define REP_ROUTE 1
#endif
#ifndef REP_BAR
#define REP_BAR 1
#endif
#ifndef DBG_EN
#define DBG_EN 0x1FFu
#endif
#define EN(j) ((DBG_EN >> (j)) & 1u)
#define IN(k) (lo <= (k) && (k) < hi)
#define SEAM(k) do { if (IN(k) && IN((k) + 1)) { xcd_barrier(bar); if (REP_BAR > 1) xcd_barrier(bar); } } while (0)
template <int l>
__device__ __forceinline__ void run_layer(Frame& F, const Ptrs& P, const XcdBarrier& bar, const int lo, const int hi) {
    unsigned char* ws = P.ws;
    float* mod = (float*)(ws + WS_MOD); const float* misc = (const float*)(ws + WS_MISC);
    bf16 *H = (bf16*)(ws + WS_H), *Qb = (bf16*)(ws + WS_Q), *Kb = (bf16*)(ws + WS_K), *Vb = (bf16*)(ws + WS_V), *Y = (bf16*)(ws + WS_Y), *HE = (bf16*)(ws + WS_HE);
    const int gw = F.vcu * NWAVES + F.wave, NGW = F.G * NWAVES;
    {
        const int pb = 2 + 7 * l;
        const float* mod_l = mod + l * 2 * 6 * D;
        const float* xin = (l == 0) ? P.x : P.out;
#define QKV_BODY { g8::DenseOrder S; S.init(T, 3 * D, F.G, (int)blockIdx.x); \
            g8::EpiQKV E{Qb, (size_t)(WS_K - WS_Q) / 2, l == 0 ? P.a_q_gain : P.b_q_gain, l == 0 ? P.a_k_gain : P.b_k_gain}; \
            g8::gemm_phase(F.lds, H, (const bf16*)(ws + (l == 0 ? WS_WQKV_A : WS_WQKV_B)), D, S, E); }
        if (EN(2) && IN(pb + 0)) {
            QKV_BODY
            if (REP_QKV > 1) QKV_BODY
        } SEAM(pb + 0);
        if (EN(3) && IN(pb + 1)) for (int rep = 0; rep < (l == 0 ? REP_ATT0 : REP_ATT1); ++rep) {
            if (l == 0) {
                const float lam = misc[0];
                if (F.G == 256) { const int bh = F.vcu >> 4, s = F.vcu & 15;
                    for (int i = 0; i < 4; ++i) { const int qb = (i == 0) ? s : (i == 1) ? 31 - s : (i == 2) ? 32 + s : 63 - s; att::attn_unit<0>(bh >> 3, bh & 7, qb, Qb, Kb, Vb, H, F.lds, misc + MISC_TABA, lam, P.a_subln_g); } }
                else for (int u = (int)blockIdx.x; u < 1024; u += F.G) att::attn_unit<0>(u >> 9, (u >> 6) & 7, u & 63, Qb, Kb, Vb, H, F.lds, misc + MISC_TABA, lam, P.a_subln_g);
            } else {
                if (F.G == 256) { const int bh = F.vcu >> 3;
                    for (int i = 0; i < 4; ++i) att::attn_unit<1>(bh >> 4, bh & 15, (F.vcu & 7) * 4 + i, Qb, Kb, Vb, H, F.lds, misc + MISC_TABB, 0.f, nullptr); }
                else for (int u = (int)blockIdx.x; u < 1024; u += F.G) att::attn_unit<1>(u >> 9, (u >> 5) & 15, u & 31, Qb, Kb, Vb, H, F.lds, misc + MISC_TABB, 0.f, nullptr);
            }
        } SEAM(pb + 1);
#define WO_BODY { g8::DenseOrder S; S.init(T, D, F.G, (int)blockIdx.x); \
            g8::EpiWo E{xin, mod_l + 2 * D, P.out}; \
            g8::gemm_phase(F.lds, H, (const bf16*)(ws + (l == 0 ? WS_WO_A : WS_WO_B)), D, S, E); }
        if (EN(4) && IN(pb + 2)) {
            WO_BODY
            if (l == 0 && REP_WO0 > 1) WO_BODY
        } SEAM(pb + 2);
        unsigned* cnt = (unsigned*)(F.ctl + CW_CNT + l * 16 * 64); unsigned* ltok = (unsigned*)(ws + WS_LTOK) + (size_t)l * NE * T; float* lw = (float*)(ws + WS_LW) + (size_t)l * NE * T;
        if (EN(5) && IN(pb + 3)) {
            route_phase(F, P.out, P.norm_ffn_g + l * D, mod_l, H, P.router_w, P.router_bias, cnt, ltok, lw);
            if (REP_ROUTE > 1) route_phase(F, P.out, P.norm_ffn_g + l * D, mod_l, H, P.router_w, P.router_bias, (unsigned*)(F.ctl + CW_CNT + 2 * 16 * 64), (unsigned*)(ws + WS_HE), (float*)(ws + WS_HE + 2 * MiB));
        } SEAM(pb + 3);
        if (EN(6) && IN(pb + 4)) for (int rep = 0; rep < REP_UP; ++rep) {
            moe_prep(F, cnt);
            g8::MoeOrder<true> S{(const LAS unsigned*)(F.lds + TAB_OFF), ltok, F.G, (int)blockIdx.x};
            g8::EpiUp E{HE};
            g8::gemm_phase(F.lds, H, (const bf16*)(ws + WS_WGU) + (size_t)l * NE * 1024 * D, D, S, E);
        } SEAM(pb + 4);
        if (EN(7) && IN(pb + 5)) for (int rep = 0; rep < REP_DOWN; ++rep) {
            moe_prep(F, cnt);
            g8::MoeOrder<false> S{(const LAS unsigned*)(F.lds + TAB_OFF), ltok, F.G, (int)blockIdx.x};
            g8::EpiDown E{ltok, lw, Y};
            g8::gemm_phase(F.lds, HE, (const bf16*)(ws + WS_WD) + (size_t)l * NE * D * FF, FF, S, E);
        } SEAM(pb + 5);
        if (EN(8) && IN(pb + 6)) {
            const bool dn = (l + 1 < DEPTH);
            for (int row = gw; row < T; row += NGW) combine_row(row, P.out, Y, mod_l + (row / SEQ) * 6 * D + 5 * D, dn, P.norm_mix_g + (dn ? (l + 1) : 0) * D, mod + ((dn ? (l + 1) : 0) * 2 + row / SEQ) * 6 * D, H, F.lane);
        } SEAM(pb + 6);
    }
}
__global__ void __launch_bounds__(NWAVES * 64, 2) mk_fwd(Args args) {
    extern __shared__ __attribute__((aligned(16))) unsigned char lds[];
    Frame F;
    F.lds = (LAS unsigned char*)lds; F.MISC = (volatile LAS unsigned*)(F.lds + MISC_OFF);
    F.tid = threadIdx.x; F.lane = F.tid & 63; F.wave = __builtin_amdgcn_readfirstlane(F.tid >> 6);
    F.G = gridDim.x; { const int bx = blockIdx.x; F.vcu = (F.G % 8 == 0) ? (bx % 8) * (F.G / 8) + bx / 8 : bx; }
    const Ptrs& P = args.P;
    unsigned char* ws = P.ws;
    F.ctl = (gu32*)(ws + WS_CTL);
    for (int u = F.tid; u < (LDS_BYTES - LDSCTL_OFF) / 4; u += NWAVES * 64) ((LAS unsigned*)(F.lds + LDSCTL_OFF))[u] = 0u;
    __syncthreads();
    const int lo = args.ph_lo, hi = args.ph_hi;
    const bool multi = (hi - lo) > 1;
    XcdBarrier bar; bar.bar = (unsigned*)(F.ctl + CW_BAR); bar.x = 0; bar.st = nullptr;
    if (multi) bar = xcd_barrier_post((unsigned*)(F.ctl + CW_BAR), F.MISC + 8);
    float* mod = (float*)(ws + WS_MOD); const float* misc = (const float*)(ws + WS_MISC);
    bf16 *H = (bf16*)(ws + WS_H), *Qb = (bf16*)(ws + WS_Q), *Kb = (bf16*)(ws + WS_K), *Vb = (bf16*)(ws + WS_V), *Y = (bf16*)(ws + WS_Y), *HE = (bf16*)(ws + WS_HE);
    const int gw = F.vcu * NWAVES + F.wave, NGW = F.G * NWAVES;

    if (EN(0) && IN(0)) { for (int rep = 0; rep < REP_P0; ++rep) p0_prologue(F, P); } SEAM(0);
    if (EN(1) && IN(1)) for (int rep = 0; rep < REP_NORM1; ++rep) { for (int row = gw; row < T; row += NGW) norm_row(P.x + (size_t)row * D, P.norm_mix_g, mod + (row / SEQ) * 6 * D, 0, D, H + (size_t)row * D, F.lane); } SEAM(1);

    run_layer<0>(F, P, bar, lo, hi);
    run_layer<1>(F, P, bar, lo, hi);
#undef IN
#undef SEAM
}
#ifndef FASTMASK
#define FASTMASK 0xFFFFu
#endif
#ifndef ONE_LAUNCH
#define ONE_LAUNCH 1
#endif
extern "C" void kernel_launch(void* const* d_in, const int* in_sizes, int n_in, void* d_out, int out_size, void* d_ws, size_t ws_size, hipStream_t stream) {
    static int grid = 0;
    if (grid == 0) {
        if (n_in != 23 || out_size != T * D || ws_size < WS_END) { fprintf(stderr, "kernel_launch: unexpected shapes (n_in %d out %d ws %zu)\n", n_in, out_size, ws_size); grid = -1; return; }
        int dev = 0, cus = 0, per_cu = 0;
        if (hipGetDevice(&dev) != hipSuccess || hipDeviceGetAttribute(&cus, hipDeviceAttributeMultiprocessorCount, dev) != hipSuccess) { grid = -1; return; }
        if (hipFuncSetAttribute((const void*)mk_fwd, hipFuncAttributeMaxDynamicSharedMemorySize, LDS_BYTES) != hipSuccess) { fprintf(stderr, "kernel_launch: hipFuncSetAttribute failed\n"); grid = -1; return; }
        if (hipOccupancyMaxActiveBlocksPerMultiprocessor(&per_cu, (const void*)mk_fwd, NWAVES * 64, LDS_BYTES) != hipSuccess || per_cu < 1) fprintf(stderr, "kernel_launch: occupancy query reports %d\n", per_cu);
        (void)hipGetLastError();
        grid = cus;
    }
    if (grid < 0) return;
    Args a{};
    const float** pp = (const float**)&a.P;
    for (int i = 0; i < 23; ++i) pp[i] = (const float*)d_in[i];
    a.P.out = (float*)d_out; a.P.ws = (unsigned char*)d_ws;
    const Ptrs& P = a.P;
    unsigned char* ws = P.ws;
    (void)hipMemsetAsync(ws + WS_CTL, 0, CTL_ZERO_BYTES, stream);
#if ONE_LAUNCH
    a.ph_lo = 0; a.ph_hi = 16;
    hipLaunchKernelGGL(mk_fwd, dim3(grid), dim3(NWAVES * 64), LDS_BYTES, stream, a);
#else
    float* mod = (float*)(ws + WS_MOD); float* misc = (float*)(ws + WS_MISC);
    bf16 *H = (bf16*)(ws + WS_H), *Q = (bf16*)(ws + WS_Q), *Kb = (bf16*)(ws + WS_K), *V = (bf16*)(ws + WS_V), *Y = (bf16*)(ws + WS_Y), *HE = (bf16*)(ws + WS_HE);
    unsigned* ctl = (unsigned*)(ws + WS_CTL);
#define FAST(p) ((FASTMASK >> (p)) & 1u)
#define RUNFAST(p) do { a.ph_lo = (p); a.ph_hi = (p) + 1; hipLaunchKernelGGL(mk_fwd, dim3(grid), dim3(NWAVES * 64), LDS_BYTES, stream, a); } while (0)
    if (FASTMASK != 0u) RUNFAST(0);
    if (!FAST(0)) k_adaln<<<(DEPTH * 6 * D + 255) / 256, 256, 0, stream>>>(P);
    if (FAST(1)) RUNFAST(1); else k_norm<<<T, 256, 0, stream>>>(P.x, P.norm_mix_g, mod, 0, D, H);
    for (int l = 0; l < DEPTH; ++l) {
        const int pb = 2 + 7 * l;
        const float* mod_l = mod + l * 2 * 6 * D;
        const float* xin = (l == 0) ? P.x : P.out;
        if (FAST(pb + 0)) RUNFAST(pb + 0); else { ProbQKV pq{H, l == 0 ? P.a_w_qkv : P.b_w_qkv, l == 0 ? P.a_q_gain : P.b_q_gain, l == 0 ? P.a_k_gain : P.b_k_gain, Q, Kb, V, D, 0, 0}; k_slow_gemm<ProbQKV><<<(T / 64) * 48, 256, 0, stream>>>(pq); }
        if (FAST(pb + 1)) RUNFAST(pb + 1); else { if (l == 0) k_slow_attnA<<<BATCH * 8 * (SEQ / 32), 64, 0, stream>>>(Q, Kb, V, P.t5_bias, misc, P.a_subln_g, H); else k_slow_attnB<<<BATCH * 16 * (SEQ / 64), 64, 0, stream>>>(Q, Kb, V, P.b_rel_bias, H); }
        if (FAST(pb + 2)) RUNFAST(pb + 2); else { ProbWo pw{H, l == 0 ? P.a_w_o : P.b_w_o, xin, mod_l + 2 * D, P.out, D, 0, 0}; k_slow_gemm<ProbWo><<<(T / 64) * 16, 256, 0, stream>>>(pw); }
        unsigned* cnt = ctl + CW_CNT + l * 16 * 64; unsigned* ltok = (unsigned*)(ws + WS_LTOK) + (size_t)l * NE * T; float* lw = (float*)(ws + WS_LW) + (size_t)l * NE * T;
        if (FAST(pb + 3)) RUNFAST(pb + 3); else k_norm_route<<<T / 4, 256, 0, stream>>>(P.out, P.norm_ffn_g + l * D, mod_l, 3 * D, 4 * D, H, P.router_w, P.router_bias, cnt, ltok, lw);
        if (FAST(pb + 4)) RUNFAST(pb + 4); else { ProbUp pu{H, P.moe_w_gate + (size_t)l * NE * D * FF, P.moe_w_up + (size_t)l * NE * D * FF, cnt, ltok, HE, D, 0, 0, 0, 0, 0}; k_slow_gemm<ProbUp><<<NE * 256 * 8, 256, 0, stream>>>(pu); }
        if (FAST(pb + 5)) RUNFAST(pb + 5); else { ProbDown pd{HE, P.moe_w_down + (size_t)l * NE * FF * D, cnt, ltok, lw, Y, FF, 0, 0, 0, 0, 0}; k_slow_gemm<ProbDown><<<NE * 256 * 16, 256, 0, stream>>>(pd); }
        const int nl = l + 1;
        if (FAST(pb + 6)) RUNFAST(pb + 6); else k_combine<<<T, 256, 0, stream>>>(P.out, Y, mod_l + 5 * D, nl < DEPTH ? 1 : 0, P.norm_mix_g + (nl < DEPTH ? nl : 0) * D, mod + (nl < DEPTH ? nl : 0) * 2 * 6 * D, 0, D, H);
    }
#endif
}
```

```cpp
#define FASTMASK 0xFFFFu
#define ONE_LAUNCH 1
#include <hip/hip_runtime.h>
#include <cstdio>
#include <cstdint>

constexpr int BATCH = 2, SEQ = 8192, D = 1024, T = BATCH * SEQ, DEPTH = 2;
constexpr int NE = 16, FF = 512;
constexpr float NORM_EPS = 1e-6f;
constexpr float LOG2E = 1.4426950408889634f;

typedef unsigned short bf16;
__device__ __forceinline__ unsigned f2bf(float f) { unsigned u = __builtin_bit_cast(unsigned, f); return (u + 0x7fffu + ((u >> 16) & 1u)) >> 16; }
__device__ __forceinline__ float bf2f(unsigned h) { return __builtin_bit_cast(float, (h & 0xffffu) << 16); }

constexpr size_t MiB = 1u << 20;
constexpr size_t WS_CTL = 0, CTL_ZERO_BYTES = 1 * MiB;
constexpr size_t WS_MOD = 1 * MiB;
constexpr size_t WS_MISC = WS_MOD + 128 * 1024;
constexpr size_t WS_LTOK = 2 * MiB;
constexpr size_t WS_LW = 4 * MiB;
constexpr size_t WS_WQKV_A = 8 * MiB, WS_WO_A = 14 * MiB, WS_WQKV_B = 16 * MiB, WS_WO_B = 22 * MiB;
constexpr size_t WS_WGU = 24 * MiB, WS_WD = 88 * MiB;
constexpr size_t WS_H = 120 * MiB;
constexpr size_t WS_Q = 152 * MiB, WS_K = 184 * MiB, WS_V = 216 * MiB;
constexpr size_t WS_Y = 152 * MiB;
constexpr size_t WS_HE = 216 * MiB;
constexpr size_t WS_END = 252 * MiB;
constexpr int HE_ROWS = 36864;
constexpr int CW_CNT = 1024;

struct Ptrs {
    const float *x, *c, *ada_w, *ada_b, *norm_mix_g, *norm_ffn_g, *t5_bias, *a_w_qkv, *a_q_gain, *a_k_gain, *a_lambda, *a_subln_g, *a_w_o,
        *b_w_qkv, *b_q_gain, *b_k_gain, *b_rel_bias, *b_w_o, *router_w, *router_bias, *moe_w_gate, *moe_w_up, *moe_w_down;
    float* out; unsigned char* ws;
};

__global__ void __launch_bounds__(256) k_adaln(Ptrs P) {
    __shared__ float sc[2][D];
    for (int i = threadIdx.x; i < 2 * D; i += 256) { const float v = P.c[i]; sc[i / D][i % D] = v / (1.f + __expf(-v)); }
    __syncthreads();
    const int idx = blockIdx.x * 256 + threadIdx.x;
    if (idx >= DEPTH * 6 * D) return;
    const int l = idx / (6 * D), n = idx % (6 * D);
    float a0 = 0.f, a1 = 0.f;
    for (int k = 0; k < D; ++k) { const float w = P.ada_w[((size_t)l * D + k) * (6 * D) + n]; a0 += sc[0][k] * w; a1 += sc[1][k] * w; }
    float* mod = (float*)(P.ws + WS_MOD);
    const float bb = P.ada_b[l * 6 * D + n];
    mod[(l * 2 + 0) * 6 * D + n] = a0 + bb; mod[(l * 2 + 1) * 6 * D + n] = a1 + bb;
    if (idx == 0) {
        float s01 = 0.f, s23 = 0.f;
        for (int d = 0; d < 64; ++d) { s01 += P.a_lambda[d] * P.a_lambda[64 + d]; s23 += P.a_lambda[128 + d] * P.a_lambda[192 + d]; }
        ((float*)(P.ws + WS_MISC))[0] = __expf(s01) - __expf(s23) + 0.2f;
    }
}

__device__ __forceinline__ float block_sum_256(float v, float* red) {
    for (int o = 32; o > 0; o >>= 1) v += __shfl_xor(v, o);
    __syncthreads();
    if ((threadIdx.x & 63) == 0) red[threadIdx.x >> 6] = v;
    __syncthreads();
    return red[0] + red[1] + red[2] + red[3];
}

__global__ void __launch_bounds__(256) k_norm(const float* xin, const float* g, const float* mod_l, int sh_off, int sc_off, bf16* h) {
    __shared__ float red[4];
    const int row = blockIdx.x, b = row / SEQ, t = threadIdx.x;
    const float4 v = ((const float4*)(xin + (size_t)row * D))[t];
    const float ss = block_sum_256(v.x * v.x + v.y * v.y + v.z * v.z + v.w * v.w, red);
    const float inv = rsqrtf(ss * (1.f / D) + NORM_EPS);
    const float* mb = mod_l + b * 6 * D;
    const float4 gg = ((const float4*)g)[t], sc = ((const float4*)(mb + sc_off))[t], sh = ((const float4*)(mb + sh_off))[t];
    const float o0 = v.x * inv * gg.x * (1.f + sc.x) + sh.x, o1 = v.y * inv * gg.y * (1.f + sc.y) + sh.y, o2 = v.z * inv * gg.z * (1.f + sc.z) + sh.z, o3 = v.w * inv * gg.w * (1.f + sc.w) + sh.w;
    uint2 w; w.x = f2bf(o0) | (f2bf(o1) << 16); w.y = f2bf(o2) | (f2bf(o3) << 16);
    ((uint2*)(h + (size_t)row * D))[t] = w;
}

template <class Prob> __global__ void __launch_bounds__(256) k_slow_gemm(Prob pb) {
    __shared__ float As[16][68], Bs[16][68];
    __shared__ float Cs[Prob::NPASS][64][65];
    if (!pb.setup(blockIdx.x)) return;
    const int tid = threadIdx.x, ty = tid >> 4, tx = tid & 15;
    for (int pass = 0; pass < Prob::NPASS; ++pass) {
        float acc[4][4];
#pragma unroll
        for (int i = 0; i < 4; ++i)
#pragma unroll
            for (int j = 0; j < 4; ++j) acc[i][j] = 0.f;
        for (int k0 = 0; k0 < pb.K; k0 += 16) {
            __syncthreads();
#pragma unroll
            for (int i = 0; i < 4; ++i) { const int e = tid + 256 * i; { const int r = e >> 4, k = e & 15; As[k][r] = pb.A(r, k0 + k); } { const int k = e >> 6, c = e & 63; Bs[k][c] = pb.B(pass, k0 + k, c); } }
            __syncthreads();
#pragma unroll
            for (int k = 0; k < 16; ++k) {
                float a[4], b[4];
#pragma unroll
                for (int i = 0; i < 4; ++i) { a[i] = As[k][ty * 4 + i]; b[i] = Bs[k][tx * 4 + i]; }
#pragma unroll
                for (int i = 0; i < 4; ++i)
#pragma unroll
                    for (int j = 0; j < 4; ++j) acc[i][j] += a[i] * b[j];
            }
        }
#pragma unroll
        for (int i = 0; i < 4; ++i)
#pragma unroll
            for (int j = 0; j < 4; ++j) Cs[pass][ty * 4 + i][tx * 4 + j] = acc[i][j];
    }
    __syncthreads();
    pb.epi(Cs, tid);
}

struct ProbQKV {
    static constexpr int NPASS = 1;
    const bf16* H; const float* W; const float* qg; const float* kg; bf16 *Q, *Kb, *V; int K;
    int m0, n0;
    __device__ bool setup(int bx) { m0 = (bx / 48) * 64; n0 = (bx % 48) * 64; return true; }
    __device__ float A(int r, int k) const { return bf2f(H[(size_t)(m0 + r) * D + k]); }
    __device__ float B(int, int k, int c) const { return W[(size_t)k * (3 * D) + n0 + c]; }
    __device__ void epi(float (*Cs)[64][65], int tid) const {
        const int r = tid >> 2, part = tid & 3;
        const int region = n0 / D, col0 = n0 % D;
        float ss = 0.f;
        for (int c = 0; c < 16; ++c) { const float v = Cs[0][r][part * 16 + c]; ss += v * v; }
        ss += __shfl_xor(ss, 1); ss += __shfl_xor(ss, 2);
        const float inv = rsqrtf(ss * (1.f / 64.f) + NORM_EPS);
        bf16* dst = (region == 0 ? Q : region == 1 ? Kb : V) + (size_t)(m0 + r) * D + col0;
        for (int c = 0; c < 16; ++c) { const int cc = part * 16 + c; float v = Cs[0][r][cc];
            if (region == 0) v = v * inv * qg[cc] * (0.125f * LOG2E); else if (region == 1) v = v * inv * kg[cc];
            dst[cc] = (bf16)f2bf(v); }
    }
};

struct ProbWo {
    static constexpr int NPASS = 1;
    const bf16* O; const float* W; const float* xres; const float* gate; float* out; int K;
    int m0, n0;
    __device__ bool setup(int bx) { m0 = (bx / 16) * 64; n0 = (bx % 16) * 64; return true; }
    __device__ float A(int r, int k) const { return bf2f(O[(size_t)(m0 + r) * D + k]); }
    __device__ float B(int, int k, int c) const { return W[(size_t)k * D + n0 + c]; }
    __device__ void epi(float (*Cs)[64][65], int tid) const {
        const int r = tid >> 2, part = tid & 3, row = m0 + r, b = row / SEQ;
        for (int c = 0; c < 16; ++c) { const int col = n0 + part * 16 + c; out[(size_t)row * D + col] = xres[(size_t)row * D + col] + gate[b * 6 * D + col] * Cs[0][r][part * 16 + c]; }
    }
};

__device__ __forceinline__ void expert_bases(const unsigned* cnt  , int e, int& cnt_e, int& base_e) {
    int base = 0, ce = 0;
    for (int i = 0; i < NE; ++i) { const int c = (int)cnt[i * 64]; if (i < e) base += (c + 255) & ~255; if (i == e) ce = c; }
    cnt_e = ce; base_e = base;
}

struct ProbUp {
    static constexpr int NPASS = 2;
    const bf16* H2; const float *Wg, *Wu; const unsigned* cnt; const unsigned* ltok; bf16* he; int K;
    int e, r0, n0, cnt_e, base_e;
    __device__ bool setup(int bx) { n0 = (bx % 8) * 64; const int rt = (bx / 8) % 256; e = bx / (8 * 256); r0 = rt * 64; expert_bases(cnt, e, cnt_e, base_e); return r0 < cnt_e; }
    __device__ float A(int r, int k) const { const int rr = r0 + r; if (rr >= cnt_e) return 0.f; const unsigned tok = ltok[(size_t)e * T + rr] & 0x7fffffffu; return bf2f(H2[(size_t)tok * D + k]); }
    __device__ float B(int pass, int k, int c) const { return (pass == 0 ? Wg : Wu)[((size_t)e * D + k) * FF + n0 + c]; }
    __device__ void epi(float (*Cs)[64][65], int tid) const {
        const int r = tid >> 2, part = tid & 3; if (r0 + r >= cnt_e) return;
        bf16* dst = he + (size_t)(base_e + r0 + r) * FF + n0;
        for (int c = 0; c < 16; ++c) { const int cc = part * 16 + c; const float g = Cs[0][r][cc], u = Cs[1][r][cc]; dst[cc] = (bf16)f2bf(g / (1.f + __expf(-g)) * u); }
    }
};
struct ProbDown {
    static constexpr int NPASS = 1;
    const bf16* he; const float* Wd; const unsigned* cnt; const unsigned* ltok; const float* lw; bf16* ybuf; int K;
    int e, r0, n0, cnt_e, base_e;
    __device__ bool setup(int bx) { n0 = (bx % 16) * 64; const int rt = (bx / 16) % 256; e = bx / (16 * 256); r0 = rt * 64; expert_bases(cnt, e, cnt_e, base_e); return r0 < cnt_e; }
    __device__ float A(int r, int k) const { const int rr = r0 + r; if (rr >= cnt_e) return 0.f; return bf2f(he[(size_t)(base_e + rr) * FF + k]); }
    __device__ float B(int, int k, int c) const { return Wd[((size_t)e * FF + k) * D + n0 + c]; }
    __device__ void epi(float (*Cs)[64][65], int tid) const {
        const int r = tid >> 2, part = tid & 3; if (r0 + r >= cnt_e) return;
        const unsigned tk = ltok[(size_t)e * T + r0 + r]; const float w = lw[(size_t)e * T + r0 + r];
        bf16* dst = ybuf + ((size_t)(tk >> 31) * T + (tk & 0x7fffffffu)) * D + n0;
        for (int c = 0; c < 16; ++c) { const int cc = part * 16 + c; dst[cc] = (bf16)f2bf(w * Cs[0][r][cc]); }
    }
};

__global__ void __launch_bounds__(256) k_norm_route(const float* xin, const float* g, const float* mod_l, int sh_off, int sc_off, bf16* h, const float* rw, const float* rb,
                                                    unsigned* cnt, unsigned* ltok, float* lw) {
    const int lane = threadIdx.x & 63, row = blockIdx.x * 4 + (threadIdx.x >> 6), b = row / SEQ;
    const float* mb = mod_l + b * 6 * D;
    float hv[16]; float ss = 0.f;
#pragma unroll
    for (int j = 0; j < 4; ++j) { const float4 v = ((const float4*)(xin + (size_t)row * D))[lane + 64 * j]; hv[4 * j] = v.x; hv[4 * j + 1] = v.y; hv[4 * j + 2] = v.z; hv[4 * j + 3] = v.w; ss += v.x * v.x + v.y * v.y + v.z * v.z + v.w * v.w; }
    for (int o = 32; o > 0; o >>= 1) ss += __shfl_xor(ss, o);
    const float inv = rsqrtf(ss * (1.f / D) + NORM_EPS);
    float lg[16];
#pragma unroll
    for (int e = 0; e < 16; ++e) lg[e] = 0.f;
#pragma unroll
    for (int j = 0; j < 4; ++j) {
        const int c0 = (lane + 64 * j) * 4;
        const float4 gg = *(const float4*)(g + c0), sc = *(const float4*)(mb + sc_off + c0), sh = *(const float4*)(mb + sh_off + c0);
        hv[4 * j] = hv[4 * j] * inv * gg.x * (1.f + sc.x) + sh.x; hv[4 * j + 1] = hv[4 * j + 1] * inv * gg.y * (1.f + sc.y) + sh.y;
        hv[4 * j + 2] = hv[4 * j + 2] * inv * gg.z * (1.f + sc.z) + sh.z; hv[4 * j + 3] = hv[4 * j + 3] * inv * gg.w * (1.f + sc.w) + sh.w;
        uint2 w; w.x = f2bf(hv[4 * j]) | (f2bf(hv[4 * j + 1]) << 16); w.y = f2bf(hv[4 * j + 2]) | (f2bf(hv[4 * j + 3]) << 16);
        *(uint2*)(h + (size_t)row * D + c0) = w;
#pragma unroll
        for (int i = 0; i < 4; ++i) { const float4* wr = (const float4*)(rw + (size_t)(c0 + i) * NE); const float x = hv[4 * j + i];
#pragma unroll
            for (int q = 0; q < 4; ++q) { const float4 w4 = wr[q]; lg[4 * q] += x * w4.x; lg[4 * q + 1] += x * w4.y; lg[4 * q + 2] += x * w4.z; lg[4 * q + 3] += x * w4.w; } }
    }
#pragma unroll
    for (int e = 0; e < 16; ++e) for (int o = 32; o > 0; o >>= 1) lg[e] += __shfl_xor(lg[e], o);
    if (lane == 0) {
        float sc[16], sel[16];
#pragma unroll
        for (int e = 0; e < 16; ++e) { sc[e] = 1.f / (1.f + __expf(-lg[e])); sel[e] = sc[e] + rb[e]; }
        int bg = 0; float bgs = -3e38f;
#pragma unroll
        for (int gi = 0; gi < 4; ++gi) {
            float m1 = -3e38f, m2 = -3e38f;
#pragma unroll
            for (int i = 0; i < 4; ++i) { const float v = sel[gi * 4 + i]; if (v > m1) { m2 = m1; m1 = v; } else if (v > m2) m2 = v; }
            const float gs = m1 + m2; if (gs > bgs) { bgs = gs; bg = gi; }
        }
        int e0 = 0, e1 = 0; float s0 = -3e38f, s1 = -3e38f, w0 = 0.f, w1 = 0.f;
#pragma unroll
        for (int gi = 0; gi < 4; ++gi) if (gi == bg) {
#pragma unroll
            for (int i = 0; i < 4; ++i) { const int e = gi * 4 + i; const float v = sel[e];
                if (v > s0) { s1 = s0; e1 = e0; w1 = w0; s0 = v; e0 = e; w0 = sc[e]; } else if (v > s1) { s1 = v; e1 = e; w1 = sc[e]; } }
        }
        const float ws = w0 + w1; w0 /= ws; w1 /= ws;
        const unsigned p0 = atomicAdd(&cnt[e0 * 64], 1u), p1 = atomicAdd(&cnt[e1 * 64], 1u);
        ltok[(size_t)e0 * T + p0] = (unsigned)row; lw[(size_t)e0 * T + p0] = w0;
        ltok[(size_t)e1 * T + p1] = (unsigned)row | 0x80000000u; lw[(size_t)e1 * T + p1] = w1;
    }
}

__global__ void __launch_bounds__(256) k_combine(float* xio, const bf16* ybuf, const float* gate  , int do_norm, const float* g, const float* modn, int sh_off, int sc_off, bf16* h) {
    __shared__ float red[4];
    const int row = blockIdx.x, b = row / SEQ, t = threadIdx.x;
    float4 v = ((const float4*)(xio + (size_t)row * D))[t];
    const uint2 y0 = ((const uint2*)(ybuf + (size_t)row * D))[t], y1 = ((const uint2*)(ybuf + ((size_t)T + row) * D))[t];
    const float4 gt = ((const float4*)(gate + b * 6 * D))[t];
    v.x += gt.x * (bf2f(y0.x) + bf2f(y1.x)); v.y += gt.y * (bf2f(y0.x >> 16) + bf2f(y1.x >> 16)); v.z += gt.z * (bf2f(y0.y) + bf2f(y1.y)); v.w += gt.w * (bf2f(y0.y >> 16) + bf2f(y1.y >> 16));
    ((float4*)(xio + (size_t)row * D))[t] = v;
    if (do_norm) {
        const float ss = block_sum_256(v.x * v.x + v.y * v.y + v.z * v.z + v.w * v.w, red);
        const float inv = rsqrtf(ss * (1.f / D) + NORM_EPS);
        const float* mb = modn + b * 6 * D;
        const float4 gg = ((const float4*)g)[t], sc = ((const float4*)(mb + sc_off))[t], sh = ((const float4*)(mb + sh_off))[t];
        const float o0 = v.x * inv * gg.x * (1.f + sc.x) + sh.x, o1 = v.y * inv * gg.y * (1.f + sc.y) + sh.y, o2 = v.z * inv * gg.z * (1.f + sc.z) + sh.z, o3 = v.w * inv * gg.w * (1.f + sc.w) + sh.w;
        uint2 w; w.x = f2bf(o0) | (f2bf(o1) << 16); w.y = f2bf(o2) | (f2bf(o3) << 16);
        ((uint2*)(h + (size_t)row * D))[t] = w;
    }
}

__device__ __forceinline__ int t5_bucket_ref(int rel) {
    const int ret = rel > 0 ? 16 : 0; const int n = rel < 0 ? -rel : rel;
    const float nf = (float)(n < 1 ? 1 : n);
    int large = 8 + (int)(logf(nf / 8.f) / logf(128.f) * 8.f); if (large > 15) large = 15;
    return ret + (n < 8 ? n : large);
}
__device__ __forceinline__ void slow_map(const bf16* Qrow, const bf16* Kcol, const bf16* Vcol, const float* t5h, int qpos, int kend, float (&o)[64]) {
    float q[64];
#pragma unroll
    for (int d = 0; d < 64; ++d) { q[d] = bf2f(Qrow[d]); o[d] = 0.f; }
    float m = -3e38f, l = 0.f;
    for (int j = 0; j < kend; ++j) {
        const uint4* kr = (const uint4*)(Kcol + (size_t)j * D);
        float s = 0.f;
#pragma unroll
        for (int c = 0; c < 8; ++c) { const uint4 kk = kr[c];
            s += q[8 * c] * bf2f(kk.x) + q[8 * c + 1] * bf2f(kk.x >> 16) + q[8 * c + 2] * bf2f(kk.y) + q[8 * c + 3] * bf2f(kk.y >> 16)
               + q[8 * c + 4] * bf2f(kk.z) + q[8 * c + 5] * bf2f(kk.z >> 16) + q[8 * c + 6] * bf2f(kk.w) + q[8 * c + 7] * bf2f(kk.w >> 16); }
        s += t5h[t5_bucket_ref(j - qpos) * 8] * LOG2E;
        const float mn = fmaxf(m, s), a = exp2f(m - mn), p = exp2f(s - mn);
        l = l * a + p; m = mn;
        const uint4* vr = (const uint4*)(Vcol + (size_t)j * D);
#pragma unroll
        for (int c = 0; c < 8; ++c) { const uint4 vv = vr[c];
            o[8 * c] = o[8 * c] * a + p * bf2f(vv.x); o[8 * c + 1] = o[8 * c + 1] * a + p * bf2f(vv.x >> 16); o[8 * c + 2] = o[8 * c + 2] * a + p * bf2f(vv.y); o[8 * c + 3] = o[8 * c + 3] * a + p * bf2f(vv.y >> 16);
            o[8 * c + 4] = o[8 * c + 4] * a + p * bf2f(vv.z); o[8 * c + 5] = o[8 * c + 5] * a + p * bf2f(vv.z >> 16); o[8 * c + 6] = o[8 * c + 6] * a + p * bf2f(vv.w); o[8 * c + 7] = o[8 * c + 7] * a + p * bf2f(vv.w >> 16); }
    }
    const float il = 1.f / l;
#pragma unroll
    for (int d = 0; d < 64; ++d) o[d] *= il;
}
__global__ void __launch_bounds__(64) k_slow_attnA(const bf16* Q, const bf16* Kb, const bf16* Vb, const float* t5, const float* misc, const float* subg, bf16* O) {
    const int blk = blockIdx.x, qt = blk % (SEQ / 32), h = (blk / (SEQ / 32)) % 8, b = blk / (SEQ / 32 * 8);
    const int lane = threadIdx.x, ql = lane >> 1, vh = lane & 1, qpos = qt * 32 + ql; const size_t row = (size_t)b * SEQ + qpos;
    const int kend = (qpos / 64 + 1) * 64;
    float o0[64], o1[64];
    slow_map(Q + row * D + (2 * h) * 64, Kb + (size_t)b * SEQ * D + (2 * h) * 64, Vb + (size_t)b * SEQ * D + h * 128 + vh * 64, t5 + h, qpos, kend, o0);
    slow_map(Q + row * D + (2 * h + 1) * 64, Kb + (size_t)b * SEQ * D + (2 * h + 1) * 64, Vb + (size_t)b * SEQ * D + h * 128 + vh * 64, t5 + h, qpos, kend, o1);
    const float lam = misc[0]; float ss = 0.f;
#pragma unroll
    for (int d = 0; d < 64; ++d) { o0[d] -= lam * o1[d]; ss += o0[d] * o0[d]; }
    ss += __shfl_xor(ss, 1);
    const float inv = rsqrtf(ss * (1.f / 128.f) + NORM_EPS) * 0.8f;
    bf16* dst = O + row * D + h * 128 + vh * 64;
#pragma unroll
    for (int d = 0; d < 64; d += 2) *(unsigned*)(dst + d) = f2bf(o0[d] * inv * subg[vh * 64 + d]) | (f2bf(o0[d + 1] * inv * subg[vh * 64 + d + 1]) << 16);
}
__global__ void __launch_bounds__(64) k_slow_attnB(const bf16* Q, const bf16* Kb, const bf16* Vb, const float* relb, bf16* O) {
    const int blk = blockIdx.x, ci = blk % (SEQ / 64), h = (blk / (SEQ / 64)) % 16, b = blk / (SEQ / 64 * 16);
    const int qpos = ci * 64 + threadIdx.x; const size_t row = (size_t)b * SEQ + qpos;
    const int k0 = ci >= 8 ? (ci - 8) * 64 : 0, kend = (ci + 1) * 64;
    float q[64], o[64];
#pragma unroll
    for (int d = 0; d < 64; ++d) { q[d] = bf2f(Q[row * D + h * 64 + d]); o[d] = 0.f; }
    float m = -3e38f, l = 0.f;
    const bf16* Kc = Kb + (size_t)b * SEQ * D + h * 64; const bf16* Vc = Vb + (size_t)b * SEQ * D + h * 64;
    for (int j = k0; j < kend; ++j) {
        const uint4* kr = (const uint4*)(Kc + (size_t)j * D);
        float s = 0.f;
#pragma unroll
        for (int c = 0; c < 8; ++c) { const uint4 kk = kr[c];
            s += q[8 * c] * bf2f(kk.x) + q[8 * c + 1] * bf2f(kk.x >> 16) + q[8 * c + 2] * bf2f(kk.y) + q[8 * c + 3] * bf2f(kk.y >> 16)
               + q[8 * c + 4] * bf2f(kk.z) + q[8 * c + 5] * bf2f(kk.z >> 16) + q[8 * c + 6] * bf2f(kk.w) + q[8 * c + 7] * bf2f(kk.w >> 16); }
        int rel = j - qpos; rel = rel < -256 ? -256 : (rel > 256 ? 256 : rel);
        s += relb[h * 513 + rel + 256] * LOG2E;
        const float mn = fmaxf(m, s), a = exp2f(m - mn), p = exp2f(s - mn);
        l = l * a + p; m = mn;
        const uint4* vr = (const uint4*)(Vc + (size_t)j * D);
#pragma unroll
        for (int c = 0; c < 8; ++c) { const uint4 vv = vr[c];
            o[8 * c] = o[8 * c] * a + p * bf2f(vv.x); o[8 * c + 1] = o[8 * c + 1] * a + p * bf2f(vv.x >> 16); o[8 * c + 2] = o[8 * c + 2] * a + p * bf2f(vv.y); o[8 * c + 3] = o[8 * c + 3] * a + p * bf2f(vv.y >> 16);
            o[8 * c + 4] = o[8 * c + 4] * a + p * bf2f(vv.z); o[8 * c + 5] = o[8 * c + 5] * a + p * bf2f(vv.z >> 16); o[8 * c + 6] = o[8 * c + 6] * a + p * bf2f(vv.w); o[8 * c + 7] = o[8 * c + 7] * a + p * bf2f(vv.w >> 16); }
    }
    const float il = 1.f / l;
    bf16* dst = O + row * D + h * 64;
#pragma unroll
    for (int d = 0; d < 64; d += 2) *(unsigned*)(dst + d) = f2bf(o[d] * il) | (f2bf(o[d + 1] * il) << 16);
}

#define GAS __attribute__((address_space(1)))
#define LAS __attribute__((address_space(3)))
typedef unsigned v4u __attribute__((ext_vector_type(4)));
typedef unsigned v2u __attribute__((ext_vector_type(2)));
typedef float f32x4 __attribute__((ext_vector_type(4)));
typedef float f32x16 __attribute__((ext_vector_type(16)));
typedef short bf16x8 __attribute__((ext_vector_type(8)));
typedef short s16x4 __attribute__((ext_vector_type(4)));
typedef GAS unsigned gu32;
#define RLX_AGENT __ATOMIC_RELAXED, __HIP_MEMORY_SCOPE_AGENT
#define LDS_WAIT() asm volatile("s_waitcnt lgkmcnt(0)" ::: "memory")
#define VM_WAIT() asm volatile("s_waitcnt vmcnt(0)" ::: "memory")

constexpr int NWAVES = 8;
constexpr int RING_BYTES = 131072;
constexpr int LDSCTL_OFF = RING_BYTES, MISC_OFF = LDSCTL_OFF + 320;
constexpr int TAB_OFF = RING_BYTES + 1024;
constexpr int LDS_BYTES = 147456;
constexpr int CW_BAR = 4096;

__device__ __forceinline__ unsigned cvt_pk_bf16(float lo, float hi) { unsigned r; asm volatile("v_cvt_pk_bf16_f32 %0, %1, %2" : "=v"(r) : "v"(lo), "v"(hi)); return r; }
__device__ __forceinline__ float wave_sum(float v) {
#pragma unroll
    for (int o = 1; o < 64; o <<= 1) v += __shfl_xor(v, o);
    return v;
}

#define XB_TMO      128
#define XB_XCNT(j)  (256  + 64 * (j))
#define XB_XSUB(j)  (1280 + 64 * (j))
#define XB_XGEN(j)  (2304 + 64 * (j))
#define XB_TOP      3328
#define XB_TOPGEN   3392
#define XCD_BAR_WORDS 3456
#define XB_SPIN_CAP (1u << 18)
__device__ __forceinline__ unsigned xb_ld(unsigned* p)              { return __hip_atomic_load(p, __ATOMIC_RELAXED, __HIP_MEMORY_SCOPE_AGENT); }
__device__ __forceinline__ unsigned xb_add(unsigned* p, unsigned v) { return __hip_atomic_fetch_add(p, v, __ATOMIC_RELAXED, __HIP_MEMORY_SCOPE_AGENT); }
__device__ __forceinline__ unsigned xb_xcc_id() { return (unsigned)__builtin_amdgcn_s_getreg((3 << 11) | 20) & 0xFu; }
#define XB_SPIN(cond, bar) do { unsigned _sp = 0; while (cond) { __builtin_amdgcn_s_sleep(1); \
    if ((++_sp & 255u) == 0u) { if (xb_ld(&(bar)[XB_TMO])) break; if (_sp > XB_SPIN_CAP) { atomicAdd(&(bar)[XB_TMO], 1u); break; } } } } while (0)
struct XcdBarrier { unsigned* bar; unsigned x; volatile LAS unsigned* st; };
__device__ __forceinline__ XcdBarrier xcd_barrier_post(unsigned* bar, volatile LAS unsigned* st) {
    XcdBarrier b; b.bar = bar; b.x = xb_xcc_id(); b.st = st;
    if (threadIdx.x == 0) (void)xb_add(&bar[XB_XCNT(b.x)], 1u);
    return b;
}
__device__ __forceinline__ void xcd_barrier_complete(unsigned* bar, unsigned x, unsigned& nloc, unsigned& nx) {
    const unsigned G = gridDim.x * gridDim.y * gridDim.z;
    unsigned sum, cnt, mine, sp = 0u;
    for (;;) {
        sum = 0u; cnt = 0u; mine = 0u;
#pragma unroll
        for (unsigned j = 0; j < 16; ++j) { const unsigned c = xb_ld(&bar[XB_XCNT(j)]); sum += c; cnt += (c > 0u) ? 1u : 0u; mine = (j == x) ? c : mine; }
        if (sum == G) break;
        __builtin_amdgcn_s_sleep(1);
        if ((++sp & 255u) == 0u) { if (xb_ld(&bar[XB_TMO])) break; if (sp > XB_SPIN_CAP) { atomicAdd(&bar[XB_TMO], 1u); break; } }
    }
    nloc = mine > 0u ? mine : 1u; nx = cnt > 0u ? cnt : 1u;
}
__device__ __forceinline__ void xcd_barrier(const XcdBarrier& b) {
    asm volatile("s_waitcnt vmcnt(0)" ::: "memory");
    __syncthreads();
    if (threadIdx.x == 0) {
        unsigned* bar = b.bar;
        __builtin_amdgcn_s_waitcnt(0);
        unsigned nloc = b.st[0], nx = b.st[1];
        if (nloc == 0u) { xcd_barrier_complete(bar, b.x, nloc, nx); b.st[0] = nloc; b.st[1] = nx; }
        const unsigned old = xb_add(&bar[XB_XSUB(b.x)], 1u);
        const unsigned gen = old / nloc;
        if (old + 1u == (gen + 1u) * nloc) {
            __builtin_amdgcn_fence(__ATOMIC_RELEASE, "agent");
            asm volatile("s_waitcnt vmcnt(0)" ::: "memory");
            const unsigned og = xb_add(&bar[XB_TOP], 1u);
            const unsigned tg = og / nx;
            if (og + 1u == (tg + 1u) * nx) xb_add(&bar[XB_TOPGEN], 1u);
            else XB_SPIN(xb_ld(&bar[XB_TOPGEN]) == tg, bar);
            __builtin_amdgcn_fence(__ATOMIC_ACQUIRE, "agent");
            xb_add(&bar[XB_XGEN(b.x)], 1u);
            asm volatile("s_waitcnt vmcnt(0)" ::: "memory");
        } else {
            XB_SPIN(xb_ld(&bar[XB_XGEN(b.x)]) == gen, bar);
            __builtin_amdgcn_fence(__ATOMIC_ACQUIRE, "agent");
            asm volatile("s_waitcnt vmcnt(0)" ::: "memory");
        }
    }
    __syncthreads();
}

namespace g8 {
constexpr int BM = 256, BK = 64, HALF = 128, HTB = HALF * BK * 2, STAGE_BYTES = 8 * HTB;
__host__ __device__ __forceinline__ int lds_byte(int r, int c) { const int st = (r >> 4) * 2 + (c >> 5), rr = r & 15, cc = c & 31, ob = rr * 64 + cc * 2; return st * 1024 + (ob ^ (((ob >> 9) & 1) << 5)); }
__host__ __device__ __forceinline__ void stage_rc(int b, int& R, int& C) { const int st = b / 1024, sb = b % 1024, swz = sb ^ (((sb >> 9) & 1) << 5); R = (st >> 1) * 16 + swz / 64; C = (st & 1) * 32 + (swz % 64) / 2; }
__host__ __device__ __forceinline__ int perm32(int rho) { const int n = rho >> 4, i = rho & 15; return 8 * (i >> 2) + 4 * n + (i & 3); }

struct Unit { int arow0, brow0, orow0, pn, lidx, nvalid; };

struct DenseOrder {
    int nM, nN, nwg, G, c;
    __device__ void init(int M, int N, int G_, int c_) { nM = M / BM; nN = N / BM; nwg = nM * nN; G = G_; c = c_; }
    __device__ __forceinline__ bool next(int i, Unit& u) const {
        const long L = (long)i * G + c; if (L >= nwg) return false;
        int wgid = (int)L; { const int q = nwg / 8, r = nwg % 8, xcd = wgid % 8, off = wgid / 8; wgid = (xcd < r ? xcd * (q + 1) : r * (q + 1) + (xcd - r) * q) + off; }
        const int nig = 8 * nN, gid = wgid / nig, fm = gid * 8, gsz = (nM - fm) < 8 ? (nM - fm) : 8;
        const int pm = fm + ((wgid % nig) % gsz), pn = (wgid % nig) / gsz;
        u.arow0 = pm * BM; u.orow0 = pm * BM; u.brow0 = pn * BM; u.pn = pn; u.lidx = 0; u.nvalid = BM; return true;
    }
    __device__ __forceinline__ void aoffs(const Unit& u, int K, unsigned (&o)[4]) const {
#pragma unroll
        for (int i = 0; i < 2; ++i) { int R, C; stage_rc((int)threadIdx.x * 16 + i * 8192, R, C);
#pragma unroll
            for (int h = 0; h < 2; ++h) o[h * 2 + i] = (unsigned)((u.arow0 + h * HALF + R) * K + C) * 2u; }
    }
};
template <bool GATHER> struct MoeOrder {
    const LAS unsigned* tab; const unsigned* ltok; int G, c;
    __device__ __forceinline__ bool next(int i, Unit& u) const {
        const int L = i * G + c; const int ntile = (int)__builtin_amdgcn_readfirstlane(tab[0]);
        if (L >= ntile * 4) return false;
        const int rt = L >> 2, pn = L & 3; const unsigned w = __builtin_amdgcn_readfirstlane(tab[1 + rt]); const int e = (int)(w & 255u), ti = (int)(w >> 8);
        const int base = (int)__builtin_amdgcn_readfirstlane(tab[160 + e]), cnt = (int)__builtin_amdgcn_readfirstlane(tab[176 + e]);
        u.lidx = e * T + ti * BM; u.orow0 = base + ti * BM; u.arow0 = base + ti * BM; u.brow0 = e * 1024 + pn * BM; u.pn = pn; u.nvalid = (cnt - ti * BM) < BM ? (cnt - ti * BM) : BM; return true;
    }
    __device__ __forceinline__ void aoffs(const Unit& u, int K, unsigned (&o)[4]) const {
#pragma unroll
        for (int i = 0; i < 2; ++i) { int R, C; stage_rc((int)threadIdx.x * 16 + i * 8192, R, C);
#pragma unroll
            for (int h = 0; h < 2; ++h) {
                int row;
                if (GATHER) { int r = h * HALF + R; if (r >= u.nvalid) r = 0; row = (int)(ltok[u.lidx + r] & 0x7fffffffu); }
                else row = u.arow0 + h * HALF + R;
                o[h * 2 + i] = (unsigned)(row * K + C) * 2u; } }
    }
};

struct EpiQKV {
    static constexpr bool PERM = true;
    bf16* Q; size_t stride; const float *qg, *kg;
    __device__ __forceinline__ void operator()(const f32x4 (&acc)[2][2][4][2], const Unit& u, int wr, int wc, int fr, int fq) const {
        const int region = u.pn >> 2, colt = (u.pn & 3) * BM;
        bf16* base = Q + (size_t)region * stride;
        const bool nrm = region < 2;
        const float* gp = (region == 0) ? qg : kg; const float gs = (region == 0) ? 0.125f * LOG2E : 1.f;
        f32x4 gv[2][2];
#pragma unroll
        for (int bj = 0; bj < 2; ++bj)
#pragma unroll
            for (int n = 0; n < 2; ++n) { gv[bj][n] = (f32x4){1.f, 1.f, 1.f, 1.f}; if (nrm) gv[bj][n] = *(const f32x4*)(gp + 32 * bj + 8 * fq + 4 * n) * gs; }
#pragma unroll
        for (int ai = 0; ai < 2; ++ai)
#pragma unroll
            for (int m = 0; m < 4; ++m) {
                const int row = u.orow0 + ai * HALF + wr * 64 + m * 16 + fr;
                float ss = 0.f;
#pragma unroll
                for (int bj = 0; bj < 2; ++bj)
#pragma unroll
                    for (int n = 0; n < 2; ++n) { const f32x4 x = acc[ai][bj][m][n]; ss += (x[0] * x[0] + x[1] * x[1]) + (x[2] * x[2] + x[3] * x[3]); }
                ss += __shfl_xor(ss, 16); ss += __shfl_xor(ss, 32);
                const float inv = nrm ? rsqrtf(ss * (1.f / 64.f) + NORM_EPS) : 1.f;
                bf16* rowp = base + (size_t)row * D + colt + 64 * wc + 8 * fq;
#pragma unroll
                for (int bj = 0; bj < 2; ++bj) { const f32x4 v0 = acc[ai][bj][m][0] * gv[bj][0] * inv, v1 = acc[ai][bj][m][1] * gv[bj][1] * inv;
                    v4u w; w.x = cvt_pk_bf16(v0[0], v0[1]); w.y = cvt_pk_bf16(v0[2], v0[3]); w.z = cvt_pk_bf16(v1[0], v1[1]); w.w = cvt_pk_bf16(v1[2], v1[3]);
                    *(v4u*)(rowp + 32 * bj) = w; }
            }
    }
};
struct EpiWo {
    static constexpr bool PERM = false;
    const float* xres; const float* gate; float* out;
    __device__ __forceinline__ void operator()(const f32x4 (&acc)[2][2][4][2], const Unit& u, int wr, int wc, int fr, int fq) const {
        const int b = u.orow0 / SEQ; const int col0 = u.pn * BM + wc * 32 + 4 * fq;
        f32x4 gt[2][2];
#pragma unroll
        for (int bj = 0; bj < 2; ++bj)
#pragma unroll
            for (int n = 0; n < 2; ++n) gt[bj][n] = *(const f32x4*)(gate + b * 6 * D + col0 + bj * HALF + n * 16);
#pragma unroll
        for (int ai = 0; ai < 2; ++ai)
#pragma unroll
            for (int m = 0; m < 4; ++m) { const size_t off = (size_t)(u.orow0 + ai * HALF + wr * 64 + m * 16 + fr) * D + col0;
#pragma unroll
                for (int bj = 0; bj < 2; ++bj)
#pragma unroll
                    for (int n = 0; n < 2; ++n) { const f32x4 xr = *(const f32x4*)(xres + off + bj * HALF + n * 16); *(f32x4*)(out + off + bj * HALF + n * 16) = xr + gt[bj][n] * acc[ai][bj][m][n]; }
                if (m & 1) asm volatile("" ::: "memory"); }
    }
};
struct EpiUp {
    static constexpr bool PERM = true;
    bf16* he;
    __device__ __forceinline__ void operator()(const f32x4 (&acc)[2][2][4][2], const Unit& u, int wr, int wc, int fr, int fq) const {
#pragma unroll
        for (int ai = 0; ai < 2; ++ai)
#pragma unroll
            for (int m = 0; m < 4; ++m) { const int row = u.orow0 + ai * HALF + wr * 64 + m * 16 + fr;
                f32x4 v[2];
#pragma unroll
                for (int n = 0; n < 2; ++n)
#pragma unroll
                    for (int i = 0; i < 4; ++i) { const float g = acc[ai][0][m][n][i], up = acc[ai][1][m][n][i]; v[n][i] = g * __builtin_amdgcn_rcpf(1.f + __builtin_amdgcn_exp2f(-g * LOG2E)) * up; }
                v4u w; w.x = cvt_pk_bf16(v[0][0], v[0][1]); w.y = cvt_pk_bf16(v[0][2], v[0][3]); w.z = cvt_pk_bf16(v[1][0], v[1][1]); w.w = cvt_pk_bf16(v[1][2], v[1][3]);
                *(v4u*)(he + (size_t)row * FF + u.pn * HALF + 32 * wc + 8 * fq) = w; }
    }
};
struct EpiDown {
    static constexpr bool PERM = true;
    const unsigned* ltok; const float* lw; bf16* ybuf;
    __device__ __forceinline__ void operator()(const f32x4 (&acc)[2][2][4][2], const Unit& u, int wr, int wc, int fr, int fq) const {
#pragma unroll
        for (int ai = 0; ai < 2; ++ai)
#pragma unroll
            for (int m = 0; m < 4; ++m) { const int r = ai * HALF + wr * 64 + m * 16 + fr;
                if (r < u.nvalid) { const unsigned tk = ltok[u.lidx + r]; const float w = lw[u.lidx + r];
                    bf16* dst = ybuf + ((size_t)(tk >> 31) * T + (tk & 0x7fffffffu)) * D + u.pn * BM + 32 * wc + 8 * fq;
#pragma unroll
                    for (int bj = 0; bj < 2; ++bj) { const f32x4 v0 = acc[ai][bj][m][0] * w, v1 = acc[ai][bj][m][1] * w;
                        v4u o; o.x = cvt_pk_bf16(v0[0], v0[1]); o.y = cvt_pk_bf16(v0[2], v0[3]); o.z = cvt_pk_bf16(v1[0], v1[1]); o.w = cvt_pk_bf16(v1[2], v1[3]);
                        *(v4u*)(dst + bj * HALF) = o; } } }
    }
};

template <class Epi, class Sched>
__device__ __forceinline__ void gemm_phase(LAS unsigned char* lds, const bf16* A, const bf16* Bt, const int K, const Sched& S, const Epi& E) {
    const int tid = threadIdx.x, wid = __builtin_amdgcn_readfirstlane(tid >> 6), lane = tid & 63, wr = wid >> 2, wc = wid & 3, fr = lane & 15, fq = lane >> 4;
    const int nt = K / BK;
    unsigned voffB[2];
#pragma unroll
    for (int i = 0; i < 2; ++i) { int R, C; stage_rc(tid * 16 + i * 8192, R, C); const int Rb = Epi::PERM ? ((R & ~31) + perm32(R & 31)) : R; voffB[i] = (unsigned)(Rb * K + C) * 2u; }
    const size_t kstep = (size_t)(BK * 2);
    const size_t hstep = (size_t)HALF * K * 2;
    const unsigned ldsw = (unsigned)wid * 1024u;
    const int aoff = lds_byte(wr * 64 + fr, fq * 8), boff = lds_byte(wc * 32 + fr, fq * 8);
#define G8_SA(b, h) (((b) * 2 + (h)) * HTB)
#define G8_SB(b, h) ((4 + (b) * 2 + (h)) * HTB)
#define G8_STAGE_B(bufoff, gbase) do { _Pragma("unroll") for (int _i = 0; _i < 2; ++_i) \
        __builtin_amdgcn_global_load_lds((const unsigned*)((const char*)(gbase) + voffB[_i]), (LAS unsigned*)(lds + (bufoff) + ldsw + _i * 8192), 16, 0, 0); } while (0)
#define G8_STAGE_A(bufoff, kt, offs, h) do { _Pragma("unroll") for (int _i = 0; _i < 2; ++_i) \
        __builtin_amdgcn_global_load_lds((const unsigned*)((const char*)A + (size_t)(kt) * kstep + (offs)[(h) * 2 + _i]), (LAS unsigned*)(lds + (bufoff) + ldsw + _i * 8192), 16, 0, 0); } while (0)
#define G8_LDA(dst, b, h) do { _Pragma("unroll") for (int m = 0; m < 4; ++m) _Pragma("unroll") for (int k = 0; k < 2; ++k) dst[m][k] = *(const LAS bf16x8*)(lds + G8_SA(b, h) + aoff + m * 2048 + k * 1024); } while (0)
#define G8_LDB(dst, b, h) do { _Pragma("unroll") for (int n = 0; n < 2; ++n) _Pragma("unroll") for (int k = 0; k < 2; ++k) dst[n][k] = *(const LAS bf16x8*)(lds + G8_SB(b, h) + boff + n * 2048 + k * 1024); } while (0)
#define G8_MMA(ai, bj, At, Bt_) do { __builtin_amdgcn_s_setprio(1); _Pragma("unroll") for (int m = 0; m < 4; ++m) _Pragma("unroll") for (int n = 0; n < 2; ++n) _Pragma("unroll") for (int k = 0; k < 2; ++k) \
        acc[ai][bj][m][n] = __builtin_amdgcn_mfma_f32_16x16x32_bf16(Bt_[n][k], At[m][k], acc[ai][bj][m][n], 0, 0, 0); __builtin_amdgcn_s_setprio(0); } while (0)
#define G8_WAIT_V(n) asm volatile("s_waitcnt vmcnt(" #n ")" ::: "memory")
#define G8_WAIT_L(n) asm volatile("s_waitcnt lgkmcnt(" #n ")" ::: "memory")
#define G8_BAR __builtin_amdgcn_s_barrier()
#define G8_SCHED __builtin_amdgcn_sched_barrier(0)
    Unit cur, nxt; int ui = 0;
    if (!S.next(0, cur)) return;
    f32x4 acc[2][2][4][2];
#pragma unroll
    for (int a = 0; a < 2; ++a)
#pragma unroll
        for (int b = 0; b < 2; ++b)
#pragma unroll
            for (int m = 0; m < 4; ++m)
#pragma unroll
                for (int n = 0; n < 2; ++n) acc[a][b][m][n] = (f32x4){0.f, 0.f, 0.f, 0.f};
    bf16x8 At[4][2], B0[2][2], B1[2][2];
    unsigned offc[4], offn[4];
    S.aoffs(cur, K, offc);
    const char* cB = (const char*)Bt + (size_t)cur.brow0 * K * 2;
    G8_STAGE_B(G8_SB(0, 0), cB); G8_STAGE_B(G8_SB(0, 1), cB + hstep); G8_STAGE_A(G8_SA(0, 0), 0, offc, 0); G8_STAGE_A(G8_SA(0, 1), 0, offc, 1);
    if (wr == 1) G8_BAR;
    G8_WAIT_V(2); G8_BAR;
    G8_STAGE_B(G8_SB(1, 0), cB + kstep); G8_STAGE_A(G8_SA(1, 0), 1, offc, 0); G8_STAGE_B(G8_SB(1, 1), cB + hstep + kstep);
    G8_WAIT_V(6); G8_BAR;
    for (;;) {
        const bool has_next = S.next(ui + 1, nxt);
        if (has_next) S.aoffs(nxt, K, offn); else {
#pragma unroll
            for (int j = 0; j < 4; ++j) offn[j] = offc[j]; }
        const char* nB = has_next ? (const char*)Bt + (size_t)nxt.brow0 * K * 2 : cB;
        for (int t = 0; t < nt; t += 2) {
            const bool last = (t == nt - 2);
            const int kt2 = last ? 0 : t + 2;
            unsigned o2[4];
#pragma unroll
            for (int j = 0; j < 4; ++j) o2[j] = last ? offn[j] : offc[j];
            const char* b2 = last ? nB : cB + (size_t)(t + 2) * kstep; const char* b3 = b2 + kstep;
            G8_LDB(B0, 0, 0); G8_LDB(B1, 0, 1); G8_SCHED; G8_LDA(At, 0, 0); G8_STAGE_A(G8_SA(1, 1), t + 1, offc, 1);
            G8_WAIT_V(8); G8_WAIT_L(0); G8_BAR; G8_MMA(0, 0, At, B0); G8_MMA(0, 1, At, B1); G8_BAR; G8_SCHED;
            G8_LDA(At, 0, 1); G8_STAGE_B(G8_SB(0, 0), b2); G8_STAGE_B(G8_SB(0, 1), b2 + hstep); G8_STAGE_A(G8_SA(0, 0), kt2, o2, 0);
            G8_WAIT_V(8); G8_WAIT_L(0); G8_BAR; G8_MMA(1, 0, At, B0); G8_MMA(1, 1, At, B1); G8_BAR; G8_SCHED;
            G8_LDB(B0, 1, 0); G8_LDB(B1, 1, 1); G8_SCHED; G8_LDA(At, 1, 0); G8_STAGE_A(G8_SA(0, 1), kt2, o2, 1);
            G8_WAIT_V(8); G8_WAIT_L(0); G8_BAR; G8_MMA(0, 0, At, B0); G8_MMA(0, 1, At, B1); G8_BAR; G8_SCHED;
            G8_LDA(At, 1, 1); G8_STAGE_B(G8_SB(1, 0), b3); G8_STAGE_B(G8_SB(1, 1), b3 + hstep); G8_STAGE_A(G8_SA(1, 0), kt2 + 1, o2, 0);
            G8_WAIT_V(8); G8_WAIT_L(0); G8_BAR; G8_MMA(1, 0, At, B0); G8_MMA(1, 1, At, B1); G8_BAR; G8_SCHED;
        }
        if (wr == 0) G8_BAR;
        E(acc, cur, wr, wc, fr, fq);
        if (!has_next) break;
#pragma unroll
        for (int a = 0; a < 2; ++a)
#pragma unroll
            for (int b = 0; b < 2; ++b)
#pragma unroll
                for (int m = 0; m < 4; ++m)
#pragma unroll
                    for (int n = 0; n < 2; ++n) acc[a][b][m][n] = (f32x4){0.f, 0.f, 0.f, 0.f};
        cur = nxt; cB = nB; ++ui;
#pragma unroll
        for (int j = 0; j < 4; ++j) offc[j] = offn[j];
        if (wr == 1) G8_BAR;
    }
    G8_WAIT_V(0);
    G8_BAR;
#undef G8_SA
#undef G8_SB
#undef G8_STAGE_A
#undef G8_STAGE_B
#undef G8_LDA
#undef G8_LDB
#undef G8_MMA
#undef G8_WAIT_V
#undef G8_WAIT_L
#undef G8_BAR
#undef G8_SCHED
}
}
namespace att {
__device__ __forceinline__ int crow(int r, int hi) { return (r & 3) + 8 * (r >> 2) + 4 * hi; }
__device__ __forceinline__ void glds16(const void* gsrc, unsigned lds_dst) { unsigned keep;
    asm volatile("s_mov_b32 %0, m0\n\ts_mov_b32 m0, %2\n\ts_nop 0\n\tglobal_load_lds_dwordx4 %1, off\n\ts_mov_b32 m0, %0" : "=&s"(keep) : "v"(gsrc), "s"(lds_dst) : "memory"); }
__device__ __forceinline__ void glds16s(const void* sbase, unsigned voff, unsigned lds_dst) { unsigned keep;
    asm volatile("s_mov_b32 %0, m0\n\ts_mov_b32 m0, %3\n\ts_nop 0\n\tglobal_load_lds_dwordx4 %1, %2\n\ts_mov_b32 m0, %0" : "=&s"(keep) : "v"(voff), "s"(sbase), "s"(lds_dst) : "memory"); }
typedef LAS const char* lds_cptr;
typedef short v4i16_t __attribute__((ext_vector_type(4)));
__device__ __forceinline__ s16x4 vtr(lds_cptr p) { return __builtin_bit_cast(s16x4, __builtin_amdgcn_ds_read_tr16_b64_v4i16((LAS v4i16_t*)p)); }
__device__ __forceinline__ float swap_add(float v) { auto rr = __builtin_amdgcn_permlane32_swap(__float_as_uint(v), __float_as_uint(v), false, false); return __uint_as_float(rr[0]) + __uint_as_float(rr[1]); }
#define ATT_WAIT_BAR(N) asm volatile("s_waitcnt vmcnt(" #N ") lgkmcnt(0)\n\ts_barrier" ::: "memory")

template <int MIX>
__device__ __forceinline__ void attn_unit(int b, int h, int blk, const bf16* Q, const bf16* __restrict__ K, const bf16* __restrict__ V, bf16* O, LAS unsigned char* lds, const float* tabg, float lam, const float* subg) {
    constexpr int KC = MIX == 0 ? 128 : 64, DV = KC, NDB = DV / 32, SLOT = KC * 128, NP = MIX == 0 ? 2 : 1;
    constexpr int TABN = MIX == 0 ? 768 : 416, OFFS = MIX == 0 ? 704 : 352, FARREL = MIX == 0 ? -559 : -256;
    constexpr int LDS_K = 0, LDS_V = 3 * SLOT, LDS_T = 6 * SLOT;
    const int tid = threadIdx.x, lane = tid & 63, r32 = lane & 31, hi = lane >> 5; const int wid = __builtin_amdgcn_readfirstlane(tid >> 6);
    int map, rb, R0, T_lo, T_hi, ci, w_lo;
    if (MIX == 0) { map = wid >> 2; rb = wid & 3; R0 = blk * 128; ci = 2 * blk + (rb >> 1); T_lo = 0; T_hi = 2 * blk + 1; w_lo = 0; }
    else { map = 0; rb = wid; R0 = blk * 256; ci = 4 * blk + (rb >> 1); T_lo = 4 * blk - 8 > 0 ? 4 * blk - 8 : 0; T_hi = 4 * blk + 3; w_lo = ci - 8 > 0 ? ci - 8 : 0; }
    const int w_hi = ci, qrow0 = R0 + 32 * rb;
    const size_t rowbase = (size_t)b * SEQ;
    const int hcol = h * KC, qcol = hcol + map * 64;
    const unsigned lds0 = (unsigned)(uintptr_t)lds;
    LAS float* tab = (LAS float*)(lds + LDS_T);
    for (int i = tid; i < TABN; i += NWAVES * 64) tab[i] = tabg[h * TABN + i];
    bf16x8 qr[4];
#pragma unroll
    for (int d0 = 0; d0 < 4; ++d0) qr[d0] = *(const bf16x8*)(Q + (rowbase + qrow0 + r32) * D + qcol + d0 * 16 + hi * 8);
    asm volatile("s_waitcnt vmcnt(0)" ::: "memory");
#pragma unroll
    for (int d0 = 0; d0 < 4; ++d0) asm volatile("" : "+v"(qr[d0]));
    unsigned koff[NP], voff[NP], kdst[NP], vdst[NP];
#pragma unroll
    for (int j = 0; j < NP; ++j) { const int p = wid + 8 * j;
        koff[j] = (unsigned)((lane * D + p * 8) * 2); kdst[j] = lds0 + LDS_K + p * 1024;
        voff[j] = (unsigned)(((16 * (p & 3) + (lane >> 2)) * D + 32 * (p >> 2) + 8 * (lane & 3)) * 2); vdst[j] = lds0 + LDS_V + p * 1024; }
    const bf16* Kbase = K + rowbase * D + hcol; const bf16* Vbase = V + rowbase * D + hcol;
#define ATT_ISSUE(t, slot) do { const bf16* kb_ = Kbase + (size_t)(t) * 64 * D; const bf16* vb_ = Vbase + (size_t)(t) * 64 * D; _Pragma("unroll") for (int j_ = 0; j_ < NP; ++j_) { \
        glds16s(kb_, koff[j_], (unsigned)__builtin_amdgcn_readfirstlane(kdst[j_] + (slot))); \
        glds16s(vb_, voff[j_], (unsigned)__builtin_amdgcn_readfirstlane(vdst[j_] + (slot))); } } while (0)
    const lds_cptr kp0 = (lds_cptr)lds + LDS_K + (map * 8 + hi) * 1024 + r32 * 16;
    const lds_cptr vp0 = (lds_cptr)lds + LDS_V + ((lane >> 4) & 1) * 32 + (lane & 3) * 8 + (4 * hi + ((lane & 15) >> 2)) * 64;
    f32x16 o[NDB];
#pragma unroll
    for (int i = 0; i < NDB; ++i) o[i] = f32x16{};
    float lsum = 0.f;
    int t_first = T_lo;
    if constexpr (MIX == 0) {
        int NF = R0 >= 622 ? ((R0 - 622) / 64 + 1) & ~1 : 0;
        if (NF >= 4) {
#define SB_() __builtin_amdgcn_sched_barrier(0)
#define PIN_(x) asm volatile("" : "+v"(x))
#define MF_(a, b, c) __builtin_amdgcn_mfma_f32_32x32x16_bf16(a, b, c, 0, 0, 0)
#define DMA_K_(t, slot) do { const bf16* kb_ = Kbase + (size_t)(t) * 64 * D; _Pragma("unroll") for (int j_ = 0; j_ < NP; ++j_) glds16s(kb_, koff[j_], (unsigned)__builtin_amdgcn_readfirstlane(kdst[j_] + (slot))); } while (0)
#define DMA_V_(t, slot) do { const bf16* vb_ = Vbase + (size_t)(t) * 64 * D; _Pragma("unroll") for (int j_ = 0; j_ < NP; ++j_) glds16s(vb_, voff[j_], (unsigned)__builtin_amdgcn_readfirstlane(vdst[j_] + (slot))); } while (0)
#define KLD2_(kp, j) do { kf[2 * (j)] = *(const LAS bf16x8*)((kp) + (j) * 2048); kf[2 * (j) + 1] = *(const LAS bf16x8*)((kp) + (j) * 2048 + 512); } while (0)
            const f32x16 zero16 = f32x16{};
            bf16x8 kf[8]; f32x16 pA0, pA1, pB0, pB1; s16x4 vlo[4], vhi[4]; v4u pw0, pw1, pw2, pw3;
            int sl_prev = 0, sl_cur = 0, sl_next = SLOT;
#define ROT_() do { sl_prev = sl_cur; sl_cur = sl_next; sl_next = (sl_next == 2 * SLOT) ? 0 : sl_next + SLOT; } while (0)
            DMA_K_(0, 0); DMA_V_(0, 0); DMA_K_(1, SLOT); DMA_K_(2, 2 * SLOT);
            ATT_WAIT_BAR(6);
            { const lds_cptr kp = kp0;
#pragma unroll
              for (int d0 = 0; d0 < 4; ++d0) { const bf16x8 k0 = *(const LAS bf16x8*)(kp + d0 * 2048), k1 = *(const LAS bf16x8*)(kp + d0 * 2048 + 512);
                  if (d0 == 0) { pA0 = MF_(k0, qr[0], zero16); pA1 = MF_(k1, qr[0], zero16); } else { pA0 = MF_(k0, qr[d0], pA0); pA1 = MF_(k1, qr[d0], pA1); } }
#pragma unroll
              for (int r = 0; r < 16; ++r) { pA0[r] = __builtin_amdgcn_exp2f(pA0[r]); pA1[r] = __builtin_amdgcn_exp2f(pA1[r]); } }
            ATT_WAIT_BAR(0);
            DMA_K_(3, 0); DMA_V_(1, SLOT);
            ROT_();
#pragma unroll
            for (int j = 0; j < 4; ++j) KLD2_(kp0 + sl_cur, j);
            ATT_WAIT_BAR(4);
#define PKW_(P, B) cvt_pk_bf16(P[B], P[(B) + 1])
#define PAF_(k) __builtin_bit_cast(bf16x8, pw##k)
#define VRD_(f) do { vlo[(f) & 3] = vtr(vp_ + (((f) >> 2) * 4096 + ((f) & 3) * 1024)); vhi[(f) & 3] = vtr(vp_ + (((f) >> 2) * 4096 + ((f) & 3) * 1024 + 512)); } while (0)
#define VFR_(f) (bf16x8){vlo[(f) & 3][0], vlo[(f) & 3][1], vlo[(f) & 3][2], vlo[(f) & 3][3], vhi[(f) & 3][0], vhi[(f) & 3][1], vhi[(f) & 3][2], vhi[(f) & 3][3]}
#define GAPA_(CX, MFX, A0, A1, A2, A3, W0, W1, PW) do { MFX; PIN_(CX); sacc += A0; sacc += A1; sacc += A2; sacc += A3; PIN_(sacc); W0; W1; PIN_(PW); SB_(); } while (0)
#define GAPB_(f, X, B, PK) do { o[(f) >> 2] = MF_(VFR_(f), PAF_(PK), o[(f) >> 2]); X[B] = __builtin_amdgcn_exp2f(X[B]); X[(B) + 1] = __builtin_amdgcn_exp2f(X[(B) + 1]); PIN_(X); if ((f) + 4 < 16) VRD_((f) + 4); SB_(); } while (0)
#define KRD_(G, j) do { if (G) { KLD2_(kp0 + sl_next, j); SB_(); } } while (0)
#define STEP_(C0, C1, P0, P1, t, GK, GV, GL) do { SB_(); \
            const lds_cptr vp_ = vp0 + sl_prev; \
            float sacc = (P0[0] + P0[1]); \
            GAPA_(C0, C0 = MF_(kf[0], qr[0], zero16), P0[2], P0[3], P0[4], P0[5],     pw0[0] = PKW_(P0, 0), pw0[1] = PKW_(P0, 2), pw0); \
            GAPA_(C1, C1 = MF_(kf[1], qr[0], zero16), P0[6], P0[7], P0[8], P0[9],     pw0[2] = PKW_(P0, 4), pw0[3] = PKW_(P0, 6), pw0); \
            GAPA_(C0, C0 = MF_(kf[2], qr[1], C0),   P0[10], P0[11], P0[12], P0[13], pw1[0] = PKW_(P0, 8), pw1[1] = PKW_(P0, 10), pw1); \
            GAPA_(C1, C1 = MF_(kf[3], qr[1], C1),   P0[14], P0[15], P1[0], P1[1],   pw1[2] = PKW_(P0, 12), pw1[3] = PKW_(P0, 14), pw1); \
            VRD_(0); SB_(); GAPA_(C0, C0 = MF_(kf[4], qr[2], C0),   P1[2], P1[3], P1[4], P1[5],     pw2[0] = PKW_(P1, 0), pw2[1] = PKW_(P1, 2), pw2); \
            VRD_(1); SB_(); GAPA_(C1, C1 = MF_(kf[5], qr[2], C1),   P1[6], P1[7], P1[8], P1[9],     pw2[2] = PKW_(P1, 4), pw2[3] = PKW_(P1, 6), pw2); \
            VRD_(2); SB_(); GAPA_(C0, C0 = MF_(kf[6], qr[3], C0),   P1[10], P1[11], P1[12], P1[13], pw3[0] = PKW_(P1, 8), pw3[1] = PKW_(P1, 10), pw3); \
            VRD_(3); SB_(); GAPA_(C1, C1 = MF_(kf[7], qr[3], C1),   P1[14], P1[15], 0.f, 0.f,       pw3[2] = PKW_(P1, 12), pw3[3] = PKW_(P1, 14), pw3); \
            PIN_(P0); PIN_(P1); lsum += sacc; \
            if (GK) { DMA_K_((t) + 3, sl_cur); } if (GV) { DMA_V_((t) + 1, sl_next); } \
            SB_(); \
            GAPB_(0, C0, 0, 0); GAPB_(1, C0, 2, 1); GAPB_(2, C0, 4, 2); \
            KRD_(GL, 0); GAPB_(3, C0, 6, 3); \
            KRD_(GL, 1); GAPB_(4, C0, 8, 0); \
            KRD_(GL, 2); GAPB_(5, C0, 10, 1); \
            KRD_(GL, 3); GAPB_(6, C0, 12, 2); GAPB_(7, C0, 14, 3); \
            GAPB_(8, C1, 0, 0); GAPB_(9, C1, 2, 1); GAPB_(10, C1, 4, 2); GAPB_(11, C1, 6, 3); \
            GAPB_(12, C1, 8, 0); GAPB_(13, C1, 10, 1); GAPB_(14, C1, 12, 2); GAPB_(15, C1, 14, 3); \
        } while (0)
#define ENDW_(tt) do { if ((tt) + 3 < NF) { ATT_WAIT_BAR(4); } else if ((tt) + 2 < NF) { ATT_WAIT_BAR(2); } else { ATT_WAIT_BAR(0); } } while (0)
            int t = 1;
            for (; t + 5 < NF; t += 2) {
                STEP_(pB0, pB1, pA0, pA1, t, true, true, true);       ATT_WAIT_BAR(4); ROT_();
                STEP_(pA0, pA1, pB0, pB1, t + 1, true, true, true);   ATT_WAIT_BAR(4); ROT_();
            }
            for (; t + 1 < NF; t += 2) {
                STEP_(pB0, pB1, pA0, pA1, t, (t + 3 < NF), (t + 1 < NF), (t + 1 < NF));         ENDW_(t);     ROT_();
                STEP_(pA0, pA1, pB0, pB1, t + 1, (t + 4 < NF), (t + 2 < NF), (t + 2 < NF));     ENDW_(t + 1); ROT_();
            }
            STEP_(pB0, pB1, pA0, pA1, NF - 1, false, false, false);
            { float sacc = pB0[0] + pB0[1];
#pragma unroll
              for (int r = 2; r < 16; ++r) sacc += pB0[r];
#pragma unroll
              for (int r = 0; r < 16; ++r) sacc += pB1[r];
              lsum += sacc;
              pw0 = (v4u){PKW_(pB0, 0), PKW_(pB0, 2), PKW_(pB0, 4), PKW_(pB0, 6)}; pw1 = (v4u){PKW_(pB0, 8), PKW_(pB0, 10), PKW_(pB0, 12), PKW_(pB0, 14)};
              pw2 = (v4u){PKW_(pB1, 0), PKW_(pB1, 2), PKW_(pB1, 4), PKW_(pB1, 6)}; pw3 = (v4u){PKW_(pB1, 8), PKW_(pB1, 10), PKW_(pB1, 12), PKW_(pB1, 14)};
              SB_();
              const lds_cptr vp = vp0 + sl_cur;
#pragma unroll
              for (int db = 0; db < NDB; ++db) {
                  { const s16x4 lo = vtr(vp + db * 4096), hh = vtr(vp + db * 4096 + 512); o[db] = MF_(((bf16x8){lo[0], lo[1], lo[2], lo[3], hh[0], hh[1], hh[2], hh[3]}), PAF_(0), o[db]); }
                  { const s16x4 lo = vtr(vp + db * 4096 + 1024), hh = vtr(vp + db * 4096 + 1024 + 512); o[db] = MF_(((bf16x8){lo[0], lo[1], lo[2], lo[3], hh[0], hh[1], hh[2], hh[3]}), PAF_(1), o[db]); }
                  { const s16x4 lo = vtr(vp + db * 4096 + 2048), hh = vtr(vp + db * 4096 + 2048 + 512); o[db] = MF_(((bf16x8){lo[0], lo[1], lo[2], lo[3], hh[0], hh[1], hh[2], hh[3]}), PAF_(2), o[db]); }
                  { const s16x4 lo = vtr(vp + db * 4096 + 3072), hh = vtr(vp + db * 4096 + 3072 + 512); o[db] = MF_(((bf16x8){lo[0], lo[1], lo[2], lo[3], hh[0], hh[1], hh[2], hh[3]}), PAF_(3), o[db]); } } }
            ATT_WAIT_BAR(0);
            t_first = NF;
#undef SB_
#undef PIN_
#undef MF_
#undef DMA_K_
#undef DMA_V_
#undef KLD2_
#undef ROT_
#undef PKW_
#undef PAF_
#undef VRD_
#undef VFR_
#undef GAPA_
#undef GAPB_
#undef KRD_
#undef STEP_
#undef ENDW_
        }
    }
    ATT_ISSUE(t_first, 0); if (t_first + 1 <= T_hi) ATT_ISSUE(t_first + 1, SLOT);
    int sl = 0;
    for (int t = t_first; t <= T_hi; ++t) {
        if (t < T_hi) { if (NP == 2) ATT_WAIT_BAR(4); else ATT_WAIT_BAR(2); } else ATT_WAIT_BAR(0);
        if (t + 2 <= T_hi) { const int s2 = sl >= SLOT ? sl - SLOT : sl + 2 * SLOT; ATT_ISSUE(t + 2, s2); }
        if (t >= w_lo && t <= w_hi) {
            f32x16 p0, p1;
            const int maxrel = 64 * t + 63 - qrow0;
            if (maxrel > FARREL) { const LAS float* tp = tab + (64 * t + 4 * hi - (qrow0 + r32) + OFFS);
#pragma unroll
                for (int r = 0; r < 16; ++r) { p0[r] = tp[(r & 3) + 8 * (r >> 2)]; p1[r] = tp[32 + (r & 3) + 8 * (r >> 2)]; } }
            else { p0 = f32x16{}; p1 = f32x16{}; }
            const lds_cptr kp = kp0 + sl;
#pragma unroll
            for (int d0 = 0; d0 < 4; ++d0) { const bf16x8 k0 = *(const LAS bf16x8*)(kp + d0 * 2048), k1 = *(const LAS bf16x8*)(kp + d0 * 2048 + 512);
                p0 = __builtin_amdgcn_mfma_f32_32x32x16_bf16(k0, qr[d0], p0, 0, 0, 0); p1 = __builtin_amdgcn_mfma_f32_32x32x16_bf16(k1, qr[d0], p1, 0, 0, 0); }
            float sa = 0.f, sb = 0.f;
#pragma unroll
            for (int r = 0; r < 16; ++r) { p0[r] = __builtin_amdgcn_exp2f(p0[r]); p1[r] = __builtin_amdgcn_exp2f(p1[r]); sa += p0[r]; sb += p1[r]; }
            lsum += sa + sb;
            v4u pw[4];
            pw[0] = (v4u){cvt_pk_bf16(p0[0], p0[1]), cvt_pk_bf16(p0[2], p0[3]), cvt_pk_bf16(p0[4], p0[5]), cvt_pk_bf16(p0[6], p0[7])};
            pw[1] = (v4u){cvt_pk_bf16(p0[8], p0[9]), cvt_pk_bf16(p0[10], p0[11]), cvt_pk_bf16(p0[12], p0[13]), cvt_pk_bf16(p0[14], p0[15])};
            pw[2] = (v4u){cvt_pk_bf16(p1[0], p1[1]), cvt_pk_bf16(p1[2], p1[3]), cvt_pk_bf16(p1[4], p1[5]), cvt_pk_bf16(p1[6], p1[7])};
            pw[3] = (v4u){cvt_pk_bf16(p1[8], p1[9]), cvt_pk_bf16(p1[10], p1[11]), cvt_pk_bf16(p1[12], p1[13]), cvt_pk_bf16(p1[14], p1[15])};
            const lds_cptr vp = vp0 + sl;
#pragma unroll
            for (int db = 0; db < NDB; ++db)
#pragma unroll
                for (int s = 0; s < 4; ++s) { const s16x4 lo = vtr(vp + db * 4096 + s * 1024), hh = vtr(vp + db * 4096 + s * 1024 + 512);
                    const bf16x8 vf = (bf16x8){lo[0], lo[1], lo[2], lo[3], hh[0], hh[1], hh[2], hh[3]};
                    o[db] = __builtin_amdgcn_mfma_f32_32x32x16_bf16(vf, __builtin_bit_cast(bf16x8, pw[s]), o[db], 0, 0, 0); }
        }
        sl = sl == 2 * SLOT ? 0 : sl + SLOT;
    }
    const float l = swap_add(lsum);
    const size_t orow = (rowbase + qrow0 + r32) * D;
    if (MIX == 0) {
        const float f = (map == 0 ? 1.f : -lam) / l;
        ATT_WAIT_BAR(0);
        LAS float* X = (LAS float*)lds + rb * 4096 + lane;
        if (map == 1) {
#pragma unroll
            for (int db = 0; db < NDB; ++db)
#pragma unroll
                for (int r = 0; r < 16; ++r) X[(db * 16 + r) * 64] = o[db][r] * f; }
        ATT_WAIT_BAR(0);
        if (map == 0) { float ss = 0.f;
#pragma unroll
            for (int db = 0; db < NDB; ++db)
#pragma unroll
                for (int r = 0; r < 16; ++r) { const float v = o[db][r] * f + X[(db * 16 + r) * 64]; o[db][r] = v; ss += v * v; }
            ss = swap_add(ss);
            const float inv = rsqrtf(ss * (1.f / 128.f) + NORM_EPS) * 0.8f;
#pragma unroll
            for (int db = 0; db < NDB; ++db)
#pragma unroll
                for (int g = 0; g < 4; ++g) { const int d = 32 * db + 8 * g + 4 * hi; const f32x4 sg = *(const f32x4*)(subg + d);
                    v2u w; w.x = cvt_pk_bf16(o[db][4 * g] * inv * sg[0], o[db][4 * g + 1] * inv * sg[1]); w.y = cvt_pk_bf16(o[db][4 * g + 2] * inv * sg[2], o[db][4 * g + 3] * inv * sg[3]);
                    *(v2u*)(O + orow + h * 128 + d) = w; } }
        ATT_WAIT_BAR(0);
    } else {
        const float f = 1.f / l;
#pragma unroll
        for (int db = 0; db < NDB; ++db)
#pragma unroll
            for (int g = 0; g < 4; ++g) { const int d = 32 * db + 8 * g + 4 * hi;
                v2u w; w.x = cvt_pk_bf16(o[db][4 * g] * f, o[db][4 * g + 1] * f); w.y = cvt_pk_bf16(o[db][4 * g + 2] * f, o[db][4 * g + 3] * f);
                *(v2u*)(O + orow + h * 64 + d) = w; }
        ATT_WAIT_BAR(0);
    }
#undef ATT_ISSUE
}
#undef ATT_WAIT_BAR
}

struct Args { Ptrs P; int ph_lo, ph_hi; };
struct Frame { LAS unsigned char* lds; volatile LAS unsigned* MISC; gu32* ctl; int tid, lane, wave, vcu, G; };

__device__ __forceinline__ void norm_row(const float* xrow, const float* g, const float* mb, int sh_off, int sc_off, bf16* hrow, int lane) {
    f32x4 v[4]; float ss = 0.f;
#pragma unroll
    for (int j = 0; j < 4; ++j) { v[j] = ((const f32x4*)xrow)[lane + 64 * j]; ss += (v[j][0] * v[j][0] + v[j][1] * v[j][1]) + (v[j][2] * v[j][2] + v[j][3] * v[j][3]); }
    const float inv = rsqrtf(wave_sum(ss) * (1.f / D) + NORM_EPS);
#pragma unroll
    for (int j = 0; j < 4; ++j) { const int c0 = (lane + 64 * j) * 4;
        const f32x4 gg = *(const f32x4*)(g + c0), sc = *(const f32x4*)(mb + sc_off + c0), sh = *(const f32x4*)(mb + sh_off + c0);
        const f32x4 o = v[j] * inv * gg * (sc + 1.f) + sh;
        v2u w; w.x = cvt_pk_bf16(o[0], o[1]); w.y = cvt_pk_bf16(o[2], o[3]); *(v2u*)(hrow + c0) = w; }
}
__device__ __forceinline__ void route_row(int row, const float* xin, const float* g, const float* mb, int sh_off, int sc_off, bf16* h, const float* rw, const float* rb, unsigned* cnt, unsigned* ltok, float* lw, int lane) {
    float hv[16]; float ss = 0.f;
#pragma unroll
    for (int j = 0; j < 4; ++j) { const f32x4 v = ((const f32x4*)(xin + (size_t)row * D))[lane + 64 * j]; hv[4 * j] = v[0]; hv[4 * j + 1] = v[1]; hv[4 * j + 2] = v[2]; hv[4 * j + 3] = v[3]; ss += (v[0] * v[0] + v[1] * v[1]) + (v[2] * v[2] + v[3] * v[3]); }
    const float inv = rsqrtf(wave_sum(ss) * (1.f / D) + NORM_EPS);
    float lg[16];
#pragma unroll
    for (int e = 0; e < 16; ++e) lg[e] = 0.f;
#pragma unroll
    for (int j = 0; j < 4; ++j) {
        const int c0 = (lane + 64 * j) * 4;
        const f32x4 gg = *(const f32x4*)(g + c0), sc = *(const f32x4*)(mb + sc_off + c0), sh = *(const f32x4*)(mb + sh_off + c0);
#pragma unroll
        for (int i = 0; i < 4; ++i) hv[4 * j + i] = hv[4 * j + i] * inv * gg[i] * (1.f + sc[i]) + sh[i];
        v2u w; w.x = cvt_pk_bf16(hv[4 * j], hv[4 * j + 1]); w.y = cvt_pk_bf16(hv[4 * j + 2], hv[4 * j + 3]);
        *(v2u*)(h + (size_t)row * D + c0) = w;
#pragma unroll
        for (int i = 0; i < 4; ++i) { const f32x4* wr = (const f32x4*)(rw + (size_t)(c0 + i) * NE); const float x = hv[4 * j + i];
#pragma unroll
            for (int q = 0; q < 4; ++q) { const f32x4 w4 = wr[q]; lg[4 * q] += x * w4[0]; lg[4 * q + 1] += x * w4[1]; lg[4 * q + 2] += x * w4[2]; lg[4 * q + 3] += x * w4[3]; } }
    }
#pragma unroll
    for (int e = 0; e < 16; ++e) lg[e] = wave_sum(lg[e]);
    if (lane == 0) {
        float sc[16], sel[16];
#pragma unroll
        for (int e = 0; e < 16; ++e) { sc[e] = 1.f / (1.f + __expf(-lg[e])); sel[e] = sc[e] + rb[e]; }
        int bg = 0; float bgs = -3e38f;
#pragma unroll
        for (int gi = 0; gi < 4; ++gi) {
            float m1 = -3e38f, m2 = -3e38f;
#pragma unroll
            for (int i = 0; i < 4; ++i) { const float v = sel[gi * 4 + i]; if (v > m1) { m2 = m1; m1 = v; } else if (v > m2) m2 = v; }
            const float gs = m1 + m2; if (gs > bgs) { bgs = gs; bg = gi; }
        }
        int e0 = 0, e1 = 0; float s0 = -3e38f, s1 = -3e38f, w0 = 0.f, w1 = 0.f;
#pragma unroll
        for (int gi = 0; gi < 4; ++gi) if (gi == bg) {
#pragma unroll
            for (int i = 0; i < 4; ++i) { const int e = gi * 4 + i; const float v = sel[e];
                if (v > s0) { s1 = s0; e1 = e0; w1 = w0; s0 = v; e0 = e; w0 = sc[e]; } else if (v > s1) { s1 = v; e1 = e; w1 = sc[e]; } }
        }
        const float ws = w0 + w1; w0 /= ws; w1 /= ws;
        const unsigned p0 = atomicAdd(&cnt[e0 * 64], 1u), p1 = atomicAdd(&cnt[e1 * 64], 1u);
        ltok[(size_t)e0 * T + p0] = (unsigned)row; lw[(size_t)e0 * T + p0] = w0;
        ltok[(size_t)e1 * T + p1] = (unsigned)row | 0x80000000u; lw[(size_t)e1 * T + p1] = w1;
    }
}
__device__ __forceinline__ void route_phase(Frame& F, const float* xin, const float* g, const float* mod_l, bf16* h, const float* rw, const float* rb, unsigned* cnt, unsigned* ltok, float* lw) {
    LAS float* rws = (LAS float*)F.lds;
    LAS unsigned* lcnt = (LAS unsigned*)(F.lds + 65536);
    const int lane = F.lane, e_l = lane & 15;
    for (int t = F.tid; t < 1024 * 4; t += NWAVES * 64) { const int k = t >> 2, q = t & 3; const f32x4 v = *(const f32x4*)(rw + (size_t)k * NE + 4 * q);
        const int j = k >> 8, ln = (k >> 2) & 63, i = k & 3; *(LAS f32x4*)(rws + ((((j * 4 + i) * 4 + q) * 64 + ln) * 4)) = v; }
    const float rbe = rb[e_l];
    for (int chunk = F.vcu; chunk < T / 64; chunk += F.G) {
        if (F.tid < 16) lcnt[F.tid] = 0u;
        __syncthreads();
        const int row0 = chunk * 64 + F.wave * 8, b = row0 / SEQ;
        const float* mb = mod_l + b * 6 * D;
        f32x4 Gm[4], Sh[4];
#pragma unroll
        for (int j = 0; j < 4; ++j) { const int c0 = (lane + 64 * j) * 4; const f32x4 gg = *(const f32x4*)(g + c0), sc = *(const f32x4*)(mb + 4 * D + c0); Gm[j] = gg * (sc + 1.f); Sh[j] = *(const f32x4*)(mb + 3 * D + c0); }
        unsigned s_tok[2], s_pl[2]; float s_w[2]; bool s_sel[2];
#pragma unroll
        for (int grp = 0; grp < 2; ++grp) {
            const int r0 = row0 + grp * 4;
            f32x4 xv[4][4];
#pragma unroll
            for (int r = 0; r < 4; ++r)
#pragma unroll
                for (int j = 0; j < 4; ++j) xv[r][j] = *(const f32x4*)(xin + (size_t)(r0 + r) * D + (lane + 64 * j) * 4);
            float ss[4];
#pragma unroll
            for (int r = 0; r < 4; ++r) { ss[r] = 0.f;
#pragma unroll
                for (int j = 0; j < 4; ++j) ss[r] += (xv[r][j][0] * xv[r][j][0] + xv[r][j][1] * xv[r][j][1]) + (xv[r][j][2] * xv[r][j][2] + xv[r][j][3] * xv[r][j][3]); }
#pragma unroll
            for (int o = 1; o < 64; o <<= 1)
#pragma unroll
                for (int r = 0; r < 4; ++r) ss[r] += __shfl_xor(ss[r], o);
#pragma unroll
            for (int r = 0; r < 4; ++r) { const float inv = rsqrtf(ss[r] * (1.f / D) + NORM_EPS);
#pragma unroll
                for (int j = 0; j < 4; ++j) { xv[r][j] = xv[r][j] * inv * Gm[j] + Sh[j];
                    v2u w; w.x = cvt_pk_bf16(xv[r][j][0], xv[r][j][1]); w.y = cvt_pk_bf16(xv[r][j][2], xv[r][j][3]); *(v2u*)(h + (size_t)(r0 + r) * D + (lane + 64 * j) * 4) = w; } }
            float acc[64];
#pragma unroll
            for (int v = 0; v < 64; ++v) acc[v] = 0.f;
#pragma unroll
            for (int j = 0; j < 4; ++j)
#pragma unroll
                for (int i = 0; i < 4; ++i) {
                    f32x4 wq[4];
#pragma unroll
                    for (int q = 0; q < 4; ++q) wq[q] = *(const LAS f32x4*)(rws + ((((j * 4 + i) * 4 + q) * 64 + lane) * 4));
#pragma unroll
                    for (int r = 0; r < 4; ++r) { const float x = xv[r][j][i];
#pragma unroll
                        for (int q = 0; q < 4; ++q)
#pragma unroll
                            for (int c = 0; c < 4; ++c) acc[r * 16 + q * 4 + c] += x * wq[q][c]; } }
#pragma unroll
            for (int s = 32; s >= 1; s >>= 1) { const bool up = (lane & s) != 0;
#pragma unroll
                for (int v = 0; v < s; ++v) { const float a = acc[v], bq = acc[v + s]; const float keep = up ? bq : a, send = up ? a : bq; acc[v] = keep + __shfl_xor(send, s); } }
            const float sc = 1.f / (1.f + __expf(-acc[0])), sel = sc + rbe;
            const int q0 = lane & ~3, me = lane & 3, myg = (lane >> 2) & 3;
            float v4[4], s4[4];
#pragma unroll
            for (int i = 0; i < 4; ++i) { v4[i] = __shfl(sel, q0 + i); s4[i] = __shfl(sc, q0 + i); }
            float m1 = -3e38f, m2 = -3e38f;
#pragma unroll
            for (int i = 0; i < 4; ++i) { const float x = v4[i]; if (x > m1) { m2 = m1; m1 = x; } else if (x > m2) m2 = x; }
            const float gs = m1 + m2;
            int bg = 0; float best = -3e38f;
#pragma unroll
            for (int gi = 0; gi < 4; ++gi) { const float x = __shfl(gs, (lane & ~15) + 4 * gi); if (x > best) { best = x; bg = gi; } }
            int myrank = 0; float scsum = 0.f;
#pragma unroll
            for (int i = 0; i < 4; ++i) { int rk = 0;
#pragma unroll
                for (int j = 0; j < 4; ++j) if (j != i) rk += (v4[j] > v4[i] || (v4[j] == v4[i] && j < i)) ? 1 : 0;
                if (rk < 2) scsum += s4[i];
                if (i == me) myrank = rk; }
            const bool selected = (myg == bg) && (myrank < 2);
            s_sel[grp] = selected; s_w[grp] = sc / scsum; s_tok[grp] = (unsigned)(r0 + (lane >> 4)) | ((unsigned)myrank << 31); s_pl[grp] = 0u;
            if (selected) s_pl[grp] = __hip_atomic_fetch_add(lcnt + e_l, 1u, __ATOMIC_RELAXED, __HIP_MEMORY_SCOPE_WORKGROUP);
        }
        __syncthreads();
        if (F.tid < 16) lcnt[16 + F.tid] = atomicAdd(&cnt[F.tid * 64], lcnt[F.tid]);
        __syncthreads();
#pragma unroll
        for (int grp = 0; grp < 2; ++grp) if (s_sel[grp]) { const size_t idx = (size_t)e_l * T + lcnt[16 + e_l] + s_pl[grp]; ltok[idx] = s_tok[grp]; lw[idx] = s_w[grp]; }
        __syncthreads();
    }
}
template <int NR>
__device__ __forceinline__ void combine_rows(int row0, int rstride, float* xio, const bf16* ybuf, const float* gate, bool do_norm, const float* g, const float* mbn, bf16* h, int lane) {
    f32x4 v[NR][4]; v2u y0[NR][4], y1[NR][4];
#pragma unroll
    for (int r = 0; r < NR; ++r)
#pragma unroll
        for (int j = 0; j < 4; ++j) { const int c0 = (lane + 64 * j) * 4; const size_t ro = (size_t)(row0 + r * rstride) * D + c0;
            v[r][j] = *(const f32x4*)(xio + ro); y0[r][j] = *(const v2u*)(ybuf + ro); y1[r][j] = *(const v2u*)(ybuf + (size_t)T * D + ro); }
    float ss[NR];
#pragma unroll
    for (int r = 0; r < NR; ++r) { ss[r] = 0.f;
#pragma unroll
        for (int j = 0; j < 4; ++j) { const int c0 = (lane + 64 * j) * 4; const size_t ro = (size_t)(row0 + r * rstride) * D + c0;
            const f32x4 gt = *(const f32x4*)(gate + c0);
            v[r][j][0] += gt[0] * (bf2f(y0[r][j].x) + bf2f(y1[r][j].x)); v[r][j][1] += gt[1] * (bf2f(y0[r][j].x >> 16) + bf2f(y1[r][j].x >> 16));
            v[r][j][2] += gt[2] * (bf2f(y0[r][j].y) + bf2f(y1[r][j].y)); v[r][j][3] += gt[3] * (bf2f(y0[r][j].y >> 16) + bf2f(y1[r][j].y >> 16));
            *(f32x4*)(xio + ro) = v[r][j];
            ss[r] += (v[r][j][0] * v[r][j][0] + v[r][j][1] * v[r][j][1]) + (v[r][j][2] * v[r][j][2] + v[r][j][3] * v[r][j][3]); } }
    if (do_norm) {
#pragma unroll
        for (int o = 1; o < 64; o <<= 1)
#pragma unroll
            for (int r = 0; r < NR; ++r) ss[r] += __shfl_xor(ss[r], o);
#pragma unroll
        for (int r = 0; r < NR; ++r) { const float inv = rsqrtf(ss[r] * (1.f / D) + NORM_EPS);
#pragma unroll
            for (int j = 0; j < 4; ++j) { const int c0 = (lane + 64 * j) * 4;
                const f32x4 gg = *(const f32x4*)(g + c0), sc = *(const f32x4*)(mbn + D + c0), sh = *(const f32x4*)(mbn + c0);
                const f32x4 o = v[r][j] * inv * gg * (sc + 1.f) + sh;
                v2u w; w.x = cvt_pk_bf16(o[0], o[1]); w.y = cvt_pk_bf16(o[2], o[3]); *(v2u*)(h + (size_t)(row0 + r * rstride) * D + c0) = w; } }
    }
}

template <class RowMap>
__device__ __forceinline__ void transpose_item(const float* W, int K, int N, bf16* WT, RowMap rm, LAS float* scr, int item, int lane) {
    const int nblk = N / 32, kb = item / nblk, nb = item % nblk, k0 = 64 * kb, n0 = 32 * nb;
    f32x4 v[8];
#pragma unroll
    for (int i = 0; i < 8; ++i) { const int kk = (lane >> 3) + 8 * i; v[i] = *(const f32x4*)(W + (size_t)(k0 + kk) * N + n0 + (lane & 7) * 4); }
#pragma unroll
    for (int i = 0; i < 8; ++i) { const int kk = (lane >> 3) + 8 * i; LAS float* d = scr + kk * 33 + (lane & 7) * 4; d[0] = v[i][0]; d[1] = v[i][1]; d[2] = v[i][2]; d[3] = v[i][3]; }
    LDS_WAIT(); asm volatile("" ::: "memory");
    const int c = lane & 7;
#pragma unroll
    for (int j = 0; j < 4; ++j) { const int n = (lane >> 3) + 8 * j; const LAS float* s = scr + (8 * c) * 33 + n;
        v4u o; o.x = cvt_pk_bf16(s[0 * 33], s[1 * 33]); o.y = cvt_pk_bf16(s[2 * 33], s[3 * 33]); o.z = cvt_pk_bf16(s[4 * 33], s[5 * 33]); o.w = cvt_pk_bf16(s[6 * 33], s[7 * 33]);
        *(v4u*)(WT + (size_t)rm(n0 + n) * K + k0 + 8 * c) = o; }
    LDS_WAIT(); asm volatile("" ::: "memory");
}
struct RmId { __device__ __forceinline__ int operator()(int n) const { return n; } };
struct RmQkv { __device__ __forceinline__ int operator()(int n) const { return (n & ~255) + 128 * ((n >> 5) & 1) + 32 * ((n >> 6) & 3) + (n & 31); } };
struct RmGU { int add; __device__ __forceinline__ int operator()(int n) const { return 256 * (n >> 7) + (n & 127) + add; } };

__device__ __forceinline__ int t5_bucket_fast(int rel) {
    const int ret = rel > 0 ? 16 : 0; const int n = rel < 0 ? -rel : rel;
    const int large = 8 + (n >= 15) + (n >= 27) + (n >= 50) + (n >= 91) + (n >= 166) + (n >= 305) + (n >= 559);
    return ret + (n < 8 ? n : large);
}
constexpr int TABA_N = 768, TABB_N = 416;
constexpr int MISC_TABA = 64, MISC_TABB = MISC_TABA + 8 * TABA_N;

__device__ __forceinline__ void p0_prologue(Frame& F, const Ptrs& P) {
    const int gw = F.vcu * NWAVES + F.wave, NGW = F.G * NWAVES, lane = F.lane;
    float* mod = (float*)(P.ws + WS_MOD); float* misc = (float*)(P.ws + WS_MISC);
    for (int it = gw; it < DEPTH * 384; it += NGW) {
        const int l = it / 384, n0 = (it % 384) * 16, kq = lane >> 2, cq = lane & 3;
        f32x4 a0 = {0.f, 0.f, 0.f, 0.f}, a1 = {0.f, 0.f, 0.f, 0.f};
#pragma unroll 8
        for (int i = 0; i < 64; ++i) { const int k = kq + 16 * i; const f32x4 w4 = *(const f32x4*)(P.ada_w + ((size_t)l * D + k) * (6 * D) + n0 + 4 * cq);
            const float c0 = P.c[k], c1 = P.c[D + k]; const float s0 = c0 / (1.f + __expf(-c0)), s1 = c1 / (1.f + __expf(-c1)); a0 += w4 * s0; a1 += w4 * s1; }
#pragma unroll
        for (int o = 4; o < 64; o <<= 1)
#pragma unroll
            for (int i = 0; i < 4; ++i) { a0[i] += __shfl_xor(a0[i], o); a1[i] += __shfl_xor(a1[i], o); }
        if (kq == 0) { const f32x4 bb = *(const f32x4*)(P.ada_b + l * 6 * D + n0 + 4 * cq);
            *(f32x4*)(mod + (l * 2 + 0) * 6 * D + n0 + 4 * cq) = a0 + bb; *(f32x4*)(mod + (l * 2 + 1) * 6 * D + n0 + 4 * cq) = a1 + bb; }
    }
    if (gw == NGW - 1 && lane == 0) { float s01 = 0.f, s23 = 0.f;
        for (int d = 0; d < 64; ++d) { s01 += P.a_lambda[d] * P.a_lambda[64 + d]; s23 += P.a_lambda[128 + d] * P.a_lambda[192 + d]; }
        misc[0] = __expf(s01) - __expf(s23) + 0.2f; }
    for (int i = gw * 64 + lane; i < 8 * TABA_N + 16 * TABB_N; i += NGW * 64) {
        if (i < 8 * TABA_N) { const int h = i / TABA_N, rel = i % TABA_N - 704; misc[MISC_TABA + i] = (P.t5_bias[t5_bucket_fast(rel) * 8 + h] - P.t5_bias[15 * 8 + h]) * LOG2E; }
        else { const int j = i - 8 * TABA_N, h = j / TABB_N; int rel = j % TABB_N - 352; rel = rel < -256 ? -256 : (rel > 256 ? 256 : rel);
            misc[MISC_TABB + j] = (P.b_rel_bias[h * 513 + rel + 256] - P.b_rel_bias[h * 513]) * LOG2E; }
    }
    LAS float* scr = (LAS float*)(F.lds + F.wave * 16384);
    constexpr int I_QKV = 16 * 96, I_WO = 16 * 32, I_E = 256, I_DENSE = 2 * (I_QKV + I_WO), NITEMS = I_DENSE + DEPTH * NE * 3 * I_E;
    for (int it = gw; it < NITEMS; it += NGW) {
        int r = it;
        if (r < I_QKV) { transpose_item(P.a_w_qkv, D, 3 * D, (bf16*)(P.ws + WS_WQKV_A), RmQkv{}, scr, r, lane); continue; } r -= I_QKV;
        if (r < I_WO) { transpose_item(P.a_w_o, D, D, (bf16*)(P.ws + WS_WO_A), RmId{}, scr, r, lane); continue; } r -= I_WO;
        if (r < I_QKV) { transpose_item(P.b_w_qkv, D, 3 * D, (bf16*)(P.ws + WS_WQKV_B), RmQkv{}, scr, r, lane); continue; } r -= I_QKV;
        if (r < I_WO) { transpose_item(P.b_w_o, D, D, (bf16*)(P.ws + WS_WO_B), RmId{}, scr, r, lane); continue; } r -= I_WO;
        const int le = r / (3 * I_E), which = (r / I_E) % 3, item = r % I_E;
        if (which == 0) transpose_item(P.moe_w_gate + (size_t)le * D * FF, D, FF, (bf16*)(P.ws + WS_WGU) + (size_t)le * 1024 * D, RmGU{0}, scr, item, lane);
        else if (which == 1) transpose_item(P.moe_w_up + (size_t)le * D * FF, D, FF, (bf16*)(P.ws + WS_WGU) + (size_t)le * 1024 * D, RmGU{128}, scr, item, lane);
        else transpose_item(P.moe_w_down + (size_t)le * FF * D, FF, D, (bf16*)(P.ws + WS_WD) + (size_t)le * D * FF, RmId{}, scr, item, lane);
    }
}

__device__ __forceinline__ void moe_prep(Frame& F, const unsigned* cnt) {
    LAS unsigned* tab = (LAS unsigned*)(F.lds + TAB_OFF);
    if (F.tid == 0) { int rt = 0, base = 0;
        for (int e = 0; e < NE; ++e) { const int c = (int)cnt[e * 64]; const int ntl = (c + 255) >> 8; tab[160 + e] = (unsigned)base; tab[176 + e] = (unsigned)c;
            for (int i = 0; i < ntl; ++i) tab[1 + rt + i] = (unsigned)e | ((unsigned)i << 8);
            rt += ntl; base += ntl * 256; }
        tab[0] = (unsigned)rt; }
    __syncthreads();
}

#ifndef REP_P0
#define REP_P0 1
#endif
#ifndef REP_QKV
#define REP_QKV 1
#endif
#ifndef REP_ATT0
#define REP_ATT0 1
#endif
#ifndef REP_ATT1
#define REP_ATT1 1
#endif
#ifndef REP_WO0
#define REP_WO0 1
#endif
#ifndef REP_UP
#define REP_UP 1
#endif
#ifndef REP_DOWN
#define REP_DOWN 1
#endif
#ifndef REP_NORM1
#define REP_NORM1 1
#endif
#ifndef REP_ROUTE
#define REP_ROUTE 1
#endif
#ifndef REP_BAR
#define REP_BAR 1
#endif
#ifndef DBG_EN
#define DBG_EN 0x1FFu
#endif
#define EN(j) ((DBG_EN >> (j)) & 1u)
#define IN(k) (lo <= (k) && (k) < hi)
#define SEAM(k) do { if (IN(k) && IN((k) + 1)) { xcd_barrier(bar); if (REP_BAR > 1) xcd_barrier(bar); } } while (0)
template <int l>
__device__ __forceinline__ void run_layer(Frame& F, const Ptrs& P, const XcdBarrier& bar, const int lo, const int hi) {
    unsigned char* ws = P.ws;
    float* mod = (float*)(ws + WS_MOD); const float* misc = (const float*)(ws + WS_MISC);
    bf16 *H = (bf16*)(ws + WS_H), *Qb = (bf16*)(ws + WS_Q), *Kb = (bf16*)(ws + WS_K), *Vb = (bf16*)(ws + WS_V), *Y = (bf16*)(ws + WS_Y), *HE = (bf16*)(ws + WS_HE);
    const int gw = F.vcu * NWAVES + F.wave, NGW = F.G * NWAVES;
    {
        const int pb = 2 + 7 * l;
        const float* mod_l = mod + l * 2 * 6 * D;
        const float* xin = (l == 0) ? P.x : P.out;
#define QKV_BODY { g8::DenseOrder S; S.init(T, 3 * D, F.G, (int)blockIdx.x); \
            g8::EpiQKV E{Qb, (size_t)(WS_K - WS_Q) / 2, l == 0 ? P.a_q_gain : P.b_q_gain, l == 0 ? P.a_k_gain : P.b_k_gain}; \
            g8::gemm_phase(F.lds, H, (const bf16*)(ws + (l == 0 ? WS_WQKV_A : WS_WQKV_B)), D, S, E); }
        if (EN(2) && IN(pb + 0)) {
            QKV_BODY
            if (REP_QKV > 1) QKV_BODY
        } SEAM(pb + 0);
        if (EN(3) && IN(pb + 1)) for (int rep = 0; rep < (l == 0 ? REP_ATT0 : REP_ATT1); ++rep) {
            if (l == 0) {
                const float lam = misc[0];
                if (F.G == 256) { const int bh = F.vcu >> 4, s = F.vcu & 15;
                    for (int i = 0; i < 4; ++i) { const int qb = (i == 0) ? s : (i == 1) ? 31 - s : (i == 2) ? 32 + s : 63 - s; att::attn_unit<0>(bh >> 3, bh & 7, qb, Qb, Kb, Vb, H, F.lds, misc + MISC_TABA, lam, P.a_subln_g); } }
                else for (int u = (int)blockIdx.x; u < 1024; u += F.G) att::attn_unit<0>(u >> 9, (u >> 6) & 7, u & 63, Qb, Kb, Vb, H, F.lds, misc + MISC_TABA, lam, P.a_subln_g);
            } else {
                if (F.G == 256) { const int bh = F.vcu >> 3;
                    for (int i = 0; i < 4; ++i) att::attn_unit<1>(bh >> 4, bh & 15, (F.vcu & 7) * 4 + i, Qb, Kb, Vb, H, F.lds, misc + MISC_TABB, 0.f, nullptr); }
                else for (int u = (int)blockIdx.x; u < 1024; u += F.G) att::attn_unit<1>(u >> 9, (u >> 5) & 15, u & 31, Qb, Kb, Vb, H, F.lds, misc + MISC_TABB, 0.f, nullptr);
            }
        } SEAM(pb + 1);
#define WO_BODY { g8::DenseOrder S; S.init(T, D, F.G, (int)blockIdx.x); \
            g8::EpiWo E{xin, mod_l + 2 * D, P.out}; \
            g8::gemm_phase(F.lds, H, (const bf16*)(ws + (l == 0 ? WS_WO_A : WS_WO_B)), D, S, E); }
        if (EN(4) && IN(pb + 2)) {
            WO_BODY
            if (l == 0 && REP_WO0 > 1) WO_BODY
        } SEAM(pb + 2);
        unsigned* cnt = (unsigned*)(F.ctl + CW_CNT + l * 16 * 64); unsigned* ltok = (unsigned*)(ws + WS_LTOK) + (size_t)l * NE * T; float* lw = (float*)(ws + WS_LW) + (size_t)l * NE * T;
        if (EN(5) && IN(pb + 3)) {
            route_phase(F, P.out, P.norm_ffn_g + l * D, mod_l, H, P.router_w, P.router_bias, cnt, ltok, lw);
            if (REP_ROUTE > 1) route_phase(F, P.out, P.norm_ffn_g + l * D, mod_l, H, P.router_w, P.router_bias, (unsigned*)(F.ctl + CW_CNT + 2 * 16 * 64), (unsigned*)(ws + WS_HE), (float*)(ws + WS_HE + 2 * MiB));
        } SEAM(pb + 3);
        if (EN(6) && IN(pb + 4)) for (int rep = 0; rep < REP_UP; ++rep) {
            moe_prep(F, cnt);
            g8::MoeOrder<true> S{(const LAS unsigned*)(F.lds + TAB_OFF), ltok, F.G, (int)blockIdx.x};
            g8::EpiUp E{HE};
            g8::gemm_phase(F.lds, H, (const bf16*)(ws + WS_WGU) + (size_t)l * NE * 1024 * D, D, S, E);
        } SEAM(pb + 4);
        if (EN(7) && IN(pb + 5)) for (int rep = 0; rep < REP_DOWN; ++rep) {
            moe_prep(F, cnt);
            g8::MoeOrder<false> S{(const LAS unsigned*)(F.lds + TAB_OFF), ltok, F.G, (int)blockIdx.x};
            g8::EpiDown E{ltok, lw, Y};
            g8::gemm_phase(F.lds, HE, (const bf16*)(ws + WS_WD) + (size_t)l * NE * D * FF, FF, S, E);
        } SEAM(pb + 5);
        if (EN(8) && IN(pb + 6)) {
            const bool dn = (l + 1 < DEPTH);
            for (int row = gw; row < T / 2; row += NGW) {
                const int b = row / (SEQ / 2), r0 = b * SEQ + (row % (SEQ / 2));
                combine_rows<2>(r0, SEQ / 2, P.out, Y, mod_l + b * 6 * D + 5 * D, dn, P.norm_mix_g + (dn ? (l + 1) : 0) * D, mod + ((dn ? (l + 1) : 0) * 2 + b) * 6 * D, H, F.lane); }
        } SEAM(pb + 6);
    }
}
__global__ void __launch_bounds__(NWAVES * 64, 2) mk_fwd(Args args) {
    extern __shared__ __attribute__((aligned(16))) unsigned char lds[];
    Frame F;
    F.lds = (LAS unsigned char*)lds; F.MISC = (volatile LAS unsigned*)(F.lds + MISC_OFF);
    F.tid = threadIdx.x; F.lane = F.tid & 63; F.wave = __builtin_amdgcn_readfirstlane(F.tid >> 6);
    F.G = gridDim.x; { const int bx = blockIdx.x; F.vcu = (F.G % 8 == 0) ? (bx % 8) * (F.G / 8) + bx / 8 : bx; }
    const Ptrs& P = args.P;
    unsigned char* ws = P.ws;
    F.ctl = (gu32*)(ws + WS_CTL);
    for (int u = F.tid; u < (LDS_BYTES - LDSCTL_OFF) / 4; u += NWAVES * 64) ((LAS unsigned*)(F.lds + LDSCTL_OFF))[u] = 0u;
    __syncthreads();
    const int lo = args.ph_lo, hi = args.ph_hi;
    const bool multi = (hi - lo) > 1;
    XcdBarrier bar; bar.bar = (unsigned*)(F.ctl + CW_BAR); bar.x = 0; bar.st = nullptr;
    if (multi) bar = xcd_barrier_post((unsigned*)(F.ctl + CW_BAR), F.MISC + 8);
    float* mod = (float*)(ws + WS_MOD); const float* misc = (const float*)(ws + WS_MISC);
    bf16 *H = (bf16*)(ws + WS_H), *Qb = (bf16*)(ws + WS_Q), *Kb = (bf16*)(ws + WS_K), *Vb = (bf16*)(ws + WS_V), *Y = (bf16*)(ws + WS_Y), *HE = (bf16*)(ws + WS_HE);
    const int gw = F.vcu * NWAVES + F.wave, NGW = F.G * NWAVES;

    if (EN(0) && IN(0)) { for (int rep = 0; rep < REP_P0; ++rep) p0_prologue(F, P); } SEAM(0);
    if (EN(1) && IN(1)) for (int rep = 0; rep < REP_NORM1; ++rep) { for (int row = gw; row < T; row += NGW) norm_row(P.x + (size_t)row * D, P.norm_mix_g, mod + (row / SEQ) * 6 * D, 0, D, H + (size_t)row * D, F.lane); } SEAM(1);

    run_layer<0>(F, P, bar, lo, hi);
    run_layer<1>(F, P, bar, lo, hi);
#undef IN
#undef SEAM
}
#ifndef FASTMASK
#define FASTMASK 0xFFFFu
#endif
#ifndef ONE_LAUNCH
#define ONE_LAUNCH 1
#endif
extern "C" void kernel_launch(void* const* d_in, const int* in_sizes, int n_in, void* d_out, int out_size, void* d_ws, size_t ws_size, hipStream_t stream) {
    static int grid = 0;
    if (grid == 0) {
        if (n_in != 23 || out_size != T * D || ws_size < WS_END) { fprintf(stderr, "kernel_launch: unexpected shapes (n_in %d out %d ws %zu)\n", n_in, out_size, ws_size); grid = -1; return; }
        int dev = 0, cus = 0, per_cu = 0;
        if (hipGetDevice(&dev) != hipSuccess || hipDeviceGetAttribute(&cus, hipDeviceAttributeMultiprocessorCount, dev) != hipSuccess) { grid = -1; return; }
        if (hipFuncSetAttribute((const void*)mk_fwd, hipFuncAttributeMaxDynamicSharedMemorySize, LDS_BYTES) != hipSuccess) { fprintf(stderr, "kernel_launch: hipFuncSetAttribute failed\n"); grid = -1; return; }
        if (hipOccupancyMaxActiveBlocksPerMultiprocessor(&per_cu, (const void*)mk_fwd, NWAVES * 64, LDS_BYTES) != hipSuccess || per_cu < 1) fprintf(stderr, "kernel_launch: occupancy query reports %d\n", per_cu);
        (void)hipGetLastError();
        grid = cus;
    }
    if (grid < 0) return;
    Args a{};
    const float** pp = (const float**)&a.P;
    for (int i = 0; i < 23; ++i) pp[i] = (const float*)d_in[i];
    a.P.out = (float*)d_out; a.P.ws = (unsigned char*)d_ws;
    const Ptrs& P = a.P;
    unsigned char* ws = P.ws;
    (void)hipMemsetAsync(ws + WS_CTL, 0, CTL_ZERO_BYTES, stream);
#if ONE_LAUNCH
    a.ph_lo = 0; a.ph_hi = 16;
    hipLaunchKernelGGL(mk_fwd, dim3(grid), dim3(NWAVES * 64), LDS_BYTES, stream, a);
#else
    float* mod = (float*)(ws + WS_MOD); float* misc = (float*)(ws + WS_MISC);
    bf16 *H = (bf16*)(ws + WS_H), *Q = (bf16*)(ws + WS_Q), *Kb = (bf16*)(ws + WS_K), *V = (bf16*)(ws + WS_V), *Y = (bf16*)(ws + WS_Y), *HE = (bf16*)(ws + WS_HE);
    unsigned* ctl = (unsigned*)(ws + WS_CTL);
#define FAST(p) ((FASTMASK >> (p)) & 1u)
#define RUNFAST(p) do { a.ph_lo = (p); a.ph_hi = (p) + 1; hipLaunchKernelGGL(mk_fwd, dim3(grid), dim3(NWAVES * 64), LDS_BYTES, stream, a); } while (0)
    if (FASTMASK != 0u) RUNFAST(0);
    if (!FAST(0)) k_adaln<<<(DEPTH * 6 * D + 255) / 256, 256, 0, stream>>>(P);
    if (FAST(1)) RUNFAST(1); else k_norm<<<T, 256, 0, stream>>>(P.x, P.norm_mix_g, mod, 0, D, H);
    for (int l = 0; l < DEPTH; ++l) {
        const int pb = 2 + 7 * l;
        const float* mod_l = mod + l * 2 * 6 * D;
        const float* xin = (l == 0) ? P.x : P.out;
        if (FAST(pb + 0)) RUNFAST(pb + 0); else { ProbQKV pq{H, l == 0 ? P.a_w_qkv : P.b_w_qkv, l == 0 ? P.a_q_gain : P.b_q_gain, l == 0 ? P.a_k_gain : P.b_k_gain, Q, Kb, V, D, 0, 0}; k_slow_gemm<ProbQKV><<<(T / 64) * 48, 256, 0, stream>>>(pq); }
        if (FAST(pb + 1)) RUNFAST(pb + 1); else { if (l == 0) k_slow_attnA<<<BATCH * 8 * (SEQ / 32), 64, 0, stream>>>(Q, Kb, V, P.t5_bias, misc, P.a_subln_g, H); else k_slow_attnB<<<BATCH * 16 * (SEQ / 64), 64, 0, stream>>>(Q, Kb, V, P.b_rel_bias, H); }
        if (FAST(pb + 2)) RUNFAST(pb + 2); else { ProbWo pw{H, l == 0 ? P.a_w_o : P.b_w_o, xin, mod_l + 2 * D, P.out, D, 0, 0}; k_slow_gemm<ProbWo><<<(T / 64) * 16, 256, 0, stream>>>(pw); }
        unsigned* cnt = ctl + CW_CNT + l * 16 * 64; unsigned* ltok = (unsigned*)(ws + WS_LTOK) + (size_t)l * NE * T; float* lw = (float*)(ws + WS_LW) + (size_t)l * NE * T;
        if (FAST(pb + 3)) RUNFAST(pb + 3); else k_norm_route<<<T / 4, 256, 0, stream>>>(P.out, P.norm_ffn_g + l * D, mod_l, 3 * D, 4 * D, H, P.router_w, P.router_bias, cnt, ltok, lw);
        if (FAST(pb + 4)) RUNFAST(pb + 4); else { ProbUp pu{H, P.moe_w_gate + (size_t)l * NE * D * FF, P.moe_w_up + (size_t)l * NE * D * FF, cnt, ltok, HE, D, 0, 0, 0, 0, 0}; k_slow_gemm<ProbUp><<<NE * 256 * 8, 256, 0, stream>>>(pu); }
        if (FAST(pb + 5)) RUNFAST(pb + 5); else { ProbDown pd{HE, P.moe_w_down + (size_t)l * NE * FF * D, cnt, ltok, lw, Y, FF, 0, 0, 0, 0, 0}; k_slow_gemm<ProbDown><<<NE * 256 * 16, 256, 0, stream>>>(pd); }
        const int nl = l + 1;
        if (FAST(pb + 6)) RUNFAST(pb + 6); else k_combine<<<T, 256, 0, stream>>>(P.out, Y, mod_l + 5 * D, nl < DEPTH ? 1 : 0, P.norm_mix_g + (nl < DEPTH ? nl : 0) * D, mod + (nl < DEPTH ? nl : 0) * 2 * 6 * D, 0, D, H);
    }
#endif
}
```

```cpp
#define FASTMASK 0xFFFFu
#define ONE_LAUNCH 1
#include <hip/hip_runtime.h>
#include <cstdio>
#include <cstdint>

constexpr int BATCH = 2, SEQ = 8192, D = 1024, T = BATCH * SEQ, DEPTH = 2;
constexpr int NE = 16, FF = 512;
constexpr float NORM_EPS = 1e-6f;
constexpr float LOG2E = 1.4426950408889634f;

typedef unsigned short bf16;
__device__ __forceinline__ unsigned f2bf(float f) { unsigned u = __builtin_bit_cast(unsigned, f); return (u + 0x7fffu + ((u >> 16) & 1u)) >> 16; }
__device__ __forceinline__ float bf2f(unsigned h) { return __builtin_bit_cast(float, (h & 0xffffu) << 16); }

constexpr size_t MiB = 1u << 20;
constexpr size_t WS_CTL = 0, CTL_ZERO_BYTES = 1 * MiB;
constexpr size_t WS_MOD = 1 * MiB;
constexpr size_t WS_MISC = WS_MOD + 128 * 1024;
constexpr size_t WS_LTOK = 2 * MiB;
constexpr size_t WS_LW = 4 * MiB;
constexpr size_t WS_WQKV_A = 8 * MiB, WS_WO_A = 14 * MiB, WS_WQKV_B = 16 * MiB, WS_WO_B = 22 * MiB;
constexpr size_t WS_WGU = 24 * MiB, WS_WD = 88 * MiB;
constexpr size_t WS_H = 120 * MiB;
constexpr size_t WS_Q = 152 * MiB, WS_K = 184 * MiB, WS_V = 216 * MiB;
constexpr size_t WS_Y = 152 * MiB;
constexpr size_t WS_HE = 216 * MiB;
constexpr size_t WS_XB = 252 * MiB;
constexpr size_t WS_END = 284 * MiB;
constexpr int HE_ROWS = 36864;
constexpr int CW_CNT = 1024;

struct Ptrs {
    const float *x, *c, *ada_w, *ada_b, *norm_mix_g, *norm_ffn_g, *t5_bias, *a_w_qkv, *a_q_gain, *a_k_gain, *a_lambda, *a_subln_g, *a_w_o,
        *b_w_qkv, *b_q_gain, *b_k_gain, *b_rel_bias, *b_w_o, *router_w, *router_bias, *moe_w_gate, *moe_w_up, *moe_w_down;
    float* out; unsigned char* ws;
};

__global__ void __launch_bounds__(256) k_adaln(Ptrs P) {
    __shared__ float sc[2][D];
    for (int i = threadIdx.x; i < 2 * D; i += 256) { const float v = P.c[i]; sc[i / D][i % D] = v / (1.f + __expf(-v)); }
    __syncthreads();
    const int idx = blockIdx.x * 256 + threadIdx.x;
    if (idx >= DEPTH * 6 * D) return;
    const int l = idx / (6 * D), n = idx % (6 * D);
    float a0 = 0.f, a1 = 0.f;
    for (int k = 0; k < D; ++k) { const float w = P.ada_w[((size_t)l * D + k) * (6 * D) + n]; a0 += sc[0][k] * w; a1 += sc[1][k] * w; }
    float* mod = (float*)(P.ws + WS_MOD);
    const float bb = P.ada_b[l * 6 * D + n];
    mod[(l * 2 + 0) * 6 * D + n] = a0 + bb; mod[(l * 2 + 1) * 6 * D + n] = a1 + bb;
    if (idx == 0) {
        float s01 = 0.f, s23 = 0.f;
        for (int d = 0; d < 64; ++d) { s01 += P.a_lambda[d] * P.a_lambda[64 + d]; s23 += P.a_lambda[128 + d] * P.a_lambda[192 + d]; }
        ((float*)(P.ws + WS_MISC))[0] = __expf(s01) - __expf(s23) + 0.2f;
    }
}

__device__ __forceinline__ float block_sum_256(float v, float* red) {
    for (int o = 32; o > 0; o >>= 1) v += __shfl_xor(v, o);
    __syncthreads();
    if ((threadIdx.x & 63) == 0) red[threadIdx.x >> 6] = v;
    __syncthreads();
    return red[0] + red[1] + red[2] + red[3];
}

__global__ void __launch_bounds__(256) k_norm(const float* xin, const float* g, const float* mod_l, int sh_off, int sc_off, bf16* h) {
    __shared__ float red[4];
    const int row = blockIdx.x, b = row / SEQ, t = threadIdx.x;
    const float4 v = ((const float4*)(xin + (size_t)row * D))[t];
    const float ss = block_sum_256(v.x * v.x + v.y * v.y + v.z * v.z + v.w * v.w, red);
    const float inv = rsqrtf(ss * (1.f / D) + NORM_EPS);
    const float* mb = mod_l + b * 6 * D;
    const float4 gg = ((const float4*)g)[t], sc = ((const float4*)(mb + sc_off))[t], sh = ((const float4*)(mb + sh_off))[t];
    const float o0 = v.x * inv * gg.x * (1.f + sc.x) + sh.x, o1 = v.y * inv * gg.y * (1.f + sc.y) + sh.y, o2 = v.z * inv * gg.z * (1.f + sc.z) + sh.z, o3 = v.w * inv * gg.w * (1.f + sc.w) + sh.w;
    uint2 w; w.x = f2bf(o0) | (f2bf(o1) << 16); w.y = f2bf(o2) | (f2bf(o3) << 16);
    ((uint2*)(h + (size_t)row * D))[t] = w;
}

template <class Prob> __global__ void __launch_bounds__(256) k_slow_gemm(Prob pb) {
    __shared__ float As[16][68], Bs[16][68];
    __shared__ float Cs[Prob::NPASS][64][65];
    if (!pb.setup(blockIdx.x)) return;
    const int tid = threadIdx.x, ty = tid >> 4, tx = tid & 15;
    for (int pass = 0; pass < Prob::NPASS; ++pass) {
        float acc[4][4];
#pragma unroll
        for (int i = 0; i < 4; ++i)
#pragma unroll
            for (int j = 0; j < 4; ++j) acc[i][j] = 0.f;
        for (int k0 = 0; k0 < pb.K; k0 += 16) {
            __syncthreads();
#pragma unroll
            for (int i = 0; i < 4; ++i) { const int e = tid + 256 * i; { const int r = e >> 4, k = e & 15; As[k][r] = pb.A(r, k0 + k); } { const int k = e >> 6, c = e & 63; Bs[k][c] = pb.B(pass, k0 + k, c); } }
            __syncthreads();
#pragma unroll
            for (int k = 0; k < 16; ++k) {
                float a[4], b[4];
#pragma unroll
                for (int i = 0; i < 4; ++i) { a[i] = As[k][ty * 4 + i]; b[i] = Bs[k][tx * 4 + i]; }
#pragma unroll
                for (int i = 0; i < 4; ++i)
#pragma unroll
                    for (int j = 0; j < 4; ++j) acc[i][j] += a[i] * b[j];
            }
        }
#pragma unroll
        for (int i = 0; i < 4; ++i)
#pragma unroll
            for (int j = 0; j < 4; ++j) Cs[pass][ty * 4 + i][tx * 4 + j] = acc[i][j];
    }
    __syncthreads();
    pb.epi(Cs, tid);
}

struct ProbQKV {
    static constexpr int NPASS = 1;
    const bf16* H; const float* W; const float* qg; const float* kg; bf16 *Q, *Kb, *V; int K;
    int m0, n0;
    __device__ bool setup(int bx) { m0 = (bx / 48) * 64; n0 = (bx % 48) * 64; return true; }
    __device__ float A(int r, int k) const { return bf2f(H[(size_t)(m0 + r) * D + k]); }
    __device__ float B(int, int k, int c) const { return W[(size_t)k * (3 * D) + n0 + c]; }
    __device__ void epi(float (*Cs)[64][65], int tid) const {
        const int r = tid >> 2, part = tid & 3;
        const int region = n0 / D, col0 = n0 % D;
        float ss = 0.f;
        for (int c = 0; c < 16; ++c) { const float v = Cs[0][r][part * 16 + c]; ss += v * v; }
        ss += __shfl_xor(ss, 1); ss += __shfl_xor(ss, 2);
        const float inv = rsqrtf(ss * (1.f / 64.f) + NORM_EPS);
        bf16* dst = (region == 0 ? Q : region == 1 ? Kb : V) + (size_t)(m0 + r) * D + col0;
        for (int c = 0; c < 16; ++c) { const int cc = part * 16 + c; float v = Cs[0][r][cc];
            if (region == 0) v = v * inv * qg[cc] * (0.125f * LOG2E); else if (region == 1) v = v * inv * kg[cc];
            dst[cc] = (bf16)f2bf(v); }
    }
};

struct ProbWo {
    static constexpr int NPASS = 1;
    const bf16* O; const float* W; const float* xres; const float* gate; float* out; int K;
    int m0, n0;
    __device__ bool setup(int bx) { m0 = (bx / 16) * 64; n0 = (bx % 16) * 64; return true; }
    __device__ float A(int r, int k) const { return bf2f(O[(size_t)(m0 + r) * D + k]); }
    __device__ float B(int, int k, int c) const { return W[(size_t)k * D + n0 + c]; }
    __device__ void epi(float (*Cs)[64][65], int tid) const {
        const int r = tid >> 2, part = tid & 3, row = m0 + r, b = row / SEQ;
        for (int c = 0; c < 16; ++c) { const int col = n0 + part * 16 + c; out[(size_t)row * D + col] = xres[(size_t)row * D + col] + gate[b * 6 * D + col] * Cs[0][r][part * 16 + c]; }
    }
};

__device__ __forceinline__ void expert_bases(const unsigned* cnt  , int e, int& cnt_e, int& base_e) {
    int base = 0, ce = 0;
    for (int i = 0; i < NE; ++i) { const int c = (int)cnt[i * 64]; if (i < e) base += (c + 255) & ~255; if (i == e) ce = c; }
    cnt_e = ce; base_e = base;
}

struct ProbUp {
    static constexpr int NPASS = 2;
    const bf16* H2; const float *Wg, *Wu; const unsigned* cnt; const unsigned* ltok; bf16* he; int K;
    int e, r0, n0, cnt_e, base_e;
    __device__ bool setup(int bx) { n0 = (bx % 8) * 64; const int rt = (bx / 8) % 256; e = bx / (8 * 256); r0 = rt * 64; expert_bases(cnt, e, cnt_e, base_e); return r0 < cnt_e; }
    __device__ float A(int r, int k) const { const int rr = r0 + r; if (rr >= cnt_e) return 0.f; const unsigned tok = ltok[(size_t)e * T + rr] & 0x7fffffffu; return bf2f(H2[(size_t)tok * D + k]); }
    __device__ float B(int pass, int k, int c) const { return (pass == 0 ? Wg : Wu)[((size_t)e * D + k) * FF + n0 + c]; }
    __device__ void epi(float (*Cs)[64][65], int tid) const {
        const int r = tid >> 2, part = tid & 3; if (r0 + r >= cnt_e) return;
        bf16* dst = he + (size_t)(base_e + r0 + r) * FF + n0;
        for (int c = 0; c < 16; ++c) { const int cc = part * 16 + c; const float g = Cs[0][r][cc], u = Cs[1][r][cc]; dst[cc] = (bf16)f2bf(g / (1.f + __expf(-g)) * u); }
    }
};
struct ProbDown {
    static constexpr int NPASS = 1;
    const bf16* he; const float* Wd; const unsigned* cnt; const unsigned* ltok; const float* lw; bf16* ybuf; int K;
    int e, r0, n0, cnt_e, base_e;
    __device__ bool setup(int bx) { n0 = (bx % 16) * 64; const int rt = (bx / 16) % 256; e = bx / (16 * 256); r0 = rt * 64; expert_bases(cnt, e, cnt_e, base_e); return r0 < cnt_e; }
    __device__ float A(int r, int k) const { const int rr = r0 + r; if (rr >= cnt_e) return 0.f; return bf2f(he[(size_t)(base_e + rr) * FF + k]); }
    __device__ float B(int, int k, int c) const { return Wd[((size_t)e * FF + k) * D + n0 + c]; }
    __device__ void epi(float (*Cs)[64][65], int tid) const {
        const int r = tid >> 2, part = tid & 3; if (r0 + r >= cnt_e) return;
        const unsigned tk = ltok[(size_t)e * T + r0 + r]; const float w = lw[(size_t)e * T + r0 + r];
        bf16* dst = ybuf + ((size_t)(tk >> 31) * T + (tk & 0x7fffffffu)) * D + n0;
        for (int c = 0; c < 16; ++c) { const int cc = part * 16 + c; dst[cc] = (bf16)f2bf(w * Cs[0][r][cc]); }
    }
};

__global__ void __launch_bounds__(256) k_norm_route(const float* xin, const float* g, const float* mod_l, int sh_off, int sc_off, bf16* h, const float* rw, const float* rb,
                                                    unsigned* cnt, unsigned* ltok, float* lw) {
    const int lane = threadIdx.x & 63, row = blockIdx.x * 4 + (threadIdx.x >> 6), b = row / SEQ;
    const float* mb = mod_l + b * 6 * D;
    float hv[16]; float ss = 0.f;
#pragma unroll
    for (int j = 0; j < 4; ++j) { const float4 v = ((const float4*)(xin + (size_t)row * D))[lane + 64 * j]; hv[4 * j] = v.x; hv[4 * j + 1] = v.y; hv[4 * j + 2] = v.z; hv[4 * j + 3] = v.w; ss += v.x * v.x + v.y * v.y + v.z * v.z + v.w * v.w; }
    for (int o = 32; o > 0; o >>= 1) ss += __shfl_xor(ss, o);
    const float inv = rsqrtf(ss * (1.f / D) + NORM_EPS);
    float lg[16];
#pragma unroll
    for (int e = 0; e < 16; ++e) lg[e] = 0.f;
#pragma unroll
    for (int j = 0; j < 4; ++j) {
        const int c0 = (lane + 64 * j) * 4;
        const float4 gg = *(const float4*)(g + c0), sc = *(const float4*)(mb + sc_off + c0), sh = *(const float4*)(mb + sh_off + c0);
        hv[4 * j] = hv[4 * j] * inv * gg.x * (1.f + sc.x) + sh.x; hv[4 * j + 1] = hv[4 * j + 1] * inv * gg.y * (1.f + sc.y) + sh.y;
        hv[4 * j + 2] = hv[4 * j + 2] * inv * gg.z * (1.f + sc.z) + sh.z; hv[4 * j + 3] = hv[4 * j + 3] * inv * gg.w * (1.f + sc.w) + sh.w;
        uint2 w; w.x = f2bf(hv[4 * j]) | (f2bf(hv[4 * j + 1]) << 16); w.y = f2bf(hv[4 * j + 2]) | (f2bf(hv[4 * j + 3]) << 16);
        *(uint2*)(h + (size_t)row * D + c0) = w;
#pragma unroll
        for (int i = 0; i < 4; ++i) { const float4* wr = (const float4*)(rw + (size_t)(c0 + i) * NE); const float x = hv[4 * j + i];
#pragma unroll
            for (int q = 0; q < 4; ++q) { const float4 w4 = wr[q]; lg[4 * q] += x * w4.x; lg[4 * q + 1] += x * w4.y; lg[4 * q + 2] += x * w4.z; lg[4 * q + 3] += x * w4.w; } }
    }
#pragma unroll
    for (int e = 0; e < 16; ++e) for (int o = 32; o > 0; o >>= 1) lg[e] += __shfl_xor(lg[e], o);
    if (lane == 0) {
        float sc[16], sel[16];
#pragma unroll
        for (int e = 0; e < 16; ++e) { sc[e] = 1.f / (1.f + __expf(-lg[e])); sel[e] = sc[e] + rb[e]; }
        int bg = 0; float bgs = -3e38f;
#pragma unroll
        for (int gi = 0; gi < 4; ++gi) {
            float m1 = -3e38f, m2 = -3e38f;
#pragma unroll
            for (int i = 0; i < 4; ++i) { const float v = sel[gi * 4 + i]; if (v > m1) { m2 = m1; m1 = v; } else if (v > m2) m2 = v; }
            const float gs = m1 + m2; if (gs > bgs) { bgs = gs; bg = gi; }
        }
        int e0 = 0, e1 = 0; float s0 = -3e38f, s1 = -3e38f, w0 = 0.f, w1 = 0.f;
#pragma unroll
        for (int gi = 0; gi < 4; ++gi) if (gi == bg) {
#pragma unroll
            for (int i = 0; i < 4; ++i) { const int e = gi * 4 + i; const float v = sel[e];
                if (v > s0) { s1 = s0; e1 = e0; w1 = w0; s0 = v; e0 = e; w0 = sc[e]; } else if (v > s1) { s1 = v; e1 = e; w1 = sc[e]; } }
        }
        const float ws = w0 + w1; w0 /= ws; w1 /= ws;
        const unsigned p0 = atomicAdd(&cnt[e0 * 64], 1u), p1 = atomicAdd(&cnt[e1 * 64], 1u);
        ltok[(size_t)e0 * T + p0] = (unsigned)row; lw[(size_t)e0 * T + p0] = w0;
        ltok[(size_t)e1 * T + p1] = (unsigned)row | 0x80000000u; lw[(size_t)e1 * T + p1] = w1;
    }
}

__global__ void __launch_bounds__(256) k_combine(float* xio, const bf16* ybuf, const float* gate  , int do_norm, const float* g, const float* modn, int sh_off, int sc_off, bf16* h) {
    __shared__ float red[4];
    const int row = blockIdx.x, b = row / SEQ, t = threadIdx.x;
    float4 v = ((const float4*)(xio + (size_t)row * D))[t];
    const uint2 y0 = ((const uint2*)(ybuf + (size_t)row * D))[t], y1 = ((const uint2*)(ybuf + ((size_t)T + row) * D))[t];
    const float4 gt = ((const float4*)(gate + b * 6 * D))[t];
    v.x += gt.x * (bf2f(y0.x) + bf2f(y1.x)); v.y += gt.y * (bf2f(y0.x >> 16) + bf2f(y1.x >> 16)); v.z += gt.z * (bf2f(y0.y) + bf2f(y1.y)); v.w += gt.w * (bf2f(y0.y >> 16) + bf2f(y1.y >> 16));
    ((float4*)(xio + (size_t)row * D))[t] = v;
    if (do_norm) {
        const float ss = block_sum_256(v.x * v.x + v.y * v.y + v.z * v.z + v.w * v.w, red);
        const float inv = rsqrtf(ss * (1.f / D) + NORM_EPS);
        const float* mb = modn + b * 6 * D;
        const float4 gg = ((const float4*)g)[t], sc = ((const float4*)(mb + sc_off))[t], sh = ((const float4*)(mb + sh_off))[t];
        const float o0 = v.x * inv * gg.x * (1.f + sc.x) + sh.x, o1 = v.y * inv * gg.y * (1.f + sc.y) + sh.y, o2 = v.z * inv * gg.z * (1.f + sc.z) + sh.z, o3 = v.w * inv * gg.w * (1.f + sc.w) + sh.w;
        uint2 w; w.x = f2bf(o0) | (f2bf(o1) << 16); w.y = f2bf(o2) | (f2bf(o3) << 16);
        ((uint2*)(h + (size_t)row * D))[t] = w;
    }
}

__device__ __forceinline__ int t5_bucket_ref(int rel) {
    const int ret = rel > 0 ? 16 : 0; const int n = rel < 0 ? -rel : rel;
    const float nf = (float)(n < 1 ? 1 : n);
    int large = 8 + (int)(logf(nf / 8.f) / logf(128.f) * 8.f); if (large > 15) large = 15;
    return ret + (n < 8 ? n : large);
}
__device__ __forceinline__ void slow_map(const bf16* Qrow, const bf16* Kcol, const bf16* Vcol, const float* t5h, int qpos, int kend, float (&o)[64]) {
    float q[64];
#pragma unroll
    for (int d = 0; d < 64; ++d) { q[d] = bf2f(Qrow[d]); o[d] = 0.f; }
    float m = -3e38f, l = 0.f;
    for (int j = 0; j < kend; ++j) {
        const uint4* kr = (const uint4*)(Kcol + (size_t)j * D);
        float s = 0.f;
#pragma unroll
        for (int c = 0; c < 8; ++c) { const uint4 kk = kr[c];
            s += q[8 * c] * bf2f(kk.x) + q[8 * c + 1] * bf2f(kk.x >> 16) + q[8 * c + 2] * bf2f(kk.y) + q[8 * c + 3] * bf2f(kk.y >> 16)
               + q[8 * c + 4] * bf2f(kk.z) + q[8 * c + 5] * bf2f(kk.z >> 16) + q[8 * c + 6] * bf2f(kk.w) + q[8 * c + 7] * bf2f(kk.w >> 16); }
        s += t5h[t5_bucket_ref(j - qpos) * 8] * LOG2E;
        const float mn = fmaxf(m, s), a = exp2f(m - mn), p = exp2f(s - mn);
        l = l * a + p; m = mn;
        const uint4* vr = (const uint4*)(Vcol + (size_t)j * D);
#pragma unroll
        for (int c = 0; c < 8; ++c) { const uint4 vv = vr[c];
            o[8 * c] = o[8 * c] * a + p * bf2f(vv.x); o[8 * c + 1] = o[8 * c + 1] * a + p * bf2f(vv.x >> 16); o[8 * c + 2] = o[8 * c + 2] * a + p * bf2f(vv.y); o[8 * c + 3] = o[8 * c + 3] * a + p * bf2f(vv.y >> 16);
            o[8 * c + 4] = o[8 * c + 4] * a + p * bf2f(vv.z); o[8 * c + 5] = o[8 * c + 5] * a + p * bf2f(vv.z >> 16); o[8 * c + 6] = o[8 * c + 6] * a + p * bf2f(vv.w); o[8 * c + 7] = o[8 * c + 7] * a + p * bf2f(vv.w >> 16); }
    }
    const float il = 1.f / l;
#pragma unroll
    for (int d = 0; d < 64; ++d) o[d] *= il;
}
__global__ void __launch_bounds__(64) k_slow_attnA(const bf16* Q, const bf16* Kb, const bf16* Vb, const float* t5, const float* misc, const float* subg, bf16* O) {
    const int blk = blockIdx.x, qt = blk % (SEQ / 32), h = (blk / (SEQ / 32)) % 8, b = blk / (SEQ / 32 * 8);
    const int lane = threadIdx.x, ql = lane >> 1, vh = lane & 1, qpos = qt * 32 + ql; const size_t row = (size_t)b * SEQ + qpos;
    const int kend = (qpos / 64 + 1) * 64;
    float o0[64], o1[64];
    slow_map(Q + row * D + (2 * h) * 64, Kb + (size_t)b * SEQ * D + (2 * h) * 64, Vb + (size_t)b * SEQ * D + h * 128 + vh * 64, t5 + h, qpos, kend, o0);
    slow_map(Q + row * D + (2 * h + 1) * 64, Kb + (size_t)b * SEQ * D + (2 * h + 1) * 64, Vb + (size_t)b * SEQ * D + h * 128 + vh * 64, t5 + h, qpos, kend, o1);
    const float lam = misc[0]; float ss = 0.f;
#pragma unroll
    for (int d = 0; d < 64; ++d) { o0[d] -= lam * o1[d]; ss += o0[d] * o0[d]; }
    ss += __shfl_xor(ss, 1);
    const float inv = rsqrtf(ss * (1.f / 128.f) + NORM_EPS) * 0.8f;
    bf16* dst = O + row * D + h * 128 + vh * 64;
#pragma unroll
    for (int d = 0; d < 64; d += 2) *(unsigned*)(dst + d) = f2bf(o0[d] * inv * subg[vh * 64 + d]) | (f2bf(o0[d + 1] * inv * subg[vh * 64 + d + 1]) << 16);
}
__global__ void __launch_bounds__(64) k_slow_attnB(const bf16* Q, const bf16* Kb, const bf16* Vb, const float* relb, bf16* O) {
    const int blk = blockIdx.x, ci = blk % (SEQ / 64), h = (blk / (SEQ / 64)) % 16, b = blk / (SEQ / 64 * 16);
    const int qpos = ci * 64 + threadIdx.x; const size_t row = (size_t)b * SEQ + qpos;
    const int k0 = ci >= 8 ? (ci - 8) * 64 : 0, kend = (ci + 1) * 64;
    float q[64], o[64];
#pragma unroll
    for (int d = 0; d < 64; ++d) { q[d] = bf2f(Q[row * D + h * 64 + d]); o[d] = 0.f; }
    float m = -3e38f, l = 0.f;
    const bf16* Kc = Kb + (size_t)b * SEQ * D + h * 64; const bf16* Vc = Vb + (size_t)b * SEQ * D + h * 64;
    for (int j = k0; j < kend; ++j) {
        const uint4* kr = (const uint4*)(Kc + (size_t)j * D);
        float s = 0.f;
#pragma unroll
        for (int c = 0; c < 8; ++c) { const uint4 kk = kr[c];
            s += q[8 * c] * bf2f(kk.x) + q[8 * c + 1] * bf2f(kk.x >> 16) + q[8 * c + 2] * bf2f(kk.y) + q[8 * c + 3] * bf2f(kk.y >> 16)
               + q[8 * c + 4] * bf2f(kk.z) + q[8 * c + 5] * bf2f(kk.z >> 16) + q[8 * c + 6] * bf2f(kk.w) + q[8 * c + 7] * bf2f(kk.w >> 16); }
        int rel = j - qpos; rel = rel < -256 ? -256 : (rel > 256 ? 256 : rel);
        s += relb[h * 513 + rel + 256] * LOG2E;
        const float mn = fmaxf(m, s), a = exp2f(m - mn), p = exp2f(s - mn);
        l = l * a + p; m = mn;
        const uint4* vr = (const uint4*)(Vc + (size_t)j * D);
#pragma unroll
        for (int c = 0; c < 8; ++c) { const uint4 vv = vr[c];
            o[8 * c] = o[8 * c] * a + p * bf2f(vv.x); o[8 * c + 1] = o[8 * c + 1] * a + p * bf2f(vv.x >> 16); o[8 * c + 2] = o[8 * c + 2] * a + p * bf2f(vv.y); o[8 * c + 3] = o[8 * c + 3] * a + p * bf2f(vv.y >> 16);
            o[8 * c + 4] = o[8 * c + 4] * a + p * bf2f(vv.z); o[8 * c + 5] = o[8 * c + 5] * a + p * bf2f(vv.z >> 16); o[8 * c + 6] = o[8 * c + 6] * a + p * bf2f(vv.w); o[8 * c + 7] = o[8 * c + 7] * a + p * bf2f(vv.w >> 16); }
    }
    const float il = 1.f / l;
    bf16* dst = O + row * D + h * 64;
#pragma unroll
    for (int d = 0; d < 64; d += 2) *(unsigned*)(dst + d) = f2bf(o[d] * il) | (f2bf(o[d + 1] * il) << 16);
}

#define GAS __attribute__((address_space(1)))
#define LAS __attribute__((address_space(3)))
typedef unsigned v4u __attribute__((ext_vector_type(4)));
typedef unsigned v2u __attribute__((ext_vector_type(2)));
typedef float f32x4 __attribute__((ext_vector_type(4)));
typedef float f32x16 __attribute__((ext_vector_type(16)));
typedef short bf16x8 __attribute__((ext_vector_type(8)));
typedef short s16x4 __attribute__((ext_vector_type(4)));
typedef GAS unsigned gu32;
#define RLX_AGENT __ATOMIC_RELAXED, __HIP_MEMORY_SCOPE_AGENT
#define LDS_WAIT() asm volatile("s_waitcnt lgkmcnt(0)" ::: "memory")
#define VM_WAIT() asm volatile("s_waitcnt vmcnt(0)" ::: "memory")

constexpr int NWAVES = 8;
constexpr int RING_BYTES = 131072;
constexpr int LDSCTL_OFF = RING_BYTES, MISC_OFF = LDSCTL_OFF + 320;
constexpr int TAB_OFF = RING_BYTES + 1024;
constexpr int LDS_BYTES = 147456;
constexpr int CW_BAR = 4096;

__device__ __forceinline__ unsigned cvt_pk_bf16(float lo, float hi) { unsigned r; asm volatile("v_cvt_pk_bf16_f32 %0, %1, %2" : "=v"(r) : "v"(lo), "v"(hi)); return r; }
__device__ __forceinline__ float wave_sum(float v) {
#pragma unroll
    for (int o = 1; o < 64; o <<= 1) v += __shfl_xor(v, o);
    return v;
}

#define XB_TMO      128
#define XB_XCNT(j)  (256  + 64 * (j))
#define XB_XSUB(j)  (1280 + 64 * (j))
#define XB_XGEN(j)  (2304 + 64 * (j))
#define XB_TOP      3328
#define XB_TOPGEN   3392
#define XCD_BAR_WORDS 3456
#define XB_SPIN_CAP (1u << 18)
__device__ __forceinline__ unsigned xb_ld(unsigned* p)              { return __hip_atomic_load(p, __ATOMIC_RELAXED, __HIP_MEMORY_SCOPE_AGENT); }
__device__ __forceinline__ unsigned xb_add(unsigned* p, unsigned v) { return __hip_atomic_fetch_add(p, v, __ATOMIC_RELAXED, __HIP_MEMORY_SCOPE_AGENT); }
__device__ __forceinline__ unsigned xb_xcc_id() { return (unsigned)__builtin_amdgcn_s_getreg((3 << 11) | 20) & 0xFu; }
#define XB_SPIN(cond, bar) do { unsigned _sp = 0; while (cond) { __builtin_amdgcn_s_sleep(1); \
    if ((++_sp & 255u) == 0u) { if (xb_ld(&(bar)[XB_TMO])) break; if (_sp > XB_SPIN_CAP) { atomicAdd(&(bar)[XB_TMO], 1u); break; } } } } while (0)
struct XcdBarrier { unsigned* bar; unsigned x; volatile LAS unsigned* st; };
__device__ __forceinline__ XcdBarrier xcd_barrier_post(unsigned* bar, volatile LAS unsigned* st) {
    XcdBarrier b; b.bar = bar; b.x = xb_xcc_id(); b.st = st;
    if (threadIdx.x == 0) (void)xb_add(&bar[XB_XCNT(b.x)], 1u);
    return b;
}
__device__ __forceinline__ void xcd_barrier_complete(unsigned* bar, unsigned x, unsigned& nloc, unsigned& nx) {
    const unsigned G = gridDim.x * gridDim.y * gridDim.z;
    unsigned sum, cnt, mine, sp = 0u;
    for (;;) {
        sum = 0u; cnt = 0u; mine = 0u;
#pragma unroll
        for (unsigned j = 0; j < 16; ++j) { const unsigned c = xb_ld(&bar[XB_XCNT(j)]); sum += c; cnt += (c > 0u) ? 1u : 0u; mine = (j == x) ? c : mine; }
        if (sum == G) break;
        __builtin_amdgcn_s_sleep(1);
        if ((++sp & 255u) == 0u) { if (xb_ld(&bar[XB_TMO])) break; if (sp > XB_SPIN_CAP) { atomicAdd(&bar[XB_TMO], 1u); break; } }
    }
    nloc = mine > 0u ? mine : 1u; nx = cnt > 0u ? cnt : 1u;
}
__device__ __forceinline__ void xcd_barrier(const XcdBarrier& b) {
    asm volatile("s_waitcnt vmcnt(0)" ::: "memory");
    __syncthreads();
    if (threadIdx.x == 0) {
        unsigned* bar = b.bar;
        __builtin_amdgcn_s_waitcnt(0);
        unsigned nloc = b.st[0], nx = b.st[1];
        if (nloc == 0u) { xcd_barrier_complete(bar, b.x, nloc, nx); b.st[0] = nloc; b.st[1] = nx; }
        const unsigned old = xb_add(&bar[XB_XSUB(b.x)], 1u);
        const unsigned gen = old / nloc;
        if (old + 1u == (gen + 1u) * nloc) {
            __builtin_amdgcn_fence(__ATOMIC_RELEASE, "agent");
            asm volatile("s_waitcnt vmcnt(0)" ::: "memory");
            const unsigned og = xb_add(&bar[XB_TOP], 1u);
            const unsigned tg = og / nx;
            if (og + 1u == (tg + 1u) * nx) xb_add(&bar[XB_TOPGEN], 1u);
            else XB_SPIN(xb_ld(&bar[XB_TOPGEN]) == tg, bar);
            __builtin_amdgcn_fence(__ATOMIC_ACQUIRE, "agent");
            xb_add(&bar[XB_XGEN(b.x)], 1u);
            asm volatile("s_waitcnt vmcnt(0)" ::: "memory");
        } else {
            XB_SPIN(xb_ld(&bar[XB_XGEN(b.x)]) == gen, bar);
            __builtin_amdgcn_fence(__ATOMIC_ACQUIRE, "agent");
            asm volatile("s_waitcnt vmcnt(0)" ::: "memory");
        }
    }
    __syncthreads();
}

namespace g8 {
constexpr int BM = 256, BK = 64, HALF = 128, HTB = HALF * BK * 2, STAGE_BYTES = 8 * HTB;
__host__ __device__ __forceinline__ int lds_byte(int r, int c) { const int st = (r >> 4) * 2 + (c >> 5), rr = r & 15, cc = c & 31, ob = rr * 64 + cc * 2; return st * 1024 + (ob ^ (((ob >> 9) & 1) << 5)); }
__host__ __device__ __forceinline__ void stage_rc(int b, int& R, int& C) { const int st = b / 1024, sb = b % 1024, swz = sb ^ (((sb >> 9) & 1) << 5); R = (st >> 1) * 16 + swz / 64; C = (st & 1) * 32 + (swz % 64) / 2; }
__host__ __device__ __forceinline__ int perm32(int rho) { const int n = rho >> 4, i = rho & 15; return 8 * (i >> 2) + 4 * n + (i & 3); }

struct Unit { int arow0, brow0, orow0, pn, lidx, nvalid; };

struct DenseOrder {
    int nM, nN, nwg, G, c;
    __device__ void init(int M, int N, int G_, int c_) { nM = M / BM; nN = N / BM; nwg = nM * nN; G = G_; c = c_; }
    __device__ __forceinline__ bool next(int i, Unit& u) const {
        const long L = (long)i * G + c; if (L >= nwg) return false;
        int wgid = (int)L; { const int q = nwg / 8, r = nwg % 8, xcd = wgid % 8, off = wgid / 8; wgid = (xcd < r ? xcd * (q + 1) : r * (q + 1) + (xcd - r) * q) + off; }
        const int nig = 8 * nN, gid = wgid / nig, fm = gid * 8, gsz = (nM - fm) < 8 ? (nM - fm) : 8;
        const int pm = fm + ((wgid % nig) % gsz), pn = (wgid % nig) / gsz;
        u.arow0 = pm * BM; u.orow0 = pm * BM; u.brow0 = pn * BM; u.pn = pn; u.lidx = 0; u.nvalid = BM; return true;
    }
    __device__ __forceinline__ void aoffs(const Unit& u, int K, unsigned (&o)[4]) const {
#pragma unroll
        for (int i = 0; i < 2; ++i) { int R, C; stage_rc((int)threadIdx.x * 16 + i * 8192, R, C);
#pragma unroll
            for (int h = 0; h < 2; ++h) o[h * 2 + i] = (unsigned)((u.arow0 + h * HALF + R) * K + C) * 2u; }
    }
};
template <bool GATHER> struct MoeOrder {
    const LAS unsigned* tab; const unsigned* ltok; int G, c;
    __device__ __forceinline__ bool next(int i, Unit& u) const {
        const int L = i * G + c; const int ntile = (int)__builtin_amdgcn_readfirstlane(tab[0]);
        if (L >= ntile * 4) return false;
        const int rt = L >> 2, pn = L & 3; const unsigned w = __builtin_amdgcn_readfirstlane(tab[1 + rt]); const int e = (int)(w & 255u), ti = (int)(w >> 8);
        const int base = (int)__builtin_amdgcn_readfirstlane(tab[160 + e]), cnt = (int)__builtin_amdgcn_readfirstlane(tab[176 + e]);
        u.lidx = e * T + ti * BM; u.orow0 = base + ti * BM; u.arow0 = base + ti * BM; u.brow0 = e * 1024 + pn * BM; u.pn = pn; u.nvalid = (cnt - ti * BM) < BM ? (cnt - ti * BM) : BM; return true;
    }
    __device__ __forceinline__ void aoffs(const Unit& u, int K, unsigned (&o)[4]) const {
#pragma unroll
        for (int i = 0; i < 2; ++i) { int R, C; stage_rc((int)threadIdx.x * 16 + i * 8192, R, C);
#pragma unroll
            for (int h = 0; h < 2; ++h) {
                int row;
                if (GATHER) { int r = h * HALF + R; if (r >= u.nvalid) r = 0; row = (int)(ltok[u.lidx + r] & 0x7fffffffu); }
                else row = u.arow0 + h * HALF + R;
                o[h * 2 + i] = (unsigned)(row * K + C) * 2u; } }
    }
};

struct EpiQKV {
    static constexpr bool PERM = true;
    bf16* Q; size_t stride; const float *qg, *kg;
    __device__ __forceinline__ void operator()(const f32x4 (&acc)[2][2][4][2], const Unit& u, int wr, int wc, int fr, int fq) const {
        const int region = u.pn >> 2, colt = (u.pn & 3) * BM;
        bf16* base = Q + (size_t)region * stride;
        const bool nrm = region < 2;
        const float* gp = (region == 0) ? qg : kg; const float gs = (region == 0) ? 0.125f * LOG2E : 1.f;
        f32x4 gv[2][2];
#pragma unroll
        for (int bj = 0; bj < 2; ++bj)
#pragma unroll
            for (int n = 0; n < 2; ++n) { gv[bj][n] = (f32x4){1.f, 1.f, 1.f, 1.f}; if (nrm) gv[bj][n] = *(const f32x4*)(gp + 32 * bj + 8 * fq + 4 * n) * gs; }
#pragma unroll
        for (int ai = 0; ai < 2; ++ai)
#pragma unroll
            for (int m = 0; m < 4; ++m) {
                const int row = u.orow0 + ai * HALF + wr * 64 + m * 16 + fr;
                float ss = 0.f;
#pragma unroll
                for (int bj = 0; bj < 2; ++bj)
#pragma unroll
                    for (int n = 0; n < 2; ++n) { const f32x4 x = acc[ai][bj][m][n]; ss += (x[0] * x[0] + x[1] * x[1]) + (x[2] * x[2] + x[3] * x[3]); }
                ss += __shfl_xor(ss, 16); ss += __shfl_xor(ss, 32);
                const float inv = nrm ? rsqrtf(ss * (1.f / 64.f) + NORM_EPS) : 1.f;
                bf16* rowp = base + (size_t)row * D + colt + 64 * wc + 8 * fq;
#pragma unroll
                for (int bj = 0; bj < 2; ++bj) { const f32x4 v0 = acc[ai][bj][m][0] * gv[bj][0] * inv, v1 = acc[ai][bj][m][1] * gv[bj][1] * inv;
                    v4u w; w.x = cvt_pk_bf16(v0[0], v0[1]); w.y = cvt_pk_bf16(v0[2], v0[3]); w.z = cvt_pk_bf16(v1[0], v1[1]); w.w = cvt_pk_bf16(v1[2], v1[3]);
                    *(v4u*)(rowp + 32 * bj) = w; }
            }
    }
};
template <bool XBF> struct EpiWo {
    static constexpr bool PERM = true;
    const float* xf; const float* gate; bf16* xb;
    __device__ __forceinline__ void operator()(const f32x4 (&acc)[2][2][4][2], const Unit& u, int wr, int wc, int fr, int fq) const {
        const int b = u.orow0 / SEQ; const int col0 = u.pn * BM + wc * 32 + 8 * fq;
        f32x4 gt[2][2];
#pragma unroll
        for (int bj = 0; bj < 2; ++bj)
#pragma unroll
            for (int n = 0; n < 2; ++n) gt[bj][n] = *(const f32x4*)(gate + b * 6 * D + col0 + bj * HALF + 4 * n);
#pragma unroll
        for (int ai = 0; ai < 2; ++ai)
#pragma unroll
            for (int m = 0; m < 4; ++m) { const size_t off = (size_t)(u.orow0 + ai * HALF + wr * 64 + m * 16 + fr) * D + col0;
#pragma unroll
                for (int bj = 0; bj < 2; ++bj) { f32x4 x0, x1;
                    if (XBF) { const v4u r = *(const v4u*)(xb + off + bj * HALF); x0 = (f32x4){bf2f(r.x), bf2f(r.x >> 16), bf2f(r.y), bf2f(r.y >> 16)}; x1 = (f32x4){bf2f(r.z), bf2f(r.z >> 16), bf2f(r.w), bf2f(r.w >> 16)}; }
                    else { x0 = *(const f32x4*)(xf + off + bj * HALF); x1 = *(const f32x4*)(xf + off + bj * HALF + 4); }
                    const f32x4 v0 = x0 + gt[bj][0] * acc[ai][bj][m][0], v1 = x1 + gt[bj][1] * acc[ai][bj][m][1];
                    v4u w; w.x = cvt_pk_bf16(v0[0], v0[1]); w.y = cvt_pk_bf16(v0[2], v0[3]); w.z = cvt_pk_bf16(v1[0], v1[1]); w.w = cvt_pk_bf16(v1[2], v1[3]);
                    *(v4u*)(xb + off + bj * HALF) = w; }
                if (m & 1) asm volatile("" ::: "memory"); }
    }
};
struct EpiUp {
    static constexpr bool PERM = true;
    bf16* he;
    __device__ __forceinline__ void operator()(const f32x4 (&acc)[2][2][4][2], const Unit& u, int wr, int wc, int fr, int fq) const {
#pragma unroll
        for (int ai = 0; ai < 2; ++ai)
#pragma unroll
            for (int m = 0; m < 4; ++m) { const int row = u.orow0 + ai * HALF + wr * 64 + m * 16 + fr;
                f32x4 v[2];
#pragma unroll
                for (int n = 0; n < 2; ++n)
#pragma unroll
                    for (int i = 0; i < 4; ++i) { const float g = acc[ai][0][m][n][i], up = acc[ai][1][m][n][i]; v[n][i] = g * __builtin_amdgcn_rcpf(1.f + __builtin_amdgcn_exp2f(-g * LOG2E)) * up; }
                v4u w; w.x = cvt_pk_bf16(v[0][0], v[0][1]); w.y = cvt_pk_bf16(v[0][2], v[0][3]); w.z = cvt_pk_bf16(v[1][0], v[1][1]); w.w = cvt_pk_bf16(v[1][2], v[1][3]);
                *(v4u*)(he + (size_t)row * FF + u.pn * HALF + 32 * wc + 8 * fq) = w; }
    }
};
struct EpiDown {
    static constexpr bool PERM = true;
    const unsigned* ltok; const float* lw; bf16* ybuf;
    __device__ __forceinline__ void operator()(const f32x4 (&acc)[2][2][4][2], const Unit& u, int wr, int wc, int fr, int fq) const {
#pragma unroll
        for (int ai = 0; ai < 2; ++ai)
#pragma unroll
            for (int m = 0; m < 4; ++m) { const int r = ai * HALF + wr * 64 + m * 16 + fr;
                if (r < u.nvalid) { const unsigned tk = ltok[u.lidx + r]; const float w = lw[u.lidx + r];
                    bf16* dst = ybuf + ((size_t)(tk >> 31) * T + (tk & 0x7fffffffu)) * D + u.pn * BM + 32 * wc + 8 * fq;
#pragma unroll
                    for (int bj = 0; bj < 2; ++bj) { const f32x4 v0 = acc[ai][bj][m][0] * w, v1 = acc[ai][bj][m][1] * w;
                        v4u o; o.x = cvt_pk_bf16(v0[0], v0[1]); o.y = cvt_pk_bf16(v0[2], v0[3]); o.z = cvt_pk_bf16(v1[0], v1[1]); o.w = cvt_pk_bf16(v1[2], v1[3]);
                        *(v4u*)(dst + bj * HALF) = o; } } }
    }
};

template <class Epi, class Sched>
__device__ __forceinline__ void gemm_phase(LAS unsigned char* lds, const bf16* A, const bf16* Bt, const int K, const Sched& S, const Epi& E) {
    const int tid = threadIdx.x, wid = __builtin_amdgcn_readfirstlane(tid >> 6), lane = tid & 63, wr = wid >> 2, wc = wid & 3, fr = lane & 15, fq = lane >> 4;
    const int nt = K / BK;
    unsigned voffB[2];
#pragma unroll
    for (int i = 0; i < 2; ++i) { int R, C; stage_rc(tid * 16 + i * 8192, R, C); const int Rb = Epi::PERM ? ((R & ~31) + perm32(R & 31)) : R; voffB[i] = (unsigned)(Rb * K + C) * 2u; }
    const size_t kstep = (size_t)(BK * 2);
    const size_t hstep = (size_t)HALF * K * 2;
    const unsigned ldsw = (unsigned)wid * 1024u;
    const int aoff = lds_byte(wr * 64 + fr, fq * 8), boff = lds_byte(wc * 32 + fr, fq * 8);
#define G8_SA(b, h) (((b) * 2 + (h)) * HTB)
#define G8_SB(b, h) ((4 + (b) * 2 + (h)) * HTB)
#define G8_STAGE_B(bufoff, gbase) do { _Pragma("unroll") for (int _i = 0; _i < 2; ++_i) \
        __builtin_amdgcn_global_load_lds((const unsigned*)((const char*)(gbase) + voffB[_i]), (LAS unsigned*)(lds + (bufoff) + ldsw + _i * 8192), 16, 0, 0); } while (0)
#define G8_STAGE_A(bufoff, kt, offs, h) do { _Pragma("unroll") for (int _i = 0; _i < 2; ++_i) \
        __builtin_amdgcn_global_load_lds((const unsigned*)((const char*)A + (size_t)(kt) * kstep + (offs)[(h) * 2 + _i]), (LAS unsigned*)(lds + (bufoff) + ldsw + _i * 8192), 16, 0, 0); } while (0)
#define G8_LDA(dst, b, h) do { _Pragma("unroll") for (int m = 0; m < 4; ++m) _Pragma("unroll") for (int k = 0; k < 2; ++k) dst[m][k] = *(const LAS bf16x8*)(lds + G8_SA(b, h) + aoff + m * 2048 + k * 1024); } while (0)
#define G8_LDB(dst, b, h) do { _Pragma("unroll") for (int n = 0; n < 2; ++n) _Pragma("unroll") for (int k = 0; k < 2; ++k) dst[n][k] = *(const LAS bf16x8*)(lds + G8_SB(b, h) + boff + n * 2048 + k * 1024); } while (0)
#define G8_MMA(ai, bj, At, Bt_) do { __builtin_amdgcn_s_setprio(1); _Pragma("unroll") for (int m = 0; m < 4; ++m) _Pragma("unroll") for (int n = 0; n < 2; ++n) _Pragma("unroll") for (int k = 0; k < 2; ++k) \
        acc[ai][bj][m][n] = __builtin_amdgcn_mfma_f32_16x16x32_bf16(Bt_[n][k], At[m][k], acc[ai][bj][m][n], 0, 0, 0); __builtin_amdgcn_s_setprio(0); } while (0)
#define G8_WAIT_V(n) asm volatile("s_waitcnt vmcnt(" #n ")" ::: "memory")
#define G8_WAIT_L(n) asm volatile("s_waitcnt lgkmcnt(" #n ")" ::: "memory")
#define G8_BAR __builtin_amdgcn_s_barrier()
#define G8_SCHED __builtin_amdgcn_sched_barrier(0)
    Unit cur, nxt; int ui = 0;
    if (!S.next(0, cur)) return;
    f32x4 acc[2][2][4][2];
#pragma unroll
    for (int a = 0; a < 2; ++a)
#pragma unroll
        for (int b = 0; b < 2; ++b)
#pragma unroll
            for (int m = 0; m < 4; ++m)
#pragma unroll
                for (int n = 0; n < 2; ++n) acc[a][b][m][n] = (f32x4){0.f, 0.f, 0.f, 0.f};
    bf16x8 At[4][2], B0[2][2], B1[2][2];
    unsigned offc[4], offn[4];
    S.aoffs(cur, K, offc);
    const char* cB = (const char*)Bt + (size_t)cur.brow0 * K * 2;
    G8_STAGE_B(G8_SB(0, 0), cB); G8_STAGE_B(G8_SB(0, 1), cB + hstep); G8_STAGE_A(G8_SA(0, 0), 0, offc, 0); G8_STAGE_A(G8_SA(0, 1), 0, offc, 1);
    if (wr == 1) G8_BAR;
    G8_WAIT_V(2); G8_BAR;
    G8_STAGE_B(G8_SB(1, 0), cB + kstep); G8_STAGE_A(G8_SA(1, 0), 1, offc, 0); G8_STAGE_B(G8_SB(1, 1), cB + hstep + kstep);
    G8_WAIT_V(6); G8_BAR;
    for (;;) {
        const bool has_next = S.next(ui + 1, nxt);
        if (has_next) S.aoffs(nxt, K, offn); else {
#pragma unroll
            for (int j = 0; j < 4; ++j) offn[j] = offc[j]; }
        const char* nB = has_next ? (const char*)Bt + (size_t)nxt.brow0 * K * 2 : cB;
        for (int t = 0; t < nt; t += 2) {
            const bool last = (t == nt - 2);
            const int kt2 = last ? 0 : t + 2;
            unsigned o2[4];
#pragma unroll
            for (int j = 0; j < 4; ++j) o2[j] = last ? offn[j] : offc[j];
            const char* b2 = last ? nB : cB + (size_t)(t + 2) * kstep; const char* b3 = b2 + kstep;
            G8_LDB(B0, 0, 0); G8_LDB(B1, 0, 1); G8_SCHED; G8_LDA(At, 0, 0); G8_STAGE_A(G8_SA(1, 1), t + 1, offc, 1);
            G8_WAIT_V(8); G8_WAIT_L(0); G8_BAR; G8_MMA(0, 0, At, B0); G8_MMA(0, 1, At, B1); G8_BAR; G8_SCHED;
            G8_LDA(At, 0, 1); G8_STAGE_B(G8_SB(0, 0), b2); G8_STAGE_B(G8_SB(0, 1), b2 + hstep); G8_STAGE_A(G8_SA(0, 0), kt2, o2, 0);
            G8_WAIT_V(8); G8_WAIT_L(0); G8_BAR; G8_MMA(1, 0, At, B0); G8_MMA(1, 1, At, B1); G8_BAR; G8_SCHED;
            G8_LDB(B0, 1, 0); G8_LDB(B1, 1, 1); G8_SCHED; G8_LDA(At, 1, 0); G8_STAGE_A(G8_SA(0, 1), kt2, o2, 1);
            G8_WAIT_V(8); G8_WAIT_L(0); G8_BAR; G8_MMA(0, 0, At, B0); G8_MMA(0, 1, At, B1); G8_BAR; G8_SCHED;
            G8_LDA(At, 1, 1); G8_STAGE_B(G8_SB(1, 0), b3); G8_STAGE_B(G8_SB(1, 1), b3 + hstep); G8_STAGE_A(G8_SA(1, 0), kt2 + 1, o2, 0);
            G8_WAIT_V(8); G8_WAIT_L(0); G8_BAR; G8_MMA(1, 0, At, B0); G8_MMA(1, 1, At, B1); G8_BAR; G8_SCHED;
        }
        if (wr == 0) G8_BAR;
        E(acc, cur, wr, wc, fr, fq);
        if (!has_next) break;
#pragma unroll
        for (int a = 0; a < 2; ++a)
#pragma unroll
            for (int b = 0; b < 2; ++b)
#pragma unroll
                for (int m = 0; m < 4; ++m)
#pragma unroll
                    for (int n = 0; n < 2; ++n) acc[a][b][m][n] = (f32x4){0.f, 0.f, 0.f, 0.f};
        cur = nxt; cB = nB; ++ui;
#pragma unroll
        for (int j = 0; j < 4; ++j) offc[j] = offn[j];
        if (wr == 1) G8_BAR;
    }
    G8_WAIT_V(0);
    G8_BAR;
#undef G8_SA
#undef G8_SB
#undef G8_STAGE_A
#undef G8_STAGE_B
#undef G8_LDA
#undef G8_LDB
#undef G8_MMA
#undef G8_WAIT_V
#undef G8_WAIT_L
#undef G8_BAR
#undef G8_SCHED
}
}
namespace att {
__device__ __forceinline__ int crow(int r, int hi) { return (r & 3) + 8 * (r >> 2) + 4 * hi; }
__device__ __forceinline__ void glds16(const void* gsrc, unsigned lds_dst) { unsigned keep;
    asm volatile("s_mov_b32 %0, m0\n\ts_mov_b32 m0, %2\n\ts_nop 0\n\tglobal_load_lds_dwordx4 %1, off\n\ts_mov_b32 m0, %0" : "=&s"(keep) : "v"(gsrc), "s"(lds_dst) : "memory"); }
__device__ __forceinline__ void glds16s(const void* sbase, unsigned voff, unsigned lds_dst) { unsigned keep;
    asm volatile("s_mov_b32 %0, m0\n\ts_mov_b32 m0, %3\n\ts_nop 0\n\tglobal_load_lds_dwordx4 %1, %2\n\ts_mov_b32 m0, %0" : "=&s"(keep) : "v"(voff), "s"(sbase), "s"(lds_dst) : "memory"); }
typedef LAS const char* lds_cptr;
typedef short v4i16_t __attribute__((ext_vector_type(4)));
__device__ __forceinline__ s16x4 vtr(lds_cptr p) { return __builtin_bit_cast(s16x4, __builtin_amdgcn_ds_read_tr16_b64_v4i16((LAS v4i16_t*)p)); }
__device__ __forceinline__ float swap_add(float v) { auto rr = __builtin_amdgcn_permlane32_swap(__float_as_uint(v), __float_as_uint(v), false, false); return __uint_as_float(rr[0]) + __uint_as_float(rr[1]); }
#define ATT_WAIT_BAR(N) asm volatile("s_waitcnt vmcnt(" #N ") lgkmcnt(0)\n\ts_barrier" ::: "memory")

template <int MIX>
__device__ __forceinline__ void attn_unit(int b, int h, int blk, const bf16* Q, const bf16* __restrict__ K, const bf16* __restrict__ V, bf16* O, LAS unsigned char* lds, const float* tabg, float lam, const float* subg) {
    constexpr int KC = MIX == 0 ? 128 : 64, DV = KC, NDB = DV / 32, SLOT = KC * 128, NP = MIX == 0 ? 2 : 1;
    constexpr int TABN = MIX == 0 ? 768 : 416, OFFS = MIX == 0 ? 704 : 352, FARREL = MIX == 0 ? -559 : -256;
    constexpr int LDS_K = 0, LDS_V = 3 * SLOT, LDS_T = 6 * SLOT;
    const int tid = threadIdx.x, lane = tid & 63, r32 = lane & 31, hi = lane >> 5; const int wid = __builtin_amdgcn_readfirstlane(tid >> 6);
    int map, rb, R0, T_lo, T_hi, ci, w_lo;
    if (MIX == 0) { map = wid >> 2; rb = wid & 3; R0 = blk * 128; ci = 2 * blk + (rb >> 1); T_lo = 0; T_hi = 2 * blk + 1; w_lo = 0; }
    else { map = 0; rb = wid; R0 = blk * 256; ci = 4 * blk + (rb >> 1); T_lo = 4 * blk - 8 > 0 ? 4 * blk - 8 : 0; T_hi = 4 * blk + 3; w_lo = ci - 8 > 0 ? ci - 8 : 0; }
    const int w_hi = ci, qrow0 = R0 + 32 * rb;
    const size_t rowbase = (size_t)b * SEQ;
    const int hcol = h * KC, qcol = hcol + map * 64;
    const unsigned lds0 = (unsigned)(uintptr_t)lds;
    LAS float* tab = (LAS float*)(lds + LDS_T);
    for (int i = tid; i < TABN; i += NWAVES * 64) tab[i] = tabg[h * TABN + i];
    bf16x8 qr[4];
#pragma unroll
    for (int d0 = 0; d0 < 4; ++d0) qr[d0] = *(const bf16x8*)(Q + (rowbase + qrow0 + r32) * D + qcol + d0 * 16 + hi * 8);
    asm volatile("s_waitcnt vmcnt(0)" ::: "memory");
#pragma unroll
    for (int d0 = 0; d0 < 4; ++d0) asm volatile("" : "+v"(qr[d0]));
    unsigned koff[NP], voff[NP], kdst[NP], vdst[NP];
#pragma unroll
    for (int j = 0; j < NP; ++j) { const int p = wid + 8 * j;
        koff[j] = (unsigned)((lane * D + p * 8) * 2); kdst[j] = lds0 + LDS_K + p * 1024;
        voff[j] = (unsigned)(((16 * (p & 3) + (lane >> 2)) * D + 32 * (p >> 2) + 8 * (lane & 3)) * 2); vdst[j] = lds0 + LDS_V + p * 1024; }
    const bf16* Kbase = K + rowbase * D + hcol; const bf16* Vbase = V + rowbase * D + hcol;
#define ATT_ISSUE(t, slot) do { const bf16* kb_ = Kbase + (size_t)(t) * 64 * D; const bf16* vb_ = Vbase + (size_t)(t) * 64 * D; _Pragma("unroll") for (int j_ = 0; j_ < NP; ++j_) { \
        glds16s(kb_, koff[j_], (unsigned)__builtin_amdgcn_readfirstlane(kdst[j_] + (slot))); \
        glds16s(vb_, voff[j_], (unsigned)__builtin_amdgcn_readfirstlane(vdst[j_] + (slot))); } } while (0)
    const lds_cptr kp0 = (lds_cptr)lds + LDS_K + (map * 8 + hi) * 1024 + r32 * 16;
    const lds_cptr vp0 = (lds_cptr)lds + LDS_V + ((lane >> 4) & 1) * 32 + (lane & 3) * 8 + (4 * hi + ((lane & 15) >> 2)) * 64;
    f32x16 o[NDB];
#pragma unroll
    for (int i = 0; i < NDB; ++i) o[i] = f32x16{};
    float lsum = 0.f;
    int t_first = T_lo;
    if constexpr (MIX == 0) {
        int NF = R0 >= 622 ? ((R0 - 622) / 64 + 1) & ~1 : 0;
        if (NF >= 4) {
#define SB_() __builtin_amdgcn_sched_barrier(0)
#define PIN_(x) asm volatile("" : "+v"(x))
#define MF_(a, b, c) __builtin_amdgcn_mfma_f32_32x32x16_bf16(a, b, c, 0, 0, 0)
#define DMA_K_(t, slot) do { const bf16* kb_ = Kbase + (size_t)(t) * 64 * D; _Pragma("unroll") for (int j_ = 0; j_ < NP; ++j_) glds16s(kb_, koff[j_], (unsigned)__builtin_amdgcn_readfirstlane(kdst[j_] + (slot))); } while (0)
#define DMA_V_(t, slot) do { const bf16* vb_ = Vbase + (size_t)(t) * 64 * D; _Pragma("unroll") for (int j_ = 0; j_ < NP; ++j_) glds16s(vb_, voff[j_], (unsigned)__builtin_amdgcn_readfirstlane(vdst[j_] + (slot))); } while (0)
#define KLD2_(kp, j) do { kf[2 * (j)] = *(const LAS bf16x8*)((kp) + (j) * 2048); kf[2 * (j) + 1] = *(const LAS bf16x8*)((kp) + (j) * 2048 + 512); } while (0)
            const f32x16 zero16 = f32x16{};
            bf16x8 kf[8]; f32x16 pA0, pA1, pB0, pB1; s16x4 vlo[4], vhi[4]; v4u pw0, pw1, pw2, pw3;
            int sl_prev = 0, sl_cur = 0, sl_next = SLOT;
#define ROT_() do { sl_prev = sl_cur; sl_cur = sl_next; sl_next = (sl_next == 2 * SLOT) ? 0 : sl_next + SLOT; } while (0)
            DMA_K_(0, 0); DMA_V_(0, 0); DMA_K_(1, SLOT); DMA_K_(2, 2 * SLOT);
            ATT_WAIT_BAR(6);
            { const lds_cptr kp = kp0;
#pragma unroll
              for (int d0 = 0; d0 < 4; ++d0) { const bf16x8 k0 = *(const LAS bf16x8*)(kp + d0 * 2048), k1 = *(const LAS bf16x8*)(kp + d0 * 2048 + 512);
                  if (d0 == 0) { pA0 = MF_(k0, qr[0], zero16); pA1 = MF_(k1, qr[0], zero16); } else { pA0 = MF_(k0, qr[d0], pA0); pA1 = MF_(k1, qr[d0], pA1); } }
#pragma unroll
              for (int r = 0; r < 16; ++r) { pA0[r] = __builtin_amdgcn_exp2f(pA0[r]); pA1[r] = __builtin_amdgcn_exp2f(pA1[r]); } }
            ATT_WAIT_BAR(0);
            DMA_K_(3, 0); DMA_V_(1, SLOT);
            ROT_();
#pragma unroll
            for (int j = 0; j < 4; ++j) KLD2_(kp0 + sl_cur, j);
            ATT_WAIT_BAR(4);
#define PKW_(P, B) cvt_pk_bf16(P[B], P[(B) + 1])
#define PAF_(k) __builtin_bit_cast(bf16x8, pw##k)
#define VRD_(f) do { vlo[(f) & 3] = vtr(vp_ + (((f) >> 2) * 4096 + ((f) & 3) * 1024)); vhi[(f) & 3] = vtr(vp_ + (((f) >> 2) * 4096 + ((f) & 3) * 1024 + 512)); } while (0)
#define VFR_(f) (bf16x8){vlo[(f) & 3][0], vlo[(f) & 3][1], vlo[(f) & 3][2], vlo[(f) & 3][3], vhi[(f) & 3][0], vhi[(f) & 3][1], vhi[(f) & 3][2], vhi[(f) & 3][3]}
#define GAPA_(CX, MFX, A0, A1, A2, A3, W0, W1, PW) do { MFX; PIN_(CX); sacc += A0; sacc += A1; sacc += A2; sacc += A3; PIN_(sacc); W0; W1; PIN_(PW); SB_(); } while (0)
#define GAPB_(f, X, B, PK) do { o[(f) >> 2] = MF_(VFR_(f), PAF_(PK), o[(f) >> 2]); X[B] = __builtin_amdgcn_exp2f(X[B]); X[(B) + 1] = __builtin_amdgcn_exp2f(X[(B) + 1]); PIN_(X); if ((f) + 4 < 16) VRD_((f) + 4); SB_(); } while (0)
#define KRD_(G, j) do { if (G) { KLD2_(kp0 + sl_next, j); SB_(); } } while (0)
#define STEP_(C0, C1, P0, P1, t, GK, GV, GL) do { SB_(); \
            const lds_cptr vp_ = vp0 + sl_prev; \
            float sacc = (P0[0] + P0[1]); \
            GAPA_(C0, C0 = MF_(kf[0], qr[0], zero16), P0[2], P0[3], P0[4], P0[5],     pw0[0] = PKW_(P0, 0), pw0[1] = PKW_(P0, 2), pw0); \
            GAPA_(C1, C1 = MF_(kf[1], qr[0], zero16), P0[6], P0[7], P0[8], P0[9],     pw0[2] = PKW_(P0, 4), pw0[3] = PKW_(P0, 6), pw0); \
            GAPA_(C0, C0 = MF_(kf[2], qr[1], C0),   P0[10], P0[11], P0[12], P0[13], pw1[0] = PKW_(P0, 8), pw1[1] = PKW_(P0, 10), pw1); \
            GAPA_(C1, C1 = MF_(kf[3], qr[1], C1),   P0[14], P0[15], P1[0], P1[1],   pw1[2] = PKW_(P0, 12), pw1[3] = PKW_(P0, 14), pw1); \
            VRD_(0); SB_(); GAPA_(C0, C0 = MF_(kf[4], qr[2], C0),   P1[2], P1[3], P1[4], P1[5],     pw2[0] = PKW_(P1, 0), pw2[1] = PKW_(P1, 2), pw2); \
            VRD_(1); SB_(); GAPA_(C1, C1 = MF_(kf[5], qr[2], C1),   P1[6], P1[7], P1[8], P1[9],     pw2[2] = PKW_(P1, 4), pw2[3] = PKW_(P1, 6), pw2); \
            VRD_(2); SB_(); GAPA_(C0, C0 = MF_(kf[6], qr[3], C0),   P1[10], P1[11], P1[12], P1[13], pw3[0] = PKW_(P1, 8), pw3[1] = PKW_(P1, 10), pw3); \
            VRD_(3); SB_(); GAPA_(C1, C1 = MF_(kf[7], qr[3], C1),   P1[14], P1[15], 0.f, 0.f,       pw3[2] = PKW_(P1, 12), pw3[3] = PKW_(P1, 14), pw3); \
            PIN_(P0); PIN_(P1); lsum += sacc; \
            if (GK) { DMA_K_((t) + 3, sl_cur); } if (GV) { DMA_V_((t) + 1, sl_next); } \
            SB_(); \
            GAPB_(0, C0, 0, 0); GAPB_(1, C0, 2, 1); GAPB_(2, C0, 4, 2); \
            KRD_(GL, 0); GAPB_(3, C0, 6, 3); \
            KRD_(GL, 1); GAPB_(4, C0, 8, 0); \
            KRD_(GL, 2); GAPB_(5, C0, 10, 1); \
            KRD_(GL, 3); GAPB_(6, C0, 12, 2); GAPB_(7, C0, 14, 3); \
            GAPB_(8, C1, 0, 0); GAPB_(9, C1, 2, 1); GAPB_(10, C1, 4, 2); GAPB_(11, C1, 6, 3); \
            GAPB_(12, C1, 8, 0); GAPB_(13, C1, 10, 1); GAPB_(14, C1, 12, 2); GAPB_(15, C1, 14, 3); \
        } while (0)
#define ENDW_(tt) do { if ((tt) + 3 < NF) { ATT_WAIT_BAR(4); } else if ((tt) + 2 < NF) { ATT_WAIT_BAR(2); } else { ATT_WAIT_BAR(0); } } while (0)
            int t = 1;
            for (; t + 5 < NF; t += 2) {
                STEP_(pB0, pB1, pA0, pA1, t, true, true, true);       ATT_WAIT_BAR(4); ROT_();
                STEP_(pA0, pA1, pB0, pB1, t + 1, true, true, true);   ATT_WAIT_BAR(4); ROT_();
            }
            for (; t + 1 < NF; t += 2) {
                STEP_(pB0, pB1, pA0, pA1, t, (t + 3 < NF), (t + 1 < NF), (t + 1 < NF));         ENDW_(t);     ROT_();
                STEP_(pA0, pA1, pB0, pB1, t + 1, (t + 4 < NF), (t + 2 < NF), (t + 2 < NF));     ENDW_(t + 1); ROT_();
            }
            STEP_(pB0, pB1, pA0, pA1, NF - 1, false, false, false);
            { float sacc = pB0[0] + pB0[1];
#pragma unroll
              for (int r = 2; r < 16; ++r) sacc += pB0[r];
#pragma unroll
              for (int r = 0; r < 16; ++r) sacc += pB1[r];
              lsum += sacc;
              pw0 = (v4u){PKW_(pB0, 0), PKW_(pB0, 2), PKW_(pB0, 4), PKW_(pB0, 6)}; pw1 = (v4u){PKW_(pB0, 8), PKW_(pB0, 10), PKW_(pB0, 12), PKW_(pB0, 14)};
              pw2 = (v4u){PKW_(pB1, 0), PKW_(pB1, 2), PKW_(pB1, 4), PKW_(pB1, 6)}; pw3 = (v4u){PKW_(pB1, 8), PKW_(pB1, 10), PKW_(pB1, 12), PKW_(pB1, 14)};
              SB_();
              const lds_cptr vp = vp0 + sl_cur;
#pragma unroll
              for (int db = 0; db < NDB; ++db) {
                  { const s16x4 lo = vtr(vp + db * 4096), hh = vtr(vp + db * 4096 + 512); o[db] = MF_(((bf16x8){lo[0], lo[1], lo[2], lo[3], hh[0], hh[1], hh[2], hh[3]}), PAF_(0), o[db]); }
                  { const s16x4 lo = vtr(vp + db * 4096 + 1024), hh = vtr(vp + db * 4096 + 1024 + 512); o[db] = MF_(((bf16x8){lo[0], lo[1], lo[2], lo[3], hh[0], hh[1], hh[2], hh[3]}), PAF_(1), o[db]); }
                  { const s16x4 lo = vtr(vp + db * 4096 + 2048), hh = vtr(vp + db * 4096 + 2048 + 512); o[db] = MF_(((bf16x8){lo[0], lo[1], lo[2], lo[3], hh[0], hh[1], hh[2], hh[3]}), PAF_(2), o[db]); }
                  { const s16x4 lo = vtr(vp + db * 4096 + 3072), hh = vtr(vp + db * 4096 + 3072 + 512); o[db] = MF_(((bf16x8){lo[0], lo[1], lo[2], lo[3], hh[0], hh[1], hh[2], hh[3]}), PAF_(3), o[db]); } } }
            ATT_WAIT_BAR(0);
            t_first = NF;
#undef SB_
#undef PIN_
#undef MF_
#undef DMA_K_
#undef DMA_V_
#undef KLD2_
#undef ROT_
#undef PKW_
#undef PAF_
#undef VRD_
#undef VFR_
#undef GAPA_
#undef GAPB_
#undef KRD_
#undef STEP_
#undef ENDW_
        }
    }
    ATT_ISSUE(t_first, 0); if (t_first + 1 <= T_hi) ATT_ISSUE(t_first + 1, SLOT);
    int sl = 0;
    for (int t = t_first; t <= T_hi; ++t) {
        if (t < T_hi) { if (NP == 2) ATT_WAIT_BAR(4); else ATT_WAIT_BAR(2); } else ATT_WAIT_BAR(0);
        if (t + 2 <= T_hi) { const int s2 = sl >= SLOT ? sl - SLOT : sl + 2 * SLOT; ATT_ISSUE(t + 2, s2); }
        if (t >= w_lo && t <= w_hi) {
            f32x16 p0, p1;
            const int maxrel = 64 * t + 63 - qrow0;
            if (maxrel > FARREL) { const LAS float* tp = tab + (64 * t + 4 * hi - (qrow0 + r32) + OFFS);
#pragma unroll
                for (int r = 0; r < 16; ++r) { p0[r] = tp[(r & 3) + 8 * (r >> 2)]; p1[r] = tp[32 + (r & 3) + 8 * (r >> 2)]; } }
            else { p0 = f32x16{}; p1 = f32x16{}; }
            const lds_cptr kp = kp0 + sl;
#pragma unroll
            for (int d0 = 0; d0 < 4; ++d0) { const bf16x8 k0 = *(const LAS bf16x8*)(kp + d0 * 2048), k1 = *(const LAS bf16x8*)(kp + d0 * 2048 + 512);
                p0 = __builtin_amdgcn_mfma_f32_32x32x16_bf16(k0, qr[d0], p0, 0, 0, 0); p1 = __builtin_amdgcn_mfma_f32_32x32x16_bf16(k1, qr[d0], p1, 0, 0, 0); }
            float sa = 0.f, sb = 0.f;
#pragma unroll
            for (int r = 0; r < 16; ++r) { p0[r] = __builtin_amdgcn_exp2f(p0[r]); p1[r] = __builtin_amdgcn_exp2f(p1[r]); sa += p0[r]; sb += p1[r]; }
            lsum += sa + sb;
            v4u pw[4];
            pw[0] = (v4u){cvt_pk_bf16(p0[0], p0[1]), cvt_pk_bf16(p0[2], p0[3]), cvt_pk_bf16(p0[4], p0[5]), cvt_pk_bf16(p0[6], p0[7])};
            pw[1] = (v4u){cvt_pk_bf16(p0[8], p0[9]), cvt_pk_bf16(p0[10], p0[11]), cvt_pk_bf16(p0[12], p0[13]), cvt_pk_bf16(p0[14], p0[15])};
            pw[2] = (v4u){cvt_pk_bf16(p1[0], p1[1]), cvt_pk_bf16(p1[2], p1[3]), cvt_pk_bf16(p1[4], p1[5]), cvt_pk_bf16(p1[6], p1[7])};
            pw[3] = (v4u){cvt_pk_bf16(p1[8], p1[9]), cvt_pk_bf16(p1[10], p1[11]), cvt_pk_bf16(p1[12], p1[13]), cvt_pk_bf16(p1[14], p1[15])};
            const lds_cptr vp = vp0 + sl;
#pragma unroll
            for (int db = 0; db < NDB; ++db)
#pragma unroll
                for (int s = 0; s < 4; ++s) { const s16x4 lo = vtr(vp + db * 4096 + s * 1024), hh = vtr(vp + db * 4096 + s * 1024 + 512);
                    const bf16x8 vf = (bf16x8){lo[0], lo[1], lo[2], lo[3], hh[0], hh[1], hh[2], hh[3]};
                    o[db] = __builtin_amdgcn_mfma_f32_32x32x16_bf16(vf, __builtin_bit_cast(bf16x8, pw[s]), o[db], 0, 0, 0); }
        }
        sl = sl == 2 * SLOT ? 0 : sl + SLOT;
    }
    const float l = swap_add(lsum);
    const size_t orow = (rowbase + qrow0 + r32) * D;
    if (MIX == 0) {
        const float f = (map == 0 ? 1.f : -lam) / l;
        ATT_WAIT_BAR(0);
        LAS float* X = (LAS float*)lds + rb * 4096 + lane;
        if (map == 1) {
#pragma unroll
            for (int db = 0; db < NDB; ++db)
#pragma unroll
                for (int r = 0; r < 16; ++r) X[(db * 16 + r) * 64] = o[db][r] * f; }
        ATT_WAIT_BAR(0);
        if (map == 0) { float ss = 0.f;
#pragma unroll
            for (int db = 0; db < NDB; ++db)
#pragma unroll
                for (int r = 0; r < 16; ++r) { const float v = o[db][r] * f + X[(db * 16 + r) * 64]; o[db][r] = v; ss += v * v; }
            ss = swap_add(ss);
            const float inv = rsqrtf(ss * (1.f / 128.f) + NORM_EPS) * 0.8f;
#pragma unroll
            for (int db = 0; db < NDB; ++db)
#pragma unroll
                for (int g = 0; g < 4; ++g) { const int d = 32 * db + 8 * g + 4 * hi; const f32x4 sg = *(const f32x4*)(subg + d);
                    v2u w; w.x = cvt_pk_bf16(o[db][4 * g] * inv * sg[0], o[db][4 * g + 1] * inv * sg[1]); w.y = cvt_pk_bf16(o[db][4 * g + 2] * inv * sg[2], o[db][4 * g + 3] * inv * sg[3]);
                    *(v2u*)(O + orow + h * 128 + d) = w; } }
        ATT_WAIT_BAR(0);
    } else {
        const float f = 1.f / l;
#pragma unroll
        for (int db = 0; db < NDB; ++db)
#pragma unroll
            for (int g = 0; g < 4; ++g) { const int d = 32 * db + 8 * g + 4 * hi;
                v2u w; w.x = cvt_pk_bf16(o[db][4 * g] * f, o[db][4 * g + 1] * f); w.y = cvt_pk_bf16(o[db][4 * g + 2] * f, o[db][4 * g + 3] * f);
                *(v2u*)(O + orow + h * 64 + d) = w; }
        ATT_WAIT_BAR(0);
    }
#undef ATT_ISSUE
}
#undef ATT_WAIT_BAR
}

struct Args { Ptrs P; int ph_lo, ph_hi; };
struct Frame { LAS unsigned char* lds; volatile LAS unsigned* MISC; gu32* ctl; int tid, lane, wave, vcu, G; };

__device__ __forceinline__ void norm_row(const float* xrow, const float* g, const float* mb, int sh_off, int sc_off, bf16* hrow, int lane) {
    f32x4 v[4]; float ss = 0.f;
#pragma unroll
    for (int j = 0; j < 4; ++j) { v[j] = ((const f32x4*)xrow)[lane + 64 * j]; ss += (v[j][0] * v[j][0] + v[j][1] * v[j][1]) + (v[j][2] * v[j][2] + v[j][3] * v[j][3]); }
    const float inv = rsqrtf(wave_sum(ss) * (1.f / D) + NORM_EPS);
#pragma unroll
    for (int j = 0; j < 4; ++j) { const int c0 = (lane + 64 * j) * 4;
        const f32x4 gg = *(const f32x4*)(g + c0), sc = *(const f32x4*)(mb + sc_off + c0), sh = *(const f32x4*)(mb + sh_off + c0);
        const f32x4 o = v[j] * inv * gg * (sc + 1.f) + sh;
        v2u w; w.x = cvt_pk_bf16(o[0], o[1]); w.y = cvt_pk_bf16(o[2], o[3]); *(v2u*)(hrow + c0) = w; }
}
__device__ __forceinline__ void route_row(int row, const float* xin, const float* g, const float* mb, int sh_off, int sc_off, bf16* h, const float* rw, const float* rb, unsigned* cnt, unsigned* ltok, float* lw, int lane) {
    float hv[16]; float ss = 0.f;
#pragma unroll
    for (int j = 0; j < 4; ++j) { const f32x4 v = ((const f32x4*)(xin + (size_t)row * D))[lane + 64 * j]; hv[4 * j] = v[0]; hv[4 * j + 1] = v[1]; hv[4 * j + 2] = v[2]; hv[4 * j + 3] = v[3]; ss += (v[0] * v[0] + v[1] * v[1]) + (v[2] * v[2] + v[3] * v[3]); }
    const float inv = rsqrtf(wave_sum(ss) * (1.f / D) + NORM_EPS);
    float lg[16];
#pragma unroll
    for (int e = 0; e < 16; ++e) lg[e] = 0.f;
#pragma unroll
    for (int j = 0; j < 4; ++j) {
        const int c0 = (lane + 64 * j) * 4;
        const f32x4 gg = *(const f32x4*)(g + c0), sc = *(const f32x4*)(mb + sc_off + c0), sh = *(const f32x4*)(mb + sh_off + c0);
#pragma unroll
        for (int i = 0; i < 4; ++i) hv[4 * j + i] = hv[4 * j + i] * inv * gg[i] * (1.f + sc[i]) + sh[i];
        v2u w; w.x = cvt_pk_bf16(hv[4 * j], hv[4 * j + 1]); w.y = cvt_pk_bf16(hv[4 * j + 2], hv[4 * j + 3]);
        *(v2u*)(h + (size_t)row * D + c0) = w;
#pragma unroll
        for (int i = 0; i < 4; ++i) { const f32x4* wr = (const f32x4*)(rw + (size_t)(c0 + i) * NE); const float x = hv[4 * j + i];
#pragma unroll
            for (int q = 0; q < 4; ++q) { const f32x4 w4 = wr[q]; lg[4 * q] += x * w4[0]; lg[4 * q + 1] += x * w4[1]; lg[4 * q + 2] += x * w4[2]; lg[4 * q + 3] += x * w4[3]; } }
    }
#pragma unroll
    for (int e = 0; e < 16; ++e) lg[e] = wave_sum(lg[e]);
    if (lane == 0) {
        float sc[16], sel[16];
#pragma unroll
        for (int e = 0; e < 16; ++e) { sc[e] = 1.f / (1.f + __expf(-lg[e])); sel[e] = sc[e] + rb[e]; }
        int bg = 0; float bgs = -3e38f;
#pragma unroll
        for (int gi = 0; gi < 4; ++gi) {
            float m1 = -3e38f, m2 = -3e38f;
#pragma unroll
            for (int i = 0; i < 4; ++i) { const float v = sel[gi * 4 + i]; if (v > m1) { m2 = m1; m1 = v; } else if (v > m2) m2 = v; }
            const float gs = m1 + m2; if (gs > bgs) { bgs = gs; bg = gi; }
        }
        int e0 = 0, e1 = 0; float s0 = -3e38f, s1 = -3e38f, w0 = 0.f, w1 = 0.f;
#pragma unroll
        for (int gi = 0; gi < 4; ++gi) if (gi == bg) {
#pragma unroll
            for (int i = 0; i < 4; ++i) { const int e = gi * 4 + i; const float v = sel[e];
                if (v > s0) { s1 = s0; e1 = e0; w1 = w0; s0 = v; e0 = e; w0 = sc[e]; } else if (v > s1) { s1 = v; e1 = e; w1 = sc[e]; } }
        }
        const float ws = w0 + w1; w0 /= ws; w1 /= ws;
        const unsigned p0 = atomicAdd(&cnt[e0 * 64], 1u), p1 = atomicAdd(&cnt[e1 * 64], 1u);
        ltok[(size_t)e0 * T + p0] = (unsigned)row; lw[(size_t)e0 * T + p0] = w0;
        ltok[(size_t)e1 * T + p1] = (unsigned)row | 0x80000000u; lw[(size_t)e1 * T + p1] = w1;
    }
}
__device__ __forceinline__ void route_phase(Frame& F, const bf16* xin, const float* g, const float* mod_l, bf16* h, const float* rw, const float* rb, unsigned* cnt, unsigned* ltok, float* lw) {
    LAS float* rws = (LAS float*)F.lds;
    LAS unsigned* lcnt = (LAS unsigned*)(F.lds + 65536);
    const int lane = F.lane, e_l = lane & 15;
    for (int t = F.tid; t < 1024 * 4; t += NWAVES * 64) { const int k = t >> 2, q = t & 3; const f32x4 v = *(const f32x4*)(rw + (size_t)k * NE + 4 * q);
        const int j = k >> 8, ln = (k >> 2) & 63, i = k & 3; *(LAS f32x4*)(rws + ((((j * 4 + i) * 4 + q) * 64 + ln) * 4)) = v; }
    const float rbe = rb[e_l];
    for (int chunk = F.vcu; chunk < T / 64; chunk += F.G) {
        if (F.tid < 16) lcnt[F.tid] = 0u;
        __syncthreads();
        const int row0 = chunk * 64 + F.wave * 8, b = row0 / SEQ;
        const float* mb = mod_l + b * 6 * D;
        f32x4 Gm[4], Sh[4];
#pragma unroll
        for (int j = 0; j < 4; ++j) { const int c0 = (lane + 64 * j) * 4; const f32x4 gg = *(const f32x4*)(g + c0), sc = *(const f32x4*)(mb + 4 * D + c0); Gm[j] = gg * (sc + 1.f); Sh[j] = *(const f32x4*)(mb + 3 * D + c0); }
        unsigned s_tok[2], s_pl[2]; float s_w[2]; bool s_sel[2];
#pragma unroll
        for (int grp = 0; grp < 2; ++grp) {
            const int r0 = row0 + grp * 4;
            f32x4 xv[4][4];
#pragma unroll
            for (int r = 0; r < 4; ++r)
#pragma unroll
                for (int j = 0; j < 4; ++j) { const v2u q_ = *(const v2u*)(xin + (size_t)(r0 + r) * D + (lane + 64 * j) * 4); xv[r][j] = (f32x4){bf2f(q_.x), bf2f(q_.x >> 16), bf2f(q_.y), bf2f(q_.y >> 16)}; }
            float ss[4];
#pragma unroll
            for (int r = 0; r < 4; ++r) { ss[r] = 0.f;
#pragma unroll
                for (int j = 0; j < 4; ++j) ss[r] += (xv[r][j][0] * xv[r][j][0] + xv[r][j][1] * xv[r][j][1]) + (xv[r][j][2] * xv[r][j][2] + xv[r][j][3] * xv[r][j][3]); }
#pragma unroll
            for (int o = 1; o < 64; o <<= 1)
#pragma unroll
                for (int r = 0; r < 4; ++r) ss[r] += __shfl_xor(ss[r], o);
#pragma unroll
            for (int r = 0; r < 4; ++r) { const float inv = rsqrtf(ss[r] * (1.f / D) + NORM_EPS);
#pragma unroll
                for (int j = 0; j < 4; ++j) { xv[r][j] = xv[r][j] * inv * Gm[j] + Sh[j];
                    v2u w; w.x = cvt_pk_bf16(xv[r][j][0], xv[r][j][1]); w.y = cvt_pk_bf16(xv[r][j][2], xv[r][j][3]); *(v2u*)(h + (size_t)(r0 + r) * D + (lane + 64 * j) * 4) = w; } }
            float acc[64];
#pragma unroll
            for (int v = 0; v < 64; ++v) acc[v] = 0.f;
#pragma unroll
            for (int j = 0; j < 4; ++j)
#pragma unroll
                for (int i = 0; i < 4; ++i) {
                    f32x4 wq[4];
#pragma unroll
                    for (int q = 0; q < 4; ++q) wq[q] = *(const LAS f32x4*)(rws + ((((j * 4 + i) * 4 + q) * 64 + lane) * 4));
#pragma unroll
                    for (int r = 0; r < 4; ++r) { const float x = xv[r][j][i];
#pragma unroll
                        for (int q = 0; q < 4; ++q)
#pragma unroll
                            for (int c = 0; c < 4; ++c) acc[r * 16 + q * 4 + c] += x * wq[q][c]; } }
#pragma unroll
            for (int s = 32; s >= 1; s >>= 1) { const bool up = (lane & s) != 0;
#pragma unroll
                for (int v = 0; v < s; ++v) { const float a = acc[v], bq = acc[v + s]; const float keep = up ? bq : a, send = up ? a : bq; acc[v] = keep + __shfl_xor(send, s); } }
            const float sc = 1.f / (1.f + __expf(-acc[0])), sel = sc + rbe;
            const int q0 = lane & ~3, me = lane & 3, myg = (lane >> 2) & 3;
            float v4[4], s4[4];
#pragma unroll
            for (int i = 0; i < 4; ++i) { v4[i] = __shfl(sel, q0 + i); s4[i] = __shfl(sc, q0 + i); }
            float m1 = -3e38f, m2 = -3e38f;
#pragma unroll
            for (int i = 0; i < 4; ++i) { const float x = v4[i]; if (x > m1) { m2 = m1; m1 = x; } else if (x > m2) m2 = x; }
            const float gs = m1 + m2;
            int bg = 0; float best = -3e38f;
#pragma unroll
            for (int gi = 0; gi < 4; ++gi) { const float x = __shfl(gs, (lane & ~15) + 4 * gi); if (x > best) { best = x; bg = gi; } }
            int myrank = 0; float scsum = 0.f;
#pragma unroll
            for (int i = 0; i < 4; ++i) { int rk = 0;
#pragma unroll
                for (int j = 0; j < 4; ++j) if (j != i) rk += (v4[j] > v4[i] || (v4[j] == v4[i] && j < i)) ? 1 : 0;
                if (rk < 2) scsum += s4[i];
                if (i == me) myrank = rk; }
            const bool selected = (myg == bg) && (myrank < 2);
            s_sel[grp] = selected; s_w[grp] = sc / scsum; s_tok[grp] = (unsigned)(r0 + (lane >> 4)) | ((unsigned)myrank << 31); s_pl[grp] = 0u;
            if (selected) s_pl[grp] = __hip_atomic_fetch_add(lcnt + e_l, 1u, __ATOMIC_RELAXED, __HIP_MEMORY_SCOPE_WORKGROUP);
        }
        __syncthreads();
        if (F.tid < 16) lcnt[16 + F.tid] = atomicAdd(&cnt[F.tid * 64], lcnt[F.tid]);
        __syncthreads();
#pragma unroll
        for (int grp = 0; grp < 2; ++grp) if (s_sel[grp]) { const size_t idx = (size_t)e_l * T + lcnt[16 + e_l] + s_pl[grp]; ltok[idx] = s_tok[grp]; lw[idx] = s_w[grp]; }
        __syncthreads();
    }
}
template <int NR, bool LAST>
__device__ __forceinline__ void combine_rows(int row0, int rstride, bf16* xb, float* out, const bf16* ybuf, const float* gate, const float* g, const float* mbn, bf16* h, int lane) {
    f32x4 v[NR][4]; v2u y0[NR][4], y1[NR][4];
#pragma unroll
    for (int r = 0; r < NR; ++r)
#pragma unroll
        for (int j = 0; j < 4; ++j) { const int c0 = (lane + 64 * j) * 4; const size_t ro = (size_t)(row0 + r * rstride) * D + c0;
            const v2u q_ = *(const v2u*)(xb + ro); v[r][j] = (f32x4){bf2f(q_.x), bf2f(q_.x >> 16), bf2f(q_.y), bf2f(q_.y >> 16)};
            y0[r][j] = *(const v2u*)(ybuf + ro); y1[r][j] = *(const v2u*)(ybuf + (size_t)T * D + ro); }
    float ss[NR];
#pragma unroll
    for (int r = 0; r < NR; ++r) { ss[r] = 0.f;
#pragma unroll
        for (int j = 0; j < 4; ++j) { const int c0 = (lane + 64 * j) * 4; const size_t ro = (size_t)(row0 + r * rstride) * D + c0;
            const f32x4 gt = *(const f32x4*)(gate + c0);
            v[r][j][0] += gt[0] * (bf2f(y0[r][j].x) + bf2f(y1[r][j].x)); v[r][j][1] += gt[1] * (bf2f(y0[r][j].x >> 16) + bf2f(y1[r][j].x >> 16));
            v[r][j][2] += gt[2] * (bf2f(y0[r][j].y) + bf2f(y1[r][j].y)); v[r][j][3] += gt[3] * (bf2f(y0[r][j].y >> 16) + bf2f(y1[r][j].y >> 16));
            if (LAST) *(f32x4*)(out + ro) = v[r][j];
            else { v2u w; w.x = cvt_pk_bf16(v[r][j][0], v[r][j][1]); w.y = cvt_pk_bf16(v[r][j][2], v[r][j][3]); *(v2u*)(xb + ro) = w; }
            ss[r] += (v[r][j][0] * v[r][j][0] + v[r][j][1] * v[r][j][1]) + (v[r][j][2] * v[r][j][2] + v[r][j][3] * v[r][j][3]); } }
    if (!LAST) {
#pragma unroll
        for (int o = 1; o < 64; o <<= 1)
#pragma unroll
            for (int r = 0; r < NR; ++r) ss[r] += __shfl_xor(ss[r], o);
#pragma unroll
        for (int r = 0; r < NR; ++r) { const float inv = rsqrtf(ss[r] * (1.f / D) + NORM_EPS);
#pragma unroll
            for (int j = 0; j < 4; ++j) { const int c0 = (lane + 64 * j) * 4;
                const f32x4 gg = *(const f32x4*)(g + c0), sc = *(const f32x4*)(mbn + D + c0), sh = *(const f32x4*)(mbn + c0);
                const f32x4 o = v[r][j] * inv * gg * (sc + 1.f) + sh;
                v2u w; w.x = cvt_pk_bf16(o[0], o[1]); w.y = cvt_pk_bf16(o[2], o[3]); *(v2u*)(h + (size_t)(row0 + r * rstride) * D + c0) = w; } }
    }
}

template <class RowMap>
__device__ __forceinline__ void transpose_item(const float* W, int K, int N, bf16* WT, RowMap rm, LAS float* scr, int item, int lane) {
    const int nblk = N / 32, kb = item / nblk, nb = item % nblk, k0 = 64 * kb, n0 = 32 * nb;
    f32x4 v[8];
#pragma unroll
    for (int i = 0; i < 8; ++i) { const int kk = (lane >> 3) + 8 * i; v[i] = *(const f32x4*)(W + (size_t)(k0 + kk) * N + n0 + (lane & 7) * 4); }
#pragma unroll
    for (int i = 0; i < 8; ++i) { const int kk = (lane >> 3) + 8 * i; LAS float* d = scr + kk * 33 + (lane & 7) * 4; d[0] = v[i][0]; d[1] = v[i][1]; d[2] = v[i][2]; d[3] = v[i][3]; }
    LDS_WAIT(); asm volatile("" ::: "memory");
    const int c = lane & 7;
#pragma unroll
    for (int j = 0; j < 4; ++j) { const int n = (lane >> 3) + 8 * j; const LAS float* s = scr + (8 * c) * 33 + n;
        v4u o; o.x = cvt_pk_bf16(s[0 * 33], s[1 * 33]); o.y = cvt_pk_bf16(s[2 * 33], s[3 * 33]); o.z = cvt_pk_bf16(s[4 * 33], s[5 * 33]); o.w = cvt_pk_bf16(s[6 * 33], s[7 * 33]);
        *(v4u*)(WT + (size_t)rm(n0 + n) * K + k0 + 8 * c) = o; }
    LDS_WAIT(); asm volatile("" ::: "memory");
}
struct RmId { __device__ __forceinline__ int operator()(int n) const { return n; } };
struct RmQkv { __device__ __forceinline__ int operator()(int n) const { return (n & ~255) + 128 * ((n >> 5) & 1) + 32 * ((n >> 6) & 3) + (n & 31); } };
struct RmGU { int add; __device__ __forceinline__ int operator()(int n) const { return 256 * (n >> 7) + (n & 127) + add; } };

__device__ __forceinline__ int t5_bucket_fast(int rel) {
    const int ret = rel > 0 ? 16 : 0; const int n = rel < 0 ? -rel : rel;
    const int large = 8 + (n >= 15) + (n >= 27) + (n >= 50) + (n >= 91) + (n >= 166) + (n >= 305) + (n >= 559);
    return ret + (n < 8 ? n : large);
}
constexpr int TABA_N = 768, TABB_N = 416;
constexpr int MISC_TABA = 64, MISC_TABB = MISC_TABA + 8 * TABA_N;

__device__ __forceinline__ void p0_prologue(Frame& F, const Ptrs& P) {
    const int gw = F.vcu * NWAVES + F.wave, NGW = F.G * NWAVES, lane = F.lane;
    float* mod = (float*)(P.ws + WS_MOD); float* misc = (float*)(P.ws + WS_MISC);
    for (int it = gw; it < DEPTH * 384; it += NGW) {
        const int l = it / 384, n0 = (it % 384) * 16, kq = lane >> 2, cq = lane & 3;
        f32x4 a0 = {0.f, 0.f, 0.f, 0.f}, a1 = {0.f, 0.f, 0.f, 0.f};
#pragma unroll 8
        for (int i = 0; i < 64; ++i) { const int k = kq + 16 * i; const f32x4 w4 = *(const f32x4*)(P.ada_w + ((size_t)l * D + k) * (6 * D) + n0 + 4 * cq);
            const float c0 = P.c[k], c1 = P.c[D + k]; const float s0 = c0 / (1.f + __expf(-c0)), s1 = c1 / (1.f + __expf(-c1)); a0 += w4 * s0; a1 += w4 * s1; }
#pragma unroll
        for (int o = 4; o < 64; o <<= 1)
#pragma unroll
            for (int i = 0; i < 4; ++i) { a0[i] += __shfl_xor(a0[i], o); a1[i] += __shfl_xor(a1[i], o); }
        if (kq == 0) { const f32x4 bb = *(const f32x4*)(P.ada_b + l * 6 * D + n0 + 4 * cq);
            *(f32x4*)(mod + (l * 2 + 0) * 6 * D + n0 + 4 * cq) = a0 + bb; *(f32x4*)(mod + (l * 2 + 1) * 6 * D + n0 + 4 * cq) = a1 + bb; }
    }
    if (gw == NGW - 1 && lane == 0) { float s01 = 0.f, s23 = 0.f;
        for (int d = 0; d < 64; ++d) { s01 += P.a_lambda[d] * P.a_lambda[64 + d]; s23 += P.a_lambda[128 + d] * P.a_lambda[192 + d]; }
        misc[0] = __expf(s01) - __expf(s23) + 0.2f; }
    for (int i = gw * 64 + lane; i < 8 * TABA_N + 16 * TABB_N; i += NGW * 64) {
        if (i < 8 * TABA_N) { const int h = i / TABA_N, rel = i % TABA_N - 704; misc[MISC_TABA + i] = (P.t5_bias[t5_bucket_fast(rel) * 8 + h] - P.t5_bias[15 * 8 + h]) * LOG2E; }
        else { const int j = i - 8 * TABA_N, h = j / TABB_N; int rel = j % TABB_N - 352; rel = rel < -256 ? -256 : (rel > 256 ? 256 : rel);
            misc[MISC_TABB + j] = (P.b_rel_bias[h * 513 + rel + 256] - P.b_rel_bias[h * 513]) * LOG2E; }
    }
    LAS float* scr = (LAS float*)(F.lds + F.wave * 16384);
    constexpr int I_QKV = 16 * 96, I_WO = 16 * 32, I_E = 256, I_DENSE = 2 * (I_QKV + I_WO), NITEMS = I_DENSE + DEPTH * NE * 3 * I_E;
    struct Desc { const float* W; bf16* WT; int K, N, kind, item; };
    auto decode = [&](int it) {
        Desc d; int r = it;
        if (r < I_QKV) { d.W = P.a_w_qkv; d.WT = (bf16*)(P.ws + WS_WQKV_A); d.K = D; d.N = 3 * D; d.kind = 1; d.item = r; return d; } r -= I_QKV;
        if (r < I_WO) { d.W = P.a_w_o; d.WT = (bf16*)(P.ws + WS_WO_A); d.K = D; d.N = D; d.kind = 0; d.item = r; return d; } r -= I_WO;
        if (r < I_QKV) { d.W = P.b_w_qkv; d.WT = (bf16*)(P.ws + WS_WQKV_B); d.K = D; d.N = 3 * D; d.kind = 1; d.item = r; return d; } r -= I_QKV;
        if (r < I_WO) { d.W = P.b_w_o; d.WT = (bf16*)(P.ws + WS_WO_B); d.K = D; d.N = D; d.kind = 0; d.item = r; return d; } r -= I_WO;
        const int le = r / (3 * I_E), which = (r / I_E) % 3; d.item = r % I_E;
        if (which == 0) { d.W = P.moe_w_gate + (size_t)le * D * FF; d.WT = (bf16*)(P.ws + WS_WGU) + (size_t)le * 1024 * D; d.K = D; d.N = FF; d.kind = 2; }
        else if (which == 1) { d.W = P.moe_w_up + (size_t)le * D * FF; d.WT = (bf16*)(P.ws + WS_WGU) + (size_t)le * 1024 * D; d.K = D; d.N = FF; d.kind = 3; }
        else { d.W = P.moe_w_down + (size_t)le * FF * D; d.WT = (bf16*)(P.ws + WS_WD) + (size_t)le * D * FF; d.K = FF; d.N = D; d.kind = 0; }
        return d; };
    f32x4 v[8];
#define P0_LOAD(d) do { const int nblk_ = (d).N / 32, k0_ = 64 * ((d).item / nblk_), n0_ = 32 * ((d).item % nblk_); _Pragma("unroll") for (int i = 0; i < 8; ++i) { const int kk = (lane >> 3) + 8 * i; \
        v[i] = *(const f32x4*)((d).W + (size_t)(k0_ + kk) * (d).N + n0_ + (lane & 7) * 4); } } while (0)
    int it = gw;
    if (it < NITEMS) { Desc cur = decode(it); P0_LOAD(cur);
        for (;;) {
#pragma unroll
            for (int i = 0; i < 8; ++i) { const int kk = (lane >> 3) + 8 * i; LAS float* dd = scr + kk * 33 + (lane & 7) * 4; dd[0] = v[i][0]; dd[1] = v[i][1]; dd[2] = v[i][2]; dd[3] = v[i][3]; }
            const int nit = it + NGW; const bool more = nit < NITEMS;
            Desc nx = cur; if (more) { nx = decode(nit); P0_LOAD(nx); }
            LDS_WAIT(); asm volatile("" ::: "memory");
            { const int nblk = cur.N / 32, k0 = 64 * (cur.item / nblk), n0 = 32 * (cur.item % nblk), c = lane & 7;
#pragma unroll
              for (int j = 0; j < 4; ++j) { const int n = (lane >> 3) + 8 * j; const LAS float* sp = scr + (8 * c) * 33 + n;
                  v4u o; o.x = cvt_pk_bf16(sp[0 * 33], sp[1 * 33]); o.y = cvt_pk_bf16(sp[2 * 33], sp[3 * 33]); o.z = cvt_pk_bf16(sp[4 * 33], sp[5 * 33]); o.w = cvt_pk_bf16(sp[6 * 33], sp[7 * 33]);
                  const int ng = n0 + n; int nr = ng;
                  if (cur.kind == 1) nr = (ng & ~255) + 128 * ((ng >> 5) & 1) + 32 * ((ng >> 6) & 3) + (ng & 31); else if (cur.kind >= 2) nr = 256 * (ng >> 7) + (ng & 127) + (cur.kind == 3 ? 128 : 0);
                  *(v4u*)(cur.WT + (size_t)nr * cur.K + k0 + 8 * c) = o; } }
            LDS_WAIT(); asm volatile("" ::: "memory");
            if (!more) break;
            cur = nx; it = nit;
        } }
#undef P0_LOAD
}

__device__ __forceinline__ void moe_prep(Frame& F, const unsigned* cnt) {
    LAS unsigned* tab = (LAS unsigned*)(F.lds + TAB_OFF);
    if (F.tid == 0) { int rt = 0, base = 0;
        for (int e = 0; e < NE; ++e) { const int c = (int)cnt[e * 64]; const int ntl = (c + 255) >> 8; tab[160 + e] = (unsigned)base; tab[176 + e] = (unsigned)c;
            for (int i = 0; i < ntl; ++i) tab[1 + rt + i] = (unsigned)e | ((unsigned)i << 8);
            rt += ntl; base += ntl * 256; }
        tab[0] = (unsigned)rt; }
    __syncthreads();
}

#ifndef REP_P0
#define REP_P0 1
#endif
#ifndef REP_QKV
#define REP_QKV 1
#endif
#ifndef REP_ATT0
#define REP_ATT0 1
#endif
#ifndef REP_ATT1
#define REP_ATT1 1
#endif
#ifndef REP_WO0
#define REP_WO0 1
#endif
#ifndef REP_UP
#define REP_UP 1
#endif
#ifndef REP_DOWN
#define REP_DOWN 1
#endif
#ifndef REP_NORM1
#define REP_NORM1 1
#endif
#ifndef REP_ROUTE
#define REP_ROUTE 1
#endif
#ifndef REP_BAR
#define REP_BAR 1
#endif
#ifndef DBG_EN
#define DBG_EN 0x1FFu
#endif
#define EN(j) ((DBG_EN >> (j)) & 1u)
#define IN(k) (lo <= (k) && (k) < hi)
#define SEAM(k) do { if (IN(k) && IN((k) + 1)) { xcd_barrier(bar); if (REP_BAR > 1) xcd_barrier(bar); } } while (0)
template <int l>
__device__ __forceinline__ void run_layer(Frame& F, const Ptrs& P, const XcdBarrier& bar, const int lo, const int hi) {
    unsigned char* ws = P.ws;
    float* mod = (float*)(ws + WS_MOD); const float* misc = (const float*)(ws + WS_MISC);
    bf16 *H = (bf16*)(ws + WS_H), *Qb = (bf16*)(ws + WS_Q), *Kb = (bf16*)(ws + WS_K), *Vb = (bf16*)(ws + WS_V), *Y = (bf16*)(ws + WS_Y), *HE = (bf16*)(ws + WS_HE), *XB = (bf16*)(ws + WS_XB);
    const int gw = F.vcu * NWAVES + F.wave, NGW = F.G * NWAVES;
    {
        const int pb = 2 + 7 * l;
        const float* mod_l = mod + l * 2 * 6 * D;
        const float* xin = (l == 0) ? P.x : P.out;
#define QKV_BODY { g8::DenseOrder S; S.init(T, 3 * D, F.G, (int)blockIdx.x); \
            g8::EpiQKV E{Qb, (size_t)(WS_K - WS_Q) / 2, l == 0 ? P.a_q_gain : P.b_q_gain, l == 0 ? P.a_k_gain : P.b_k_gain}; \
            g8::gemm_phase(F.lds, H, (const bf16*)(ws + (l == 0 ? WS_WQKV_A : WS_WQKV_B)), D, S, E); }
        if (EN(2) && IN(pb + 0)) {
            QKV_BODY
            if (REP_QKV > 1) QKV_BODY
        } SEAM(pb + 0);
        if (EN(3) && IN(pb + 1)) for (int rep = 0; rep < (l == 0 ? REP_ATT0 : REP_ATT1); ++rep) {
            if (l == 0) {
                const float lam = misc[0];
                if (F.G == 256) { const int bh = F.vcu >> 4, s = F.vcu & 15;
                    for (int i = 0; i < 4; ++i) { const int qb = (i == 0) ? s : (i == 1) ? 31 - s : (i == 2) ? 32 + s : 63 - s; att::attn_unit<0>(bh >> 3, bh & 7, qb, Qb, Kb, Vb, H, F.lds, misc + MISC_TABA, lam, P.a_subln_g); } }
                else for (int u = (int)blockIdx.x; u < 1024; u += F.G) att::attn_unit<0>(u >> 9, (u >> 6) & 7, u & 63, Qb, Kb, Vb, H, F.lds, misc + MISC_TABA, lam, P.a_subln_g);
            } else {
                if (F.G == 256) { const int bh = F.vcu >> 3;
                    for (int i = 0; i < 4; ++i) att::attn_unit<1>(bh >> 4, bh & 15, (F.vcu & 7) * 4 + i, Qb, Kb, Vb, H, F.lds, misc + MISC_TABB, 0.f, nullptr); }
                else for (int u = (int)blockIdx.x; u < 1024; u += F.G) att::attn_unit<1>(u >> 9, (u >> 5) & 15, u & 31, Qb, Kb, Vb, H, F.lds, misc + MISC_TABB, 0.f, nullptr);
            }
        } SEAM(pb + 1);
#define WO_BODY { g8::DenseOrder S; S.init(T, D, F.G, (int)blockIdx.x); \
            g8::EpiWo<(l > 0)> E{P.x, mod_l + 2 * D, XB}; \
            g8::gemm_phase(F.lds, H, (const bf16*)(ws + (l == 0 ? WS_WO_A : WS_WO_B)), D, S, E); }
        if (EN(4) && IN(pb + 2)) {
            WO_BODY
            if (l == 0 && REP_WO0 > 1) WO_BODY
        } SEAM(pb + 2);
        unsigned* cnt = (unsigned*)(F.ctl + CW_CNT + l * 16 * 64); unsigned* ltok = (unsigned*)(ws + WS_LTOK) + (size_t)l * NE * T; float* lw = (float*)(ws + WS_LW) + (size_t)l * NE * T;
        if (EN(5) && IN(pb + 3)) {
            route_phase(F, XB, P.norm_ffn_g + l * D, mod_l, H, P.router_w, P.router_bias, cnt, ltok, lw);
            if (REP_ROUTE > 1) route_phase(F, XB, P.norm_ffn_g + l * D, mod_l, H, P.router_w, P.router_bias, (unsigned*)(F.ctl + CW_CNT + 2 * 16 * 64), (unsigned*)(ws + WS_HE), (float*)(ws + WS_HE + 2 * MiB));
        } SEAM(pb + 3);
        if (EN(6) && IN(pb + 4)) for (int rep = 0; rep < REP_UP; ++rep) {
            moe_prep(F, cnt);
            g8::MoeOrder<true> S{(const LAS unsigned*)(F.lds + TAB_OFF), ltok, F.G, (int)blockIdx.x};
            g8::EpiUp E{HE};
            g8::gemm_phase(F.lds, H, (const bf16*)(ws + WS_WGU) + (size_t)l * NE * 1024 * D, D, S, E);
        } SEAM(pb + 4);
        if (EN(7) && IN(pb + 5)) for (int rep = 0; rep < REP_DOWN; ++rep) {
            moe_prep(F, cnt);
            g8::MoeOrder<false> S{(const LAS unsigned*)(F.lds + TAB_OFF), ltok, F.G, (int)blockIdx.x};
            g8::EpiDown E{ltok, lw, Y};
            g8::gemm_phase(F.lds, HE, (const bf16*)(ws + WS_WD) + (size_t)l * NE * D * FF, FF, S, E);
        } SEAM(pb + 5);
        if (EN(8) && IN(pb + 6)) {
            const bool dn = (l + 1 < DEPTH);
            for (int row = gw; row < T / 2; row += NGW) {
                const int b = row / (SEQ / 2), r0 = b * SEQ + (row % (SEQ / 2));
                combine_rows<2, (l + 1 >= DEPTH)>(r0, SEQ / 2, XB, P.out, Y, mod_l + b * 6 * D + 5 * D, P.norm_mix_g + (dn ? (l + 1) : 0) * D, mod + ((dn ? (l + 1) : 0) * 2 + b) * 6 * D, H, F.lane); }
        } SEAM(pb + 6);
    }
}
__global__ void __launch_bounds__(NWAVES * 64, 2) mk_fwd(Args args) {
    extern __shared__ __attribute__((aligned(16))) unsigned char lds[];
    Frame F;
    F.lds = (LAS unsigned char*)lds; F.MISC = (volatile LAS unsigned*)(F.lds + MISC_OFF);
    F.tid = threadIdx.x; F.lane = F.tid & 63; F.wave = __builtin_amdgcn_readfirstlane(F.tid >> 6);
    F.G = gridDim.x; { const int bx = blockIdx.x; F.vcu = (F.G % 8 == 0) ? (bx % 8) * (F.G / 8) + bx / 8 : bx; }
    const Ptrs& P = args.P;
    unsigned char* ws = P.ws;
    F.ctl = (gu32*)(ws + WS_CTL);
    for (int u = F.tid; u < (LDS_BYTES - LDSCTL_OFF) / 4; u += NWAVES * 64) ((LAS unsigned*)(F.lds + LDSCTL_OFF))[u] = 0u;
    __syncthreads();
    const int lo = args.ph_lo, hi = args.ph_hi;
    const bool multi = (hi - lo) > 1;
    XcdBarrier bar; bar.bar = (unsigned*)(F.ctl + CW_BAR); bar.x = 0; bar.st = nullptr;
    if (multi) bar = xcd_barrier_post((unsigned*)(F.ctl + CW_BAR), F.MISC + 8);
    float* mod = (float*)(ws + WS_MOD); const float* misc = (const float*)(ws + WS_MISC);
    bf16 *H = (bf16*)(ws + WS_H), *Qb = (bf16*)(ws + WS_Q), *Kb = (bf16*)(ws + WS_K), *Vb = (bf16*)(ws + WS_V), *Y = (bf16*)(ws + WS_Y), *HE = (bf16*)(ws + WS_HE);
    const int gw = F.vcu * NWAVES + F.wave, NGW = F.G * NWAVES;

    if (EN(0) && IN(0)) { for (int rep = 0; rep < REP_P0; ++rep) p0_prologue(F, P); } SEAM(0);
    if (EN(1) && IN(1)) for (int rep = 0; rep < REP_NORM1; ++rep) { for (int row = gw; row < T; row += NGW) norm_row(P.x + (size_t)row * D, P.norm_mix_g, mod + (row / SEQ) * 6 * D, 0, D, H + (size_t)row * D, F.lane); } SEAM(1);

    run_layer<0>(F, P, bar, lo, hi);
    run_layer<1>(F, P, bar, lo, hi);
#undef IN
#undef SEAM
}
#ifndef FASTMASK
#define FASTMASK 0xFFFFu
#endif
#ifndef ONE_LAUNCH
#define ONE_LAUNCH 1
#endif
extern "C" void kernel_launch(void* const* d_in, const int* in_sizes, int n_in, void* d_out, int out_size, void* d_ws, size_t ws_size, hipStream_t stream) {
    static int grid = 0;
    if (grid == 0) {
        if (n_in != 23 || out_size != T * D || ws_size < WS_END) { fprintf(stderr, "kernel_launch: unexpected shapes (n_in %d out %d ws %zu)\n", n_in, out_size, ws_size); grid = -1; return; }
        int dev = 0, cus = 0, per_cu = 0;
        if (hipGetDevice(&dev) != hipSuccess || hipDeviceGetAttribute(&cus, hipDeviceAttributeMultiprocessorCount, dev) != hipSuccess) { grid = -1; return; }
        if (hipFuncSetAttribute((const void*)mk_fwd, hipFuncAttributeMaxDynamicSharedMemorySize, LDS_BYTES) != hipSuccess) { fprintf(stderr, "kernel_launch: hipFuncSetAttribute failed\n"); grid = -1; return; }
        if (hipOccupancyMaxActiveBlocksPerMultiprocessor(&per_cu, (const void*)mk_fwd, NWAVES * 64, LDS_BYTES) != hipSuccess || per_cu < 1) fprintf(stderr, "kernel_launch: occupancy query reports %d\n", per_cu);
        (void)hipGetLastError();
        grid = cus;
    }
    if (grid < 0) return;
    Args a{};
    const float** pp = (const float**)&a.P;
    for (int i = 0; i < 23; ++i) pp[i] = (const float*)d_in[i];
    a.P.out = (float*)d_out; a.P.ws = (unsigned char*)d_ws;
    const Ptrs& P = a.P;
    unsigned char* ws = P.ws;
    (void)hipMemsetAsync(ws + WS_CTL, 0, CTL_ZERO_BYTES, stream);
#if ONE_LAUNCH
    a.ph_lo = 0; a.ph_hi = 16;
    hipLaunchKernelGGL(mk_fwd, dim3(grid), dim3(NWAVES * 64), LDS_BYTES, stream, a);
#else
    float* mod = (float*)(ws + WS_MOD); float* misc = (float*)(ws + WS_MISC);
    bf16 *H = (bf16*)(ws + WS_H), *Q = (bf16*)(ws + WS_Q), *Kb = (bf16*)(ws + WS_K), *V = (bf16*)(ws + WS_V), *Y = (bf16*)(ws + WS_Y), *HE = (bf16*)(ws + WS_HE);
    unsigned* ctl = (unsigned*)(ws + WS_CTL);
#define FAST(p) ((FASTMASK >> (p)) & 1u)
#define RUNFAST(p) do { a.ph_lo = (p); a.ph_hi = (p) + 1; hipLaunchKernelGGL(mk_fwd, dim3(grid), dim3(NWAVES * 64), LDS_BYTES, stream, a); } while (0)
    if (FASTMASK != 0u) RUNFAST(0);
    if (!FAST(0)) k_adaln<<<(DEPTH * 6 * D + 255) / 256, 256, 0, stream>>>(P);
    if (FAST(1)) RUNFAST(1); else k_norm<<<T, 256, 0, stream>>>(P.x, P.norm_mix_g, mod, 0, D, H);
    for (int l = 0; l < DEPTH; ++l) {
        const int pb = 2 + 7 * l;
        const float* mod_l = mod + l * 2 * 6 * D;
        const float* xin = (l == 0) ? P.x : P.out;
        if (FAST(pb + 0)) RUNFAST(pb + 0); else { ProbQKV pq{H, l == 0 ? P.a_w_qkv : P.b_w_qkv, l == 0 ? P.a_q_gain : P.b_q_gain, l == 0 ? P.a_k_gain : P.b_k_gain, Q, Kb, V, D, 0, 0}; k_slow_gemm<ProbQKV><<<(T / 64) * 48, 256, 0, stream>>>(pq); }
        if (FAST(pb + 1)) RUNFAST(pb + 1); else { if (l == 0) k_slow_attnA<<<BATCH * 8 * (SEQ / 32), 64, 0, stream>>>(Q, Kb, V, P.t5_bias, misc, P.a_subln_g, H); else k_slow_attnB<<<BATCH * 16 * (SEQ / 64), 64, 0, stream>>>(Q, Kb, V, P.b_rel_bias, H); }
        if (FAST(pb + 2)) RUNFAST(pb + 2); else { ProbWo pw{H, l == 0 ? P.a_w_o : P.b_w_o, xin, mod_l + 2 * D, P.out, D, 0, 0}; k_slow_gemm<ProbWo><<<(T / 64) * 16, 256, 0, stream>>>(pw); }
        unsigned* cnt = ctl + CW_CNT + l * 16 * 64; unsigned* ltok = (unsigned*)(ws + WS_LTOK) + (size_t)l * NE * T; float* lw = (float*)(ws + WS_LW) + (size_t)l * NE * T;
        if (FAST(pb + 3)) RUNFAST(pb + 3); else k_norm_route<<<T / 4, 256, 0, stream>>>(P.out, P.norm_ffn_g + l * D, mod_l, 3 * D, 4 * D, H, P.router_w, P.router_bias, cnt, ltok, lw);
        if (FAST(pb + 4)) RUNFAST(pb + 4); else { ProbUp pu{H, P.moe_w_gate + (size_t)l * NE * D * FF, P.moe_w_up + (size_t)l * NE * D * FF, cnt, ltok, HE, D, 0, 0, 0, 0, 0}; k_slow_gemm<ProbUp><<<NE * 256 * 8, 256, 0, stream>>>(pu); }
        if (FAST(pb + 5)) RUNFAST(pb + 5); else { ProbDown pd{HE, P.moe_w_down + (size_t)l * NE * FF * D, cnt, ltok, lw, Y, FF, 0, 0, 0, 0, 0}; k_slow_gemm<ProbDown><<<NE * 256 * 16, 256, 0, stream>>>(pd); }
        const int nl = l + 1;
        if (FAST(pb + 6)) RUNFAST(pb + 6); else k_combine<<<T, 256, 0, stream>>>(P.out, Y, mod_l + 5 * D, nl < DEPTH ? 1 : 0, P.norm_mix_g + (nl < DEPTH ? nl : 0) * D, mod + (nl < DEPTH ? nl : 0) * 2 * 6 * D, 0, D, H);
    }
#endif
}
```
